# Optimizing an MI355X kernel written in HIP

```python
import math
import jax, jax.numpy as jnp
from jax import lax
import numpy as np

D_MODEL = 1024
BATCH = 2
SEQ = 8192
DEPTH = 1
DEC_BATCH = 128
DEC_SEQ = 1
PAST_LEN = 16384
PAGE_SIZE = 128

N_META = 16
N_HEADS = 8
N_KV_HEADS = 2
HEAD_DIM = 64
Q_PER_KV = N_HEADS // N_KV_HEADS
ATTN_WIDTH = N_HEADS * HEAD_DIM
KV_WIDTH = N_KV_HEADS * HEAD_DIM
WINDOW = 128
BLOCK = 128
CONV_CH = 512
CONV_W = 31
REL_BUCKETS = 32
REL_MAX_DIST = 128
D_FF = 2816
EPS = 1e-6
NEG = -1e30
IN_SPLITS = (ATTN_WIDTH, KV_WIDTH, KV_WIDTH, 2 * CONV_CH, D_MODEL, D_MODEL)
IN_WIDTH = sum(IN_SPLITS)

kernel_name = "hybrid_swa_sink_conformer_conv_macaron_step"


def rms_norm(x, g):
    xf = x.astype(jnp.float32)
    y = xf * lax.rsqrt(jnp.mean(xf * xf, axis=-1, keepdims=True) + EPS)
    return (y * g.astype(jnp.float32)).astype(x.dtype)


def layer_norm(x, g, b):
    xf = x.astype(jnp.float32)
    mu = jnp.mean(xf, axis=-1, keepdims=True)
    var = jnp.mean(jnp.square(xf - mu), axis=-1, keepdims=True)
    y = (xf - mu) * lax.rsqrt(var + EPS)
    return (y * g.astype(jnp.float32) + b.astype(jnp.float32)).astype(x.dtype)


def swiglu_ffn(x, g, w1, w3, w2):
    h = rms_norm(x, g)
    return (jax.nn.silu(h @ w1) * (h @ w3)) @ w2


def t5_bucket(dist):
    max_exact = REL_BUCKETS // 2
    d = jnp.maximum(dist, 0)
    ratio = jnp.log(jnp.maximum(d, 1).astype(jnp.float32) / max_exact) / math.log(REL_MAX_DIST / max_exact)
    large = jnp.minimum(max_exact + (ratio * (REL_BUCKETS - max_exact)).astype(jnp.int32), REL_BUCKETS - 1)
    return jnp.where(d < max_exact, d, large)


def band_bias(dist, rel_bias):
    b = rel_bias.astype(jnp.float32)[t5_bucket(dist)]
    b = jnp.transpose(b, (2, 0, 1)).reshape(N_KV_HEADS, Q_PER_KV, *dist.shape)
    ok = (dist >= 0) & (dist < WINDOW)
    return jnp.where(ok, b, NEG)


def sink_attention(q, k, v, bias, sinks):
    s = jnp.einsum('...qkgd,...skd->...kgqs', q, k).astype(jnp.float32) * (HEAD_DIM ** -0.5) + bias
    sink = sinks.astype(jnp.float32).reshape(N_KV_HEADS, Q_PER_KV, 1)
    m = jnp.maximum(jnp.max(s, axis=-1), sink)
    p = jnp.exp(s - m[..., None])
    denom = jnp.sum(p, axis=-1) + jnp.exp(sink - m)
    p = (p / denom[..., None]).astype(v.dtype)
    return jnp.einsum('...kgqs,...skd->...qkgd', p, v)


def pre_mix(h, mix_norm, w_in, q_norm, k_norm):
    u = rms_norm(h, mix_norm)
    z = u @ w_in
    o = [0]
    for w in IN_SPLITS:
        o.append(o[-1] + w)
    lead = h.shape[:-1]
    q = rms_norm(z[..., o[0]:o[1]].reshape(*lead, N_HEADS, HEAD_DIM), q_norm)
    q = q.reshape(*lead, N_KV_HEADS, Q_PER_KV, HEAD_DIM)
    k = rms_norm(z[..., o[1]:o[2]].reshape(*lead, N_KV_HEADS, HEAD_DIM), k_norm)
    v = z[..., o[2]:o[3]].reshape(*lead, N_KV_HEADS, HEAD_DIM)
    a, b = jnp.split(z[..., o[3]:o[4]], 2, axis=-1)
    glu = a * jax.nn.sigmoid(b)
    gate_attn = jax.nn.sigmoid(z[..., o[4]:o[5]])
    gate_conv = jax.nn.sigmoid(z[..., o[5]:o[6]])
    return q, k, v, glu, gate_attn, gate_conv


def conv_branch(c, w_dw, b_dw, conv_ln_g, conv_ln_b, w_conv_out):
    y = lax.conv_general_dilated(c, w_dw[:, None, :].astype(c.dtype), window_strides=(1,), padding='VALID',
                                 dimension_numbers=('NWC', 'WIO', 'NWC'), feature_group_count=CONV_CH) + b_dw
    y = jax.nn.silu(layer_norm(y, conv_ln_g, conv_ln_b))
    return y @ w_conv_out


def post_mix(h, attn_o, conv_o, gate_attn, gate_conv, w_attn_out, w_out):
    a = attn_o.reshape(*attn_o.shape[:-3], ATTN_WIDTH) @ w_attn_out
    return h + (gate_attn * a + gate_conv * conv_o) @ w_out


def setup_inputs(seed: int = 0) -> dict:
    key = jax.random.key(seed)
    ks = jax.random.split(key, 32)
    nrm = lambda k, shape, s: jax.random.normal(k, shape, jnp.float32) * s
    gain = lambda k, n: 1.0 + 0.05 * jax.random.normal(k, (n,), jnp.float32)
    w_buf = min(WINDOW, PAST_LEN)
    return {
        "x_prompt": nrm(ks[0], (BATCH, SEQ, D_MODEL), 1.0),
        "x_sample": nrm(ks[1], (DEC_BATCH, DEC_SEQ, D_MODEL), 1.0),
        "cache_k": nrm(ks[2], (DEC_BATCH, w_buf, N_KV_HEADS, HEAD_DIM), 1.0),
        "cache_v": nrm(ks[3], (DEC_BATCH, w_buf, N_KV_HEADS, HEAD_DIM), 1.0),
        "state_conv": nrm(ks[4], (DEC_BATCH, CONV_W - 1, CONV_CH), 0.5),
        "meta_tokens": nrm(ks[5], (N_META, D_MODEL), 1.0),
        "ffn1_norm": gain(ks[6], D_MODEL),
        "ffn1_w1": nrm(ks[7], (D_MODEL, D_FF), D_MODEL ** -0.5),
        "ffn1_w3": nrm(ks[8], (D_MODEL, D_FF), D_MODEL ** -0.5),
        "ffn1_w2": nrm(ks[9], (D_FF, D_MODEL), D_FF ** -0.5),
        "mix_norm": gain(ks[10], D_MODEL),
        "w_in": nrm(ks[11], (D_MODEL, IN_WIDTH), D_MODEL ** -0.5),
        "q_norm": gain(ks[12], HEAD_DIM),
        "k_norm": gain(ks[13], HEAD_DIM),
        "rel_bias": nrm(ks[14], (REL_BUCKETS, N_HEADS), 0.5),
        "sinks": nrm(ks[15], (N_HEADS,), 0.5),
        "w_attn_out": nrm(ks[16], (ATTN_WIDTH, D_MODEL), ATTN_WIDTH ** -0.5),
        "w_dw": nrm(ks[17], (CONV_W, CONV_CH), CONV_W ** -0.5),
        "b_dw": nrm(ks[18], (CONV_CH,), 0.02),
        "conv_ln_g": gain(ks[19], CONV_CH),
        "conv_ln_b": nrm(ks[20], (CONV_CH,), 0.02),
        "w_conv_out": nrm(ks[21], (CONV_CH, D_MODEL), CONV_CH ** -0.5),
        "w_out": nrm(ks[22], (D_MODEL, D_MODEL), D_MODEL ** -0.5),
        "ffn2_norm": gain(ks[23], D_MODEL),
        "ffn2_w1": nrm(ks[24], (D_MODEL, D_FF), D_MODEL ** -0.5),
        "ffn2_w3": nrm(ks[25], (D_MODEL, D_FF), D_MODEL ** -0.5),
        "ffn2_w2": nrm(ks[26], (D_FF, D_MODEL), D_FF ** -0.5),
    }


def reference(x_prompt, x_sample, cache_k, cache_v, state_conv, meta_tokens,
              ffn1_norm, ffn1_w1, ffn1_w3, ffn1_w2, mix_norm, w_in, q_norm, k_norm,
              rel_bias, sinks, w_attn_out, w_dw, b_dw, conv_ln_g, conv_ln_b, w_conv_out,
              w_out, ffn2_norm, ffn2_w1, ffn2_w3, ffn2_w2):
    B = x_prompt.shape[0]
    x = jnp.concatenate([jnp.broadcast_to(meta_tokens.astype(x_prompt.dtype)[None], (B, N_META, D_MODEL)),
                         x_prompt], axis=1)
    L = x.shape[1]
    for _ in range(DEPTH):
        h = x + 0.5 * swiglu_ffn(x, ffn1_norm, ffn1_w1, ffn1_w3, ffn1_w2)
        q, k, v, glu, ga, gc = pre_mix(h, mix_norm, w_in, q_norm, k_norm)
        lead_pad = (-N_META) % BLOCK
        nb = (L + lead_pad) // BLOCK
        qb = jnp.pad(q, ((0, 0), (lead_pad, 0), (0, 0), (0, 0), (0, 0))).reshape(
            B, nb, BLOCK, N_KV_HEADS, Q_PER_KV, HEAD_DIM)
        kp = jnp.pad(k, ((0, 0), (lead_pad + BLOCK, 0), (0, 0), (0, 0))).reshape(B, nb + 1, BLOCK, N_KV_HEADS, HEAD_DIM)
        vp = jnp.pad(v, ((0, 0), (lead_pad + BLOCK, 0), (0, 0), (0, 0))).reshape(B, nb + 1, BLOCK, N_KV_HEADS, HEAD_DIM)
        kb = jnp.concatenate([kp[:, :-1], kp[:, 1:]], axis=2)
        vb = jnp.concatenate([vp[:, :-1], vp[:, 1:]], axis=2)
        dist = jnp.arange(BLOCK)[:, None] + BLOCK - jnp.arange(2 * BLOCK)[None, :]
        key_pos = (jnp.arange(nb)[:, None] * BLOCK + jnp.arange(2 * BLOCK)[None, :] - BLOCK - lead_pad)
        valid = jnp.where(key_pos >= 0, 0.0, NEG).astype(jnp.float32)
        bias = band_bias(dist, rel_bias)[None] + valid[:, None, None, None, :]
        attn_o = sink_attention(qb, kb, vb, bias, sinks).reshape(
            B, nb * BLOCK, N_KV_HEADS, Q_PER_KV, HEAD_DIM)[:, lead_pad:]
        c = jnp.pad(glu, ((0, 0), (CONV_W - 1, 0), (0, 0)))
        conv_o = conv_branch(c, w_dw, b_dw, conv_ln_g, conv_ln_b, w_conv_out)
        h2 = post_mix(h, attn_o, conv_o, ga, gc, w_attn_out, w_out)
        x = h2 + 0.5 * swiglu_ffn(h2, ffn2_norm, ffn2_w1, ffn2_w3, ffn2_w2)
        new_k_prompt = k[:, L - WINDOW:]
        new_v_prompt = v[:, L - WINDOW:]
        new_conv_prompt = glu[:, L - (CONV_W - 1):]
    y_prompt = x[:, N_META:]

    xs = x_sample
    T = xs.shape[1]
    w_buf = cache_k.shape[1]
    for _ in range(DEPTH):
        h = xs + 0.5 * swiglu_ffn(xs, ffn1_norm, ffn1_w1, ffn1_w3, ffn1_w2)
        q, k, v, glu, ga, gc = pre_mix(h, mix_norm, w_in, q_norm, k_norm)
        k_all = jnp.concatenate([cache_k.astype(k.dtype), k], axis=1)
        v_all = jnp.concatenate([cache_v.astype(v.dtype), v], axis=1)
        dist = jnp.arange(T)[:, None] + w_buf - jnp.arange(w_buf + T)[None, :]
        attn_o = sink_attention(q, k_all, v_all, band_bias(dist, rel_bias), sinks)
        c = jnp.concatenate([state_conv.astype(glu.dtype), glu], axis=1)
        conv_o = conv_branch(c, w_dw, b_dw, conv_ln_g, conv_ln_b, w_conv_out)
        h2 = post_mix(h, attn_o, conv_o, ga, gc, w_attn_out, w_out)
        xs = h2 + 0.5 * swiglu_ffn(h2, ffn2_norm, ffn2_w1, ffn2_w3, ffn2_w2)
        new_k_sample = k_all[:, T:]
        new_v_sample = v_all[:, T:]
        new_conv_sample = c[:, T:]
    y_sample = xs

    return (y_prompt, y_sample, new_k_prompt, new_v_prompt, new_conv_prompt,
            new_k_sample, new_v_sample, new_conv_sample)
```

```cpp
#define MK_SPLIT 0
#include <hip/hip_runtime.h>
#include <cstdio>
#include <cstdint>

constexpr int NWAVES = 8;
#ifndef MK_SPLIT
#define MK_SPLIT 0
#endif
constexpr int N_PHASES = 9;

constexpr int D = 1024, DFF = 2816, SEQ = 8192, NPROMPT = 16384, R_META = 16384, R_SAMPLE = 16400, R_END = 16528, MP = 16640, NTM = 65;
constexpr int NIN = 3840;
constexpr float EPS = 1e-6f;
constexpr size_t O_Y = 0, O_YS = 16777216, O_NKP = 16908288, O_NVP = 16941056, O_NCP = 16973824, O_NKS = 17004544, O_NVS = 19101696, O_NCS = 21198848;

constexpr size_t MiB = 1u << 20;
constexpr size_t WS_CTL = 0, CTL_ZERO_BYTES = 1 * MiB;
constexpr size_t WS_HSIDE = 1 * MiB;
constexpr size_t WS_W13A = 2 * MiB, WS_W2A = 13 * MiB, WS_WIN = 19 * MiB, WS_WMIX = 27 * MiB, WS_WOUT = 29 * MiB, WS_W13B = 31 * MiB, WS_W2B = 42 * MiB;
constexpr size_t WS_R1 = 48 * MiB;
constexpr size_t WS_R2 = 81 * MiB;
constexpr size_t WS_R3 = 171 * MiB;
constexpr size_t SZ_ROWS1K = (size_t)MP * 1024 * 2;
constexpr size_t WS_GA = WS_R2, WS_GC = WS_R2 + SZ_ROWS1K;
constexpr size_t WS_QB = WS_R3, WS_KB = WS_QB + (size_t)MP * 512 * 2, WS_VB = WS_KB + (size_t)MP * 128 * 2, WS_GLU = WS_VB + (size_t)MP * 128 * 2;
constexpr size_t WS_MIXB = WS_R3, WS_MIX = WS_R3 + 41 * MiB;
constexpr size_t WS_END = 256 * MiB;
static_assert(WS_W2B + (size_t)1024 * 2816 * 2 <= WS_R1 && WS_R1 + SZ_ROWS1K <= WS_R2 && WS_R2 + (size_t)MP * 2816 * 2 <= WS_R3 && WS_GC + SZ_ROWS1K <= WS_R3, "ws map 1");
static_assert(WS_GLU + (size_t)MP * 512 * 2 <= WS_MIX && WS_MIXB + SZ_ROWS1K <= WS_MIX && WS_MIX + SZ_ROWS1K <= WS_END, "ws map 2");
constexpr int CW_TMO = 0;
constexpr int CW_BAR = 4096;
constexpr int CW_SS1 = 32768, CW_SS2 = CW_SS1 + MP, CW_SS3 = CW_SS2 + MP;
static_assert((CW_SS3 + MP) * 4 <= (int)CTL_ZERO_BYTES, "ctl");

constexpr int RING_BYTES = 131072, LDSCTL_OFF = 159744, MISC_OFF = LDSCTL_OFF + 320, LDS_BYTES = 163840;

#define GAS __attribute__((address_space(1)))
#define LAS __attribute__((address_space(3)))
typedef unsigned short bf16;
typedef unsigned v4u __attribute__((ext_vector_type(4)));
typedef unsigned v2u __attribute__((ext_vector_type(2)));
typedef float f32x4 __attribute__((ext_vector_type(4)));
typedef float f32x16 __attribute__((ext_vector_type(16)));
typedef short bf16x8 __attribute__((ext_vector_type(8)));
typedef GAS unsigned gu32;
#define RLX_AGENT __ATOMIC_RELAXED, __HIP_MEMORY_SCOPE_AGENT
#define LDS_WAIT() asm volatile("s_waitcnt lgkmcnt(0)" ::: "memory")
#define VM_WAIT() asm volatile("s_waitcnt vmcnt(0)" ::: "memory")
__device__ __forceinline__ unsigned f2bf(float f) { unsigned u = __builtin_bit_cast(unsigned, f); return (u + 0x7fffu + ((u >> 16) & 1u)) >> 16; }
__device__ __forceinline__ unsigned pk2(float lo, float hi) { return f2bf(lo) | (f2bf(hi) << 16); }
__device__ __forceinline__ float bf2f(unsigned short h) { return __uint_as_float((unsigned)h << 16); }
#ifndef PG8_WGM
#define PG8_WGM 8
#endif
namespace pg8 {
#define PG8_LAS __attribute__((address_space(3)))
typedef unsigned short bf16_t;
typedef short bf16x8 __attribute__((ext_vector_type(8)));
typedef float f32x4 __attribute__((ext_vector_type(4)));
typedef unsigned u32x4 __attribute__((ext_vector_type(4)));
constexpr int BM = 256, BK = 64, HALF = 128, HTB = HALF * BK * 2  , STAGE_BYTES = 8 * HTB, NXCD = 8, WGM = PG8_WGM;

__host__ __device__ __forceinline__ int lds_byte(int r, int c) { const int st = (r >> 4) * 2 + (c >> 5), rr = r & 15, cc = c & 31, ob = rr * 64 + cc * 2; return st * 1024 + (ob ^ (((ob >> 9) & 1) << 5)); }
__host__ __device__ __forceinline__ void stage_rc(int b, int& R, int& C) { const int st = b / 1024, sb = b % 1024, swz = sb ^ (((sb >> 9) & 1) << 5); R = (st >> 1) * 16 + swz / 64; C = (st & 1) * 32 + (swz % 64) / 2; }
__host__ __device__ __forceinline__ int perm32(int rho) { const int n = rho >> 4, i = rho & 15; return 8 * (i >> 2) + 4 * n + (i & 3); }

struct Unit { int pm, pn; };
struct Gemm { const bf16_t* A; const bf16_t* Bt; int M, N, K; };

struct StaticOrder {
    int nM, nN, nwg, G, c;
    __host__ __device__ void init(int M, int N, int G_, int c_) { nM = M / BM; nN = N / BM; nwg = nM * nN; G = G_; c = c_; }
    __host__ __device__ bool next(int i, Unit& u) const {
        const long L = (long)i * G + c; if (L >= nwg) return false;
        int wgid = (int)L; { const int q = nwg / NXCD, r = nwg % NXCD, xcd = wgid % NXCD, off = wgid / NXCD; wgid = (xcd < r ? xcd * (q + 1) : r * (q + 1) + (xcd - r) * q) + off; }
        const int nig = WGM * nN, gid = wgid / nig, fm = gid * WGM, gsz = (nM - fm) < WGM ? (nM - fm) : WGM;
        u.pm = fm + ((wgid % nig) % gsz); u.pn = (wgid % nig) / gsz; return true;
    }
    __device__ __forceinline__ void a_ready(const Unit&) const {}
    __device__ __forceinline__ void done(const Unit&) const {}
};
typedef float f32x2 __attribute__((ext_vector_type(2)));
typedef __bf16 bf16x2_t __attribute__((ext_vector_type(2)));
__device__ __forceinline__ unsigned cvt_pk_bf16(float lo, float hi) { const f32x2 v = {lo, hi}; const bf16x2_t b = __builtin_convertvector(v, bf16x2_t); return __builtin_bit_cast(unsigned, b); }

constexpr int ROWS_PROMPT = 16384, ROW_META = 16384, ROW_SAMPLE = 16400, ROW_END = 16528, MPAD = 16640, DM = 1024;
constexpr float LOG2E = 1.4426950408889634f;
__device__ __forceinline__ float fast_sigmoid(float x) { return __builtin_amdgcn_rcpf(1.0f + __builtin_amdgcn_exp2f(-x * LOG2E)); }
__device__ __forceinline__ u32x4 pack8(const f32x4& a, const f32x4& b) { u32x4 w; w.x = cvt_pk_bf16(a[0], a[1]); w.y = cvt_pk_bf16(a[2], a[3]); w.z = cvt_pk_bf16(b[0], b[1]); w.w = cvt_pk_bf16(b[2], b[3]); return w; }
#ifndef NT_RES
#define NT_RES 0
#endif
#ifndef NT_Y
#define NT_Y 1
#endif
#if NT_RES
#define RES_LOAD(p) __builtin_nontemporal_load(p)
#else
#define RES_LOAD(p) (*(p))
#endif
#if NT_Y
#define Y_STORE(v, p) __builtin_nontemporal_store((v), (p))
#else
#define Y_STORE(v, p) (*(p) = (v))
#endif
#ifndef MK_WT
#define MK_WT 16
#endif
__device__ __forceinline__ __amdgpu_buffer_rsrc_t mkrsrc(const void* p) { return __builtin_amdgcn_make_buffer_rsrc((void*)p, 0, 0x10000000, 0x00020000); }
#define ST16(rsrc, byteoff, v) __builtin_amdgcn_raw_buffer_store_b128((v), (rsrc), (unsigned)(byteoff), 0, MK_WT)
#ifndef MK_WT_MULTI
#define MK_WT_MULTI 0
#endif
#define ST16M(rsrc, byteoff, v) __builtin_amdgcn_raw_buffer_store_b128((v), (rsrc), (unsigned)(byteoff), 0, MK_WT_MULTI)
__device__ __forceinline__ float sum4(const f32x4& a) { return (a[0] + a[1]) + (a[2] + a[3]); }
__device__ __forceinline__ float sumsq4(const f32x4& a) { return (a[0] * a[0] + a[1] * a[1]) + (a[2] * a[2] + a[3] * a[3]); }

struct EpiUp {
    static constexpr bool PERM = true, AFTER_DRAIN = false; static constexpr int MID_T = 0;
    bf16_t* O; int ldc; const float* ss;
    __device__ __forceinline__ void operator()(const f32x4 (&acc)[2][2][4][2], const Unit& u, int wr, int wc, int fr, int fq) const {
        const int row0 = u.pm * BM + wr * 64 + fr, col0 = u.pn * 128 + wc * 32 + 8 * fq;
        const __amdgpu_buffer_rsrc_t rs = mkrsrc(O);
        float sv[2][4];
#pragma unroll
        for (int ai = 0; ai < 2; ++ai)
#pragma unroll
            for (int m = 0; m < 4; ++m) sv[ai][m] = ss[row0 + ai * HALF + m * 16];
#pragma unroll
        for (int ai = 0; ai < 2; ++ai)
#pragma unroll
            for (int m = 0; m < 4; ++m) {
                const int row = row0 + ai * HALF + m * 16;
                const float is2 = sv[ai][m] * (1.0f / 1024.0f) + 1e-6f;
                const float s = __builtin_amdgcn_rsqf(is2);
                const float c = -s * LOG2E;
                f32x4 o[2];
#pragma unroll
                for (int n = 0; n < 2; ++n)
#pragma unroll
                    for (int j = 0; j < 4; j += 2) {
                        const f32x2 g = {acc[ai][0][m][n][j], acc[ai][0][m][n][j + 1]}, up = {acc[ai][1][m][n][j], acc[ai][1][m][n][j + 1]};
                        const f32x2 t = g * c; f32x2 e; e.x = __builtin_amdgcn_exp2f(t.x); e.y = __builtin_amdgcn_exp2f(t.y);
                        const f32x2 d = e * is2 + is2; f32x2 r; r.x = __builtin_amdgcn_rcpf(d.x); r.y = __builtin_amdgcn_rcpf(d.y);
                        const f32x2 v = (g * up) * r;
                        o[n][j] = v.x; o[n][j + 1] = v.y;
                    }
                ST16M(rs, ((size_t)row * ldc + col0) * 2, pack8(o[0], o[1]));
            }
    }
};

template <int MODE> struct EpiRes {
    static constexpr bool PERM = true, AFTER_DRAIN = false; static constexpr int MID_T = 0;
    const float* xf; const bf16_t* xb; float* outy; bf16_t* ob; float* ss;
    __device__ __forceinline__ void operator()(const f32x4 (&acc)[2][2][4][2], const Unit& u, int wr, int wc, int fr, int fq) const {
        const int row0 = u.pm * BM + wr * 64 + fr, col0 = u.pn * BM + wc * 32 + 8 * fq;
        const float alpha = (MODE == 1) ? 1.0f : 0.5f;
        const __amdgpu_buffer_rsrc_t rs = mkrsrc(ob);
#pragma unroll
        for (int ai = 0; ai < 2; ++ai) {
            u32x4 rw[4][2];
#pragma unroll
            for (int m = 0; m < 4; ++m)
#pragma unroll
                for (int bj = 0; bj < 2; ++bj) rw[m][bj] = RES_LOAD((const u32x4*)(xb + (size_t)(row0 + ai * HALF + m * 16) * DM + col0 + bj * HALF));
            float parts[4];
#pragma unroll
            for (int m = 0; m < 4; ++m) {
                const size_t off = (size_t)(row0 + ai * HALF + m * 16) * DM + col0;
                float part = 0.f;
#pragma unroll
                for (int bj = 0; bj < 2; ++bj) {
                    const u32x4 w = rw[m][bj];
                    const f32x4 r0 = (f32x4){__uint_as_float(w.x << 16), __uint_as_float(w.x & 0xffff0000u), __uint_as_float(w.y << 16), __uint_as_float(w.y & 0xffff0000u)};
                    const f32x4 r1 = (f32x4){__uint_as_float(w.z << 16), __uint_as_float(w.z & 0xffff0000u), __uint_as_float(w.w << 16), __uint_as_float(w.w & 0xffff0000u)};
                    const f32x4 o0 = r0 + acc[ai][bj][m][0] * alpha, o1 = r1 + acc[ai][bj][m][1] * alpha;
                    if (MODE == 2) { Y_STORE(o0, (f32x4*)(outy + off + bj * HALF)); Y_STORE(o1, (f32x4*)(outy + off + bj * HALF + 4)); }
                    else { ST16(rs, (off + bj * HALF) * 2, pack8(o0, o1)); part += sumsq4(o0) + sumsq4(o1); }
                }
                if (MODE != 2) { part += __shfl_xor(part, 16); part += __shfl_xor(part, 32); }
                parts[m] = part;
            }
            if (MODE != 2 && ss) { const float mine = fq == 0 ? parts[0] : fq == 1 ? parts[1] : fq == 2 ? parts[2] : parts[3];
                atomicAdd(ss + (u.pm * BM + ai * HALF + wr * 64 + 16 * fq + fr), mine); }
        }
    }
};

struct EpiWin {
    static constexpr bool PERM = true, AFTER_DRAIN = false; static constexpr int MID_T = 0;
    const float* ss; const float *qn, *kn; unsigned char* ws; float* out;
    static constexpr size_t O_NKP = 16908288, O_NVP = 16941056, O_NCP = 16973824, O_NKS = 17004544, O_NVS = 19101696, O_NCS = 21198848;
    __device__ __forceinline__ void operator()(const f32x4 (&acc)[2][2][4][2], const Unit& u, int wr, int wc, int fr, int fq) const {
        const int row0 = u.pm * BM + wr * 64 + fr; const int pn = u.pn;
        const __amdgpu_buffer_rsrc_t rs = mkrsrc(ws);
        const bool side_rows = (u.pm == 31 || u.pm == 63 || u.pm == 64);
        float sv[2][4];
#pragma unroll
        for (int ai = 0; ai < 2; ++ai)
#pragma unroll
            for (int m = 0; m < 4; ++m) sv[ai][m] = ss[row0 + ai * HALF + m * 16];
#pragma unroll
        for (int ai = 0; ai < 2; ++ai)
#pragma unroll
            for (int m = 0; m < 4; ++m) {
                const int row = row0 + ai * HALF + m * 16;
                const float s = __builtin_amdgcn_rsqf(sv[ai][m] * (1.0f / 1024.0f) + 1e-6f);
                const float cexp = -s * LOG2E;
                f32x4 v[2][2];
                if (pn < 7) {
#pragma unroll
                    for (int bj = 0; bj < 2; ++bj)
#pragma unroll
                        for (int n = 0; n < 2; ++n) v[bj][n] = acc[ai][bj][m][n] * ((pn >= 3 && bj == 1) ? cexp : s);
                }
                if (pn < 3) {
                    const bool isv = (pn == 2 && wc >= 2), isq = (pn < 2);
                    if (!isv) {
                        float q = (sumsq4(v[0][0]) + sumsq4(v[0][1])) + (sumsq4(v[1][0]) + sumsq4(v[1][1]));
                        q += __shfl_xor(q, 16); q += __shfl_xor(q, 32);
                        const float r = __builtin_amdgcn_rsqf(q * (1.0f / 64.0f) + 1e-6f) * (isq ? 0.125f : 1.0f);
                        const float* gn = isq ? qn : kn;
#pragma unroll
                        for (int bj = 0; bj < 2; ++bj)
#pragma unroll
                            for (int n = 0; n < 2; ++n) { const f32x4 gv = *(const f32x4*)(gn + 32 * bj + 8 * fq + 4 * n); v[bj][n] = v[bj][n] * r * gv; }
                    }
                    size_t obase; int ocol; int ld;
                    if (isq) { obase = WS_QB; ld = 512; ocol = (4 * pn + wc) * 64; } else if (!isv) { obase = WS_KB; ld = 128; ocol = wc * 64; } else { obase = WS_VB; ld = 128; ocol = (wc - 2) * 64; }
#pragma unroll
                    for (int bj = 0; bj < 2; ++bj) ST16M(rs, obase + ((size_t)row * ld + ocol + 32 * bj + 8 * fq) * 2, pack8(v[bj][0], v[bj][1]));
                    if (!isq && side_rows) {
                        float* o = nullptr; const int kvh = isv ? wc - 2 : wc;
                        if (row < ROWS_PROMPT) { const int b = row >> 13, t = row & 8191; if (t >= 8064) o = out + (isv ? O_NVP : O_NKP) + (size_t)((b * 128 + (t - 8064)) * 2 + kvh) * 64; }
                        else if (row >= ROW_SAMPLE && row < ROW_END) o = out + (isv ? O_NVS : O_NKS) + (size_t)(((row - ROW_SAMPLE) * 128 + 127) * 2 + kvh) * 64;
                        if (o) {
#pragma unroll
                            for (int bj = 0; bj < 2; ++bj)
#pragma unroll
                                for (int n = 0; n < 2; ++n) *(f32x4*)(o + 32 * bj + 8 * fq + 4 * n) = v[bj][n];
                        }
                    }
                } else if (pn < 7) {
                    const int ch = 128 * (pn - 3) + 32 * wc + 8 * fq;
                    f32x4 g[2];
#pragma unroll
                    for (int n = 0; n < 2; ++n)
#pragma unroll
                        for (int j = 0; j < 4; ++j) g[n][j] = v[0][n][j] * __builtin_amdgcn_rcpf(1.0f + __builtin_amdgcn_exp2f(v[1][n][j]));
                    ST16M(rs, WS_GLU + ((size_t)row * 512 + ch) * 2, pack8(g[0], g[1]));
                    if (side_rows) {
                        float* o = nullptr;
                        if (row < ROWS_PROMPT) { const int b = row >> 13, t = row & 8191; if (t >= 8162) o = out + O_NCP + (size_t)(b * 30 + (t - 8162)) * 512; }
                        else if (row >= ROW_SAMPLE && row < ROW_END) o = out + O_NCS + (size_t)((row - ROW_SAMPLE) * 30 + 29) * 512;
                        if (o) { *(f32x4*)(o + ch) = g[0]; *(f32x4*)(o + ch + 4) = g[1]; }
                    }
                } else {
                    const size_t obase = pn < 11 ? WS_GA : WS_GC; const int col = 256 * (pn < 11 ? pn - 7 : pn - 11) + 32 * wc + 8 * fq;
#pragma unroll
                    for (int bj = 0; bj < 2; ++bj) {
                        f32x4 g[2];
#pragma unroll
                        for (int n = 0; n < 2; ++n)
#pragma unroll
                            for (int j = 0; j < 4; ++j) g[n][j] = __builtin_amdgcn_rcpf(1.0f + __builtin_amdgcn_exp2f(acc[ai][bj][m][n][j] * cexp));
                        ST16M(rs, obase + ((size_t)row * DM + col + bj * HALF) * 2, pack8(g[0], g[1]));
                    }
                }
            }
    }
};

struct EpiMix {
    static constexpr bool PERM = true, AFTER_DRAIN = false; static constexpr int MID_T = 8;
    const bf16_t *GA, *GC; bf16_t* MIXB;
    static __device__ __forceinline__ void unpack8(const u32x4& w, f32x4& a, f32x4& b) {
        a = (f32x4){__uint_as_float(w.x << 16), __uint_as_float(w.x & 0xffff0000u), __uint_as_float(w.y << 16), __uint_as_float(w.y & 0xffff0000u)};
        b = (f32x4){__uint_as_float(w.z << 16), __uint_as_float(w.z & 0xffff0000u), __uint_as_float(w.w << 16), __uint_as_float(w.w & 0xffff0000u)}; }
    __device__ __forceinline__ void mid(f32x4 (&acc)[2][2][4][2], const Unit& u, int wr, int wc, int fr, int fq) const {
        int lo = (u.pm * BM + wr * 64 + fr) * DM + u.pn * BM + wc * 32 + 8 * fq;
        asm volatile("" : "+v"(lo));
#pragma unroll
        for (int ai = 0; ai < 2; ++ai)
#pragma unroll
            for (int m = 0; m < 4; ++m) {
                const size_t off = (size_t)(unsigned)(lo + (ai * HALF + m * 16) * DM);
#pragma unroll
                for (int bj = 0; bj < 2; ++bj) {
                    const u32x4 gaw = *(const u32x4*)(GA + off + bj * HALF), gcw = *(const u32x4*)(GC + off + bj * HALF);
                    f32x4 a0, a1, c0, c1; unpack8(gaw, a0, a1); unpack8(gcw, c0, c1);
#pragma unroll
                    for (int j = 0; j < 4; ++j) { acc[ai][bj][m][0][j] *= a0[j] * __builtin_amdgcn_rcpf(c0[j]); acc[ai][bj][m][1][j] *= a1[j] * __builtin_amdgcn_rcpf(c1[j]); }
                }
                if (m & 1) { asm volatile("" ::: "memory"); __builtin_amdgcn_sched_barrier(0); }
            }
    }
    __device__ __forceinline__ void operator()(const f32x4 (&acc)[2][2][4][2], const Unit& u, int wr, int wc, int fr, int fq) const {
        int lo = (u.pm * BM + wr * 64 + fr) * DM + u.pn * BM + wc * 32 + 8 * fq;
        asm volatile("" : "+v"(lo));
        const __amdgpu_buffer_rsrc_t rs = mkrsrc(MIXB);
#pragma unroll
        for (int ai = 0; ai < 2; ++ai) {
            u32x4 gw[4][2];
#pragma unroll
            for (int m = 0; m < 4; ++m)
#pragma unroll
                for (int bj = 0; bj < 2; ++bj) gw[m][bj] = *(const u32x4*)(GC + (size_t)(unsigned)(lo + (ai * HALF + m * 16) * DM) + bj * HALF);
#pragma unroll
            for (int m = 0; m < 4; ++m) {
                const size_t off = (size_t)(unsigned)(lo + (ai * HALF + m * 16) * DM);
#pragma unroll
                for (int bj = 0; bj < 2; ++bj) {
                    f32x4 c0, c1; unpack8(gw[m][bj], c0, c1);
                    ST16(rs, (off + bj * HALF) * 2, pack8(acc[ai][bj][m][0] * c0, acc[ai][bj][m][1] * c1));
                }
            }
        }
    }
};
struct EpiNull {
    static constexpr bool PERM = true, AFTER_DRAIN = false; static constexpr int MID_T = 0;
    float* sink;
    __device__ __forceinline__ void operator()(const f32x4 (&acc)[2][2][4][2], const Unit& u, int wr, int wc, int fr, int fq) const {
        float s = 0.f;
#pragma unroll
        for (int ai = 0; ai < 2; ++ai)
#pragma unroll
            for (int bj = 0; bj < 2; ++bj)
#pragma unroll
                for (int m = 0; m < 4; ++m)
#pragma unroll
                    for (int n = 0; n < 2; ++n) s += sum4(acc[ai][bj][m][n]);
        if (s == 1.2345e38f) sink[0] = s;
    }
};
struct NoPost { __device__ __forceinline__ void operator()() const {} };
template <class Epi, class Sched, bool ALIGN_EPI = false, bool SP2 = false, class Post = NoPost, int AUX_A = 0>
__device__ __forceinline__ void gemm_phase(PG8_LAS unsigned char* lds, const Gemm g, const Sched& S, const Epi& E, const Post& post = Post()) {
    const int tid = threadIdx.x, wid = __builtin_amdgcn_readfirstlane(tid >> 6), lane = tid & 63, wr = wid >> 2, wc = wid & 3, fr = lane & 15, fq = lane >> 4;
    const int K = g.K, nt = K / BK;
    unsigned voffA[2], voffB[2];
#pragma unroll
    for (int i = 0; i < 2; ++i) { int R, C; stage_rc(tid * 16 + i * 8192, R, C); const int Rb = Epi::PERM ? ((R & ~31) + perm32(R & 31)) : R;
        voffA[i] = (unsigned)(R * K + C) * 2u; voffB[i] = (unsigned)(Rb * K + C) * 2u; }
    const size_t kstep = (size_t)(BK * 2);
    const size_t hstep = (size_t)HALF * K * 2;
    const size_t tstep = 2 * hstep;
    const unsigned ldsw = (unsigned)wid * 1024u;
    const int aoff = lds_byte(wr * 64 + fr, fq * 8), boff = lds_byte(wc * 32 + fr, fq * 8);
#define PG8_SA(b, h) (((b) * 2 + (h)) * HTB)
#define PG8_SB(b, h) ((4 + (b) * 2 + (h)) * HTB)
#define PG8_STAGE(bufoff, gbase, voff) do { _Pragma("unroll") for (int _i = 0; _i < 2; ++_i) { \
        if (AUX_A == 2 && (const void*)(voff) == (const void*)voffA) __builtin_amdgcn_global_load_lds((const unsigned*)((const char*)(gbase) + (voff)[_i]), (PG8_LAS unsigned*)(lds + (bufoff) + ldsw + _i * 8192), 16, 0, 2); \
        else __builtin_amdgcn_global_load_lds((const unsigned*)((const char*)(gbase) + (voff)[_i]), (PG8_LAS unsigned*)(lds + (bufoff) + ldsw + _i * 8192), 16, 0, 0); } } while (0)
#define PG8_LDA(dst, b, h) do { _Pragma("unroll") for (int m = 0; m < 4; ++m) _Pragma("unroll") for (int k = 0; k < 2; ++k) dst[m][k] = *(const PG8_LAS bf16x8*)(lds + PG8_SA(b, h) + aoff + m * 2048 + k * 1024); } while (0)
#define PG8_LDB(dst, b, h) do { _Pragma("unroll") for (int n = 0; n < 2; ++n) _Pragma("unroll") for (int k = 0; k < 2; ++k) dst[n][k] = *(const PG8_LAS bf16x8*)(lds + PG8_SB(b, h) + boff + n * 2048 + k * 1024); } while (0)
#define PG8_MMA(ai, bj, At, Bt) do { __builtin_amdgcn_s_setprio(1); _Pragma("unroll") for (int m = 0; m < 4; ++m) _Pragma("unroll") for (int n = 0; n < 2; ++n) _Pragma("unroll") for (int k = 0; k < 2; ++k) \
        acc[ai][bj][m][n] = __builtin_amdgcn_mfma_f32_16x16x32_bf16(Bt[n][k], At[m][k], acc[ai][bj][m][n], 0, 0, 0); __builtin_amdgcn_s_setprio(0); } while (0)
#define PG8_WAIT_V(n) asm volatile("s_waitcnt vmcnt(" #n ")" ::: "memory")
#define PG8_WAIT_L(n) asm volatile("s_waitcnt lgkmcnt(" #n ")" ::: "memory")
#define PG8_BAR __builtin_amdgcn_s_barrier()
#define PG8_SCHED __builtin_amdgcn_sched_barrier(0)
    Unit cur, nxt; int ui = 0;
    if (!S.next(0, cur)) return;
    f32x4 acc[2][2][4][2];
#pragma unroll
    for (int a = 0; a < 2; ++a)
#pragma unroll
        for (int b = 0; b < 2; ++b)
#pragma unroll
            for (int m = 0; m < 4; ++m)
#pragma unroll
                for (int n = 0; n < 2; ++n) acc[a][b][m][n] = (f32x4){0.f, 0.f, 0.f, 0.f};
    bf16x8 At[4][2], B0[2][2], B1[2][2];
    const char* cA = (const char*)g.A + (size_t)cur.pm * tstep; const char* cB = (const char*)g.Bt + (size_t)cur.pn * tstep;
    S.a_ready(cur);
    if constexpr (SP2) {
        PG8_STAGE(PG8_SB(0, 0), cB, voffB); PG8_STAGE(PG8_SB(0, 1), cB + hstep, voffB); PG8_STAGE(PG8_SA(0, 0), cA, voffA); PG8_STAGE(PG8_SA(0, 1), cA + hstep, voffA);
        if (wr == 1) PG8_BAR;
        PG8_WAIT_V(2); PG8_BAR;
        PG8_STAGE(PG8_SB(1, 0), cB + kstep, voffB); PG8_STAGE(PG8_SA(1, 0), cA + kstep, voffA); PG8_STAGE(PG8_SB(1, 1), cB + hstep + kstep, voffB);
        PG8_WAIT_V(6); PG8_BAR;
    } else {
        PG8_STAGE(PG8_SB(0, 0), cB, voffB); PG8_STAGE(PG8_SA(0, 0), cA, voffA); PG8_STAGE(PG8_SB(0, 1), cB + hstep, voffB); PG8_STAGE(PG8_SA(0, 1), cA + hstep, voffA);
        if (wr == 1) PG8_BAR;
        PG8_WAIT_V(4); PG8_BAR;
        PG8_STAGE(PG8_SB(1, 0), cB + kstep, voffB); PG8_STAGE(PG8_SA(1, 0), cA + kstep, voffA); PG8_STAGE(PG8_SB(1, 1), cB + hstep + kstep, voffB);
        PG8_WAIT_V(6); PG8_BAR;
    }
    for (;;) {
        const bool has_next = S.next(ui + 1, nxt);
        const char* nA = has_next ? (const char*)g.A + (size_t)nxt.pm * tstep : cA; const char* nB = has_next ? (const char*)g.Bt + (size_t)nxt.pn * tstep : cB;
        for (int t = 0; t < nt; t += 2) {
            if constexpr (Epi::MID_T > 0) { if (t == Epi::MID_T) E.mid(acc, cur, wr, wc, fr, fq); }
            const bool last = (t == nt - 2);
            const char* a1 = cA + (size_t)(t + 1) * kstep;
            const char* a2 = last ? nA : cA + (size_t)(t + 2) * kstep; const char* b2 = last ? nB : cB + (size_t)(t + 2) * kstep;
            const char* a3 = a2 + kstep; const char* b3 = b2 + kstep;
            if (last && has_next) S.a_ready(nxt);
            if constexpr (SP2) {
            PG8_LDB(B0, 0, 0); PG8_LDB(B1, 0, 1); PG8_SCHED; PG8_LDA(At, 0, 0); PG8_STAGE(PG8_SA(1, 1), a1 + hstep, voffA);
            PG8_WAIT_V(8); PG8_WAIT_L(0); PG8_BAR; PG8_MMA(0, 0, At, B0); PG8_MMA(0, 1, At, B1); PG8_BAR; PG8_SCHED;
            PG8_LDA(At, 0, 1); PG8_STAGE(PG8_SB(0, 0), b2, voffB); PG8_STAGE(PG8_SB(0, 1), b2 + hstep, voffB); PG8_STAGE(PG8_SA(0, 0), a2, voffA);
            PG8_WAIT_V(8); PG8_WAIT_L(0); PG8_BAR; PG8_MMA(1, 0, At, B0); PG8_MMA(1, 1, At, B1); PG8_BAR; PG8_SCHED;
            PG8_LDB(B0, 1, 0); PG8_LDB(B1, 1, 1); PG8_SCHED; PG8_LDA(At, 1, 0); PG8_STAGE(PG8_SA(0, 1), a2 + hstep, voffA);
            PG8_WAIT_V(8); PG8_WAIT_L(0); PG8_BAR; PG8_MMA(0, 0, At, B0); PG8_MMA(0, 1, At, B1); PG8_BAR; PG8_SCHED;
            PG8_LDA(At, 1, 1); PG8_STAGE(PG8_SB(1, 0), b3, voffB); PG8_STAGE(PG8_SB(1, 1), b3 + hstep, voffB); PG8_STAGE(PG8_SA(1, 0), a3, voffA);
            PG8_WAIT_V(8); PG8_WAIT_L(0); PG8_BAR; PG8_MMA(1, 0, At, B0); PG8_MMA(1, 1, At, B1); PG8_BAR; PG8_SCHED;
            } else {
            PG8_LDB(B0, 0, 0); PG8_SCHED; PG8_LDA(At, 0, 0); PG8_STAGE(PG8_SA(1, 1), a1 + hstep, voffA);
            PG8_WAIT_L(8); PG8_BAR; PG8_WAIT_L(0); PG8_MMA(0, 0, At, B0); PG8_BAR; PG8_SCHED;
            PG8_LDB(B1, 0, 1); PG8_STAGE(PG8_SB(0, 0), b2, voffB);
            PG8_BAR; PG8_WAIT_L(0); PG8_MMA(0, 1, At, B1); PG8_BAR;
            PG8_LDA(At, 0, 1); PG8_STAGE(PG8_SA(0, 0), a2, voffA);
            PG8_BAR; PG8_WAIT_L(0); PG8_MMA(1, 0, At, B0); PG8_BAR; PG8_SCHED;
            PG8_STAGE(PG8_SB(0, 1), b2 + hstep, voffB);
            PG8_WAIT_V(6); PG8_BAR; PG8_MMA(1, 1, At, B1); PG8_BAR;
            PG8_LDB(B0, 1, 0); PG8_SCHED; PG8_LDA(At, 1, 0); PG8_STAGE(PG8_SA(0, 1), a2 + hstep, voffA);
            PG8_WAIT_L(8); PG8_BAR; PG8_WAIT_L(0); PG8_MMA(0, 0, At, B0); PG8_BAR; PG8_SCHED;
            PG8_LDB(B1, 1, 1); PG8_STAGE(PG8_SB(1, 0), b3, voffB);
            PG8_BAR; PG8_WAIT_L(0); PG8_MMA(0, 1, At, B1); PG8_BAR;
            PG8_LDA(At, 1, 1); PG8_STAGE(PG8_SA(1, 0), a3, voffA);
            PG8_BAR; PG8_WAIT_L(0); PG8_MMA(1, 0, At, B0); PG8_BAR; PG8_SCHED;
            PG8_STAGE(PG8_SB(1, 1), b3 + hstep, voffB);
            PG8_WAIT_V(6); PG8_BAR; PG8_MMA(1, 1, At, B1); PG8_BAR;
            }
        }
        if constexpr (ALIGN_EPI) { if (wr == 0) PG8_BAR; }
        if constexpr (!Epi::AFTER_DRAIN) { E(acc, cur, wr, wc, fr, fq); S.done(cur); }
        if (!has_next) break;
#pragma unroll
        for (int a = 0; a < 2; ++a)
#pragma unroll
            for (int b = 0; b < 2; ++b)
#pragma unroll
                for (int m = 0; m < 4; ++m)
#pragma unroll
                    for (int n = 0; n < 2; ++n) acc[a][b][m][n] = (f32x4){0.f, 0.f, 0.f, 0.f};
        cur = nxt; cA = nA; cB = nB; ++ui;
        if constexpr (ALIGN_EPI) { if (wr == 1) PG8_BAR; }
    }
    if constexpr (ALIGN_EPI) post();
    PG8_WAIT_V(0);
    if constexpr (!ALIGN_EPI) { if (wr == 0) PG8_BAR; }
    PG8_BAR;
    if constexpr (Epi::AFTER_DRAIN) { E.fused(acc, cur, wr, wc, fr, fq, lds, wid, lane); S.done(cur); }
#undef PG8_SA
#undef PG8_SB
#undef PG8_STAGE
#undef PG8_LDA
#undef PG8_LDB
#undef PG8_MMA
#undef PG8_WAIT_V
#undef PG8_WAIT_L
#undef PG8_BAR
#undef PG8_SCHED
}
}
#define XB_TMO      128
#define XB_XCNT(j)  (256  + 64 * (j))
#define XB_XSUB(j)  (1280 + 64 * (j))
#define XB_XGEN(j)  (2304 + 64 * (j))
#define XB_TOP      3328
#define XB_TOPGEN   3392
#define XCD_BAR_WORDS 3456
#define XB_SPIN_CAP (1u << 18)

__device__ __forceinline__ unsigned xb_ld(unsigned* p)              { return __hip_atomic_load(p, __ATOMIC_RELAXED, __HIP_MEMORY_SCOPE_AGENT); }
__device__ __forceinline__ unsigned xb_add(unsigned* p, unsigned v) { return __hip_atomic_fetch_add(p, v, __ATOMIC_RELAXED, __HIP_MEMORY_SCOPE_AGENT); }
__device__ __forceinline__ unsigned xb_xcc_id() { return (unsigned)__builtin_amdgcn_s_getreg((3 << 11) | 20) & 0xFu; }
#define XB_SPIN(cond, bar) do { unsigned _sp = 0; while (cond) { __builtin_amdgcn_s_sleep(1); \
    if ((++_sp & 255u) == 0u) { if (xb_ld(&(bar)[XB_TMO])) break; if (_sp > XB_SPIN_CAP) { atomicAdd(&(bar)[XB_TMO], 1u); break; } } } } while (0)

struct XcdBarrier {
    unsigned* bar; unsigned x;
    volatile LAS unsigned* st;
};

__device__ __forceinline__ XcdBarrier xcd_barrier_post(unsigned* bar, volatile LAS unsigned* st) {
    XcdBarrier b; b.bar = bar; b.x = xb_xcc_id(); b.st = st;
    if (threadIdx.x == 0) (void)xb_add(&bar[XB_XCNT(b.x)], 1u);
    return b;
}
__device__ __forceinline__ void xcd_barrier_complete(unsigned* bar, unsigned x, unsigned& nloc, unsigned& nx) {
    const unsigned G = gridDim.x * gridDim.y * gridDim.z;
    unsigned sum, cnt, mine, sp = 0u;
    for (;;) {
        sum = 0u; cnt = 0u; mine = 0u;
#pragma unroll
        for (unsigned j = 0; j < 16; ++j) { const unsigned c = xb_ld(&bar[XB_XCNT(j)]); sum += c; cnt += (c > 0u) ? 1u : 0u; mine = (j == x) ? c : mine; }
        if (sum == G) break;
        __builtin_amdgcn_s_sleep(1);
        if ((++sp & 255u) == 0u) { if (xb_ld(&bar[XB_TMO])) break; if (sp > XB_SPIN_CAP) { atomicAdd(&bar[XB_TMO], 1u); break; } }
    }
    nloc = mine > 0u ? mine : 1u; nx = cnt > 0u ? cnt : 1u;
}

__device__ __forceinline__ void xcd_barrier(const XcdBarrier& b) {
    asm volatile("s_waitcnt vmcnt(0)" ::: "memory");
    __syncthreads();
    if (threadIdx.x == 0) {
        unsigned* bar = b.bar;
        __builtin_amdgcn_s_waitcnt(0);
        unsigned nloc = b.st[0], nx = b.st[1];
        if (nloc == 0u) { xcd_barrier_complete(bar, b.x, nloc, nx); b.st[0] = nloc; b.st[1] = nx; }
        const unsigned old = xb_add(&bar[XB_XSUB(b.x)], 1u);
        const unsigned gen = old / nloc;
        if (old + 1u == (gen + 1u) * nloc) {
            __builtin_amdgcn_fence(__ATOMIC_RELEASE, "agent");
            asm volatile("s_waitcnt vmcnt(0)" ::: "memory");
            const unsigned og = xb_add(&bar[XB_TOP], 1u);
            const unsigned tg = og / nx;
            if (og + 1u == (tg + 1u) * nx) xb_add(&bar[XB_TOPGEN], 1u);
            else XB_SPIN(xb_ld(&bar[XB_TOPGEN]) == tg, bar);
            __builtin_amdgcn_fence(__ATOMIC_ACQUIRE, "agent");
            xb_add(&bar[XB_XGEN(b.x)], 1u);
            asm volatile("s_waitcnt vmcnt(0)" ::: "memory");
        } else {
            XB_SPIN(xb_ld(&bar[XB_XGEN(b.x)]) == gen, bar);
            __builtin_amdgcn_fence(__ATOMIC_ACQUIRE, "agent");
            asm volatile("s_waitcnt vmcnt(0)" ::: "memory");
        }
    }
    __syncthreads();
}

struct Args {
    const float* in[27]; float* out; unsigned char* ws; int ph_lo, ph_hi;
};
struct Frame {
    LAS unsigned char* lds; volatile LAS unsigned* MISC; gu32* ctl;
    int tid, lane, wave, G;
};
__device__ __forceinline__ float wave_sum(float v) {
#pragma unroll
    for (int o = 1; o < 64; o <<= 1) v += __shfl_xor(v, o);
    return v;
}
__device__ __forceinline__ float wave_max(float v) {
#pragma unroll
    for (int o = 1; o < 64; o <<= 1) v = fmaxf(v, __shfl_xor(v, o));
    return v;
}

#ifndef MK_NT
#define MK_NT 1
#endif
#if MK_NT
#define NT_LOAD(p) __builtin_nontemporal_load(p)
#define NT_STORE(v, p) __builtin_nontemporal_store((v), (p))
#else
#define NT_LOAD(p) (*(p))
#define NT_STORE(v, p) (*(p) = (v))
#endif
__device__ __forceinline__ void p0_transpose_item(const float* W, int K, int N, const float* gain, bf16* WT, int k0, int n0, int dra, int drb, LAS float* scr, int lane) {
    const int lr = lane >> 4, lc = 4 * (lane & 15);
    f32x4 w[8];
#pragma unroll
    for (int i = 0; i < 8; ++i) w[i] = NT_LOAD((const GAS f32x4*)(W + (size_t)(k0 + 4 * i + lr) * N + n0 + lc));
    if (gain) {
#pragma unroll
        for (int i = 0; i < 8; ++i) w[i] = w[i] * gain[k0 + 4 * i + lr];
    }
#pragma unroll
    for (int i = 0; i < 8; ++i) { LAS float* d = scr + (4 * i + lr) * 65 + lc; d[0] = w[i].x; d[1] = w[i].y; d[2] = w[i].z; d[3] = w[i].w; }
    LDS_WAIT(); asm volatile("" ::: "memory");
    const int c = lane & 3;
#pragma unroll
    for (int j = 0; j < 4; ++j) { const int n = (lane >> 2) + 16 * j; const LAS float* s = scr + (8 * c) * 65 + n;
        v4u o; o.x = pk2(s[0 * 65], s[1 * 65]); o.y = pk2(s[2 * 65], s[3 * 65]); o.z = pk2(s[4 * 65], s[5 * 65]); o.w = pk2(s[6 * 65], s[7 * 65]);
        const int dr = (j < 2 ? dra : drb) + (n & 31);
        *(GAS v4u*)(WT + (size_t)dr * K + k0 + 8 * c) = o; }
    LDS_WAIT(); asm volatile("" ::: "memory");
}
__device__ __forceinline__ int win_dest_row(int n0) {
    if (n0 < 512) { const int head = n0 >> 6, d = n0 & 63; return 256 * (head >> 2) + 128 * (d >> 5) + 32 * (head & 3); }
    if (n0 < 640) { const int kvh = (n0 - 512) >> 6, d = n0 & 63; return 512 + 128 * (d >> 5) + 32 * kvh; }
    if (n0 < 768) { const int vh = (n0 - 640) >> 6, d = n0 & 63; return 512 + 128 * (d >> 5) + 32 * (2 + vh); }
    if (n0 < 1792) { const int which = (n0 - 768) >> 9, ch = (n0 - 768) & 511; return 256 * (3 + (ch >> 7)) + 128 * which + (ch & 127); }
    return n0;
}
__device__ __forceinline__ int ffn_dest_row(int j0, int which) { return 256 * (j0 >> 7) + 128 * which + (j0 & 127); }

constexpr int I_W1 = 32 * 44, I_W2 = 88 * 16, I_WIN = 32 * 60, I_AO = 16 * 16, I_WO = 32 * 16;
constexpr int P0_A0 = 0, P0_B0 = 2 * I_W1, P0_C0 = P0_B0 + I_W2 + I_WIN + 2 * I_AO + I_WO, P0_NITEMS = P0_C0 + 2 * I_W1 + I_W2;
constexpr int P0_C_P3 = 2750;
__device__ __forceinline__ void p0_items(Frame& F, const Args& a, int lo, int hi, int rank, int nworkers) {
    unsigned char* ws = a.ws;
    LAS float* scr = (LAS float*)(F.lds + F.wave * 16384);
    for (int it = lo + rank * NWAVES + F.wave; it < hi; it += nworkers * NWAVES) {
        int r = it;
        if (r < P0_B0 || r >= P0_C0) {
            const bool f = r >= P0_C0; if (f) r -= P0_C0;
            const float* gain = a.in[f ? 23 : 6]; bf16* W13 = (bf16*)(ws + (f ? WS_W13B : WS_W13A)); bf16* W2 = (bf16*)(ws + (f ? WS_W2B : WS_W2A));
            if (r < I_W1) { const int kb = r / 44, nb = r % 44; p0_transpose_item(a.in[f ? 24 : 7], D, DFF, gain, W13, 32 * kb, 64 * nb, ffn_dest_row(64 * nb, 0), ffn_dest_row(64 * nb + 32, 0), scr, F.lane); continue; } r -= I_W1;
            if (r < I_W1) { const int kb = r / 44, nb = r % 44; p0_transpose_item(a.in[f ? 25 : 8], D, DFF, gain, W13, 32 * kb, 64 * nb, ffn_dest_row(64 * nb, 1), ffn_dest_row(64 * nb + 32, 1), scr, F.lane); continue; } r -= I_W1;
            { const int kb = r / 16, nb = r % 16; p0_transpose_item(a.in[26], DFF, D, nullptr, W2, 32 * kb, 64 * nb, 64 * nb, 64 * nb + 32, scr, F.lane); continue; }
        }
        r -= P0_B0;
        if (r < I_W2) { const int kb = r / 16, nb = r % 16; p0_transpose_item(a.in[9], DFF, D, nullptr, (bf16*)(ws + WS_W2A), 32 * kb, 64 * nb, 64 * nb, 64 * nb + 32, scr, F.lane); continue; } r -= I_W2;
        if (r < I_WIN) { const int kb = r / 60, nb = r % 60; p0_transpose_item(a.in[11], D, NIN, a.in[10], (bf16*)(ws + WS_WIN), 32 * kb, 64 * nb, win_dest_row(64 * nb), win_dest_row(64 * nb + 32), scr, F.lane); continue; } r -= I_WIN;
        if (r < I_AO) { const int kb = r / 16, nb = r % 16; p0_transpose_item(a.in[16], 1024, D, nullptr, (bf16*)(ws + WS_WMIX), 32 * kb, 64 * nb, 64 * nb, 64 * nb + 32, scr, F.lane); continue; } r -= I_AO;
        if (r < I_AO) { const int kb = r / 16, nb = r % 16; p0_transpose_item(a.in[21], 1024, D, nullptr, (bf16*)(ws + WS_WMIX) + 512, 32 * kb, 64 * nb, 64 * nb, 64 * nb + 32, scr, F.lane); continue; } r -= I_AO;
        { const int kb = r / 16, nb = r % 16; p0_transpose_item(a.in[22], D, D, nullptr, (bf16*)(ws + WS_WOUT), 32 * kb, 64 * nb, 64 * nb, 64 * nb + 32, scr, F.lane); }
    }
}
__device__ __forceinline__ void p0_copies(Frame& F, const Args& a, int rank, int nworkers) {
    const int gt = rank * (NWAVES * 64) + F.tid, NGT = nworkers * NWAVES * 64;
    for (int i = gt; i < 128 * 4064; i += NGT) { const int s = i / 4064, e = i % 4064;
        NT_STORE(NT_LOAD(((const GAS f32x4*)(a.in[2] + (size_t)s * 16384 + 128)) + e), ((GAS f32x4*)(a.out + O_NKS + (size_t)s * 16384)) + e);
        NT_STORE(NT_LOAD(((const GAS f32x4*)(a.in[3] + (size_t)s * 16384 + 128)) + e), ((GAS f32x4*)(a.out + O_NVS + (size_t)s * 16384)) + e); }
    for (int i = gt; i < 128 * 3712; i += NGT) { const int s = i / 3712, e = i % 3712;
        NT_STORE(NT_LOAD(((const GAS f32x4*)(a.in[4] + (size_t)s * 15360 + 512)) + e), ((GAS f32x4*)(a.out + O_NCS + (size_t)s * 15360)) + e); }
}
__device__ __forceinline__ void p0_prologue(Frame& F, const Args& a) {
    unsigned char* ws = a.ws;
#ifdef P0_ZERO_OUT
    { GAS f32x4* o = (GAS f32x4*)a.out; for (size_t i = (size_t)blockIdx.x * 512 + F.tid; i < (size_t)23164928 / 4; i += (size_t)F.G * 512) o[i] = (f32x4){0.f, 0.f, 0.f, 0.f}; }
#endif
    LAS float* scr = (LAS float*)(F.lds + F.wave * 16384);
    const int gw = blockIdx.x * NWAVES + F.wave, NGW = F.G * NWAVES;
    p0_items(F, a, P0_A0, P0_B0, blockIdx.x, F.G);
    p0_items(F, a, P0_C0 + P0_C_P3, P0_NITEMS, blockIdx.x, F.G);
    bf16* XB = (bf16*)(ws + WS_R1); float* ss1 = (float*)(F.ctl + CW_SS1);
    for (int row = gw; row < MP; row += NGW) {
        const float* src = row < NPROMPT ? a.in[0] + (size_t)row * D : row < R_SAMPLE ? a.in[5] + (size_t)(row - R_META) * D : row < R_END ? a.in[1] + (size_t)(row - R_SAMPLE) * D : nullptr;
        f32x4 v[4]; float s = 0.f;
#pragma unroll
        for (int j = 0; j < 4; ++j) { v[j] = src ? NT_LOAD(((const GAS f32x4*)src) + F.lane + 64 * j) : (f32x4){0.f, 0.f, 0.f, 0.f}; s += (v[j].x * v[j].x + v[j].y * v[j].y) + (v[j].z * v[j].z + v[j].w * v[j].w); }
        s = wave_sum(s);
        GAS unsigned long long* o8 = (GAS unsigned long long*)(XB + (size_t)row * D) + F.lane;
#pragma unroll
        for (int j = 0; j < 4; ++j) o8[64 * j] = (unsigned long long)pk2(v[j].x, v[j].y) | ((unsigned long long)pk2(v[j].z, v[j].w) << 32);
        if (F.lane == 0) ss1[row] = s;
    }
}

constexpr int VT_STRIDE = 260;
constexpr int KS_STRIDE = 72;
constexpr int L4_VT = 0, L4_KS = 33792, L4_TAB = 131072, L4_Y = 0, L4_SMP = 137216, L4_WIN = 65536;
__device__ __forceinline__ int crow(int r, int hi) { return (r & 3) + 8 * (r >> 2) + 4 * hi; }
__device__ __forceinline__ int t5_bucket(int d) {
    if (d < 16) return d;
    int b = 16;
    b += (d >= 19); b += (d >= 21); b += (d >= 24); b += (d >= 27); b += (d >= 31); b += (d >= 35); b += (d >= 40); b += (d >= 46);
    b += (d >= 52); b += (d >= 59); b += (d >= 67); b += (d >= 77); b += (d >= 87); b += (d >= 99); b += (d >= 113);
    return b;
}
__device__ __forceinline__ int tok_row(int b, int t) { return t >= 0 ? b * SEQ + t : (t >= -16 ? R_META + 16 + t : -1); }

__device__ __forceinline__ void attn_unit(Frame& F, const Args& a, int b, int kvh, int jb) {
    const bf16* Qb = (const bf16*)(a.ws + WS_QB); const bf16* Kb = (const bf16*)(a.ws + WS_KB); const bf16* Vb = (const bf16*)(a.ws + WS_VB);
    bf16* AO = (bf16*)(a.ws + WS_R1);
    LAS bf16* Vt = (LAS bf16*)(F.lds + L4_VT); LAS bf16* Ks = (LAS bf16*)(F.lds + L4_KS); const LAS float* tab = (const LAS float*)(F.lds + L4_TAB);
    const int tid = F.tid, lane = F.lane, wid = F.wave, ql = lane & 31, hi = lane >> 5;
    const int tk0 = 128 * jb - 128;
    bf16x8 qfa[2][4];
    { const int hq_ = wid & 3, qh_ = wid >> 2;
#pragma unroll
      for (int qs = 0; qs < 2; ++qs)
#pragma unroll
        for (int s = 0; s < 4; ++s) qfa[qs][s] = *(const GAS bf16x8*)(Qb + ((size_t)b * SEQ + 128 * jb + 64 * qh_ + 32 * qs + ql) * 512 + (kvh * 4 + hq_) * 64 + 16 * s + 8 * hi); }
    for (int c = tid; c < 2048; c += NWAVES * 64) {
        const int kk = c >> 3, ch = c & 7; const int row = tok_row(b, tk0 + kk);
        const int rr = row >= 0 ? row : 0;
        v4u w = *(const GAS v4u*)(Vb + (size_t)rr * 128 + kvh * 64 + ch * 8), kw = *(const GAS v4u*)(Kb + (size_t)rr * 128 + kvh * 64 + ch * 8);
        if (row < 0) { w = (v4u){0u, 0u, 0u, 0u}; kw = w; }
        *(LAS v4u*)(Ks + kk * KS_STRIDE + ch * 8) = kw;
#pragma unroll
        for (int i = 0; i < 8; ++i) { const unsigned dw = w[i >> 1]; Vt[(ch * 8 + i) * VT_STRIDE + kk] = (bf16)((i & 1) ? (dw >> 16) : (dw & 0xffffu)); }
    }
    __syncthreads();
    const int hq = wid & 3, qh = wid >> 2, head = kvh * 4 + hq;
    const float sink = a.in[15][head];
#pragma unroll
    for (int qs = 0; qs < 2; ++qs) {
        const int tq = 128 * jb + 64 * qh + 32 * qs;
        const size_t rowq = (size_t)b * SEQ + tq + ql;
        bf16x8 qf[4];
#pragma unroll
        for (int s = 0; s < 4; ++s) qf[s] = qfa[qs][s];
        f32x16 S[5];
        float mx = -1e30f;
        const LAS float* tabq = tab + head * 192 + 1 + ql - 4 * hi;
#pragma unroll
        for (int kt = 0; kt < 5; ++kt) {
            const LAS bf16* kp = Ks + ((tq - 128 + 32 * kt) - tk0 + ql) * KS_STRIDE + 8 * hi;
            f32x16 acc = (f32x16){0.f, 0.f, 0.f, 0.f, 0.f, 0.f, 0.f, 0.f, 0.f, 0.f, 0.f, 0.f, 0.f, 0.f, 0.f, 0.f};
#pragma unroll
            for (int s = 0; s < 4; ++s) {
                const bf16x8 kf = *(const LAS bf16x8*)(kp + 16 * s);
                acc = __builtin_amdgcn_mfma_f32_32x32x16_bf16(kf, qf[s], acc, 0, 0, 0);
            }
            const int kb0 = tq - 128 + 32 * kt; const float pen_lo = kb0 >= -16 ? 0.f : -1e30f, pen_hi = kb0 + 16 >= -16 ? 0.f : -1e30f;
#pragma unroll
            for (int r = 0; r < 16; ++r) {
                const float x = acc[r] + tabq[159 - (32 * kt + (r & 3) + 8 * (r >> 2))] + (r < 8 ? pen_lo : pen_hi);
                acc[r] = x; mx = fmaxf(mx, x);
            }
            S[kt] = acc;
            asm volatile("" ::: "memory"); __builtin_amdgcn_sched_barrier(0);
        }
        mx = fmaxf(mx, __shfl_xor(mx, 32)); mx = fmaxf(mx, sink);
        float sum = 0.f;
#pragma unroll
        for (int kt = 0; kt < 5; ++kt)
#pragma unroll
            for (int r = 0; r < 16; ++r) { const float p = __builtin_amdgcn_exp2f((S[kt][r] - mx) * pg8::LOG2E); S[kt][r] = p; sum += p; }
        sum += __shfl_xor(sum, 32); sum += __builtin_amdgcn_exp2f((sink - mx) * pg8::LOG2E);
        const float inv = 1.0f / sum;
        f32x16 OT[2];
        OT[0] = (f32x16){0.f, 0.f, 0.f, 0.f, 0.f, 0.f, 0.f, 0.f, 0.f, 0.f, 0.f, 0.f, 0.f, 0.f, 0.f, 0.f}; OT[1] = OT[0];
#pragma unroll
        for (int kt = 0; kt < 5; ++kt)
#pragma unroll
            for (int s = 0; s < 2; ++s) {
                v4u pw; pw.x = pg8::cvt_pk_bf16(S[kt][8 * s + 0], S[kt][8 * s + 1]); pw.y = pg8::cvt_pk_bf16(S[kt][8 * s + 2], S[kt][8 * s + 3]);
                pw.z = pg8::cvt_pk_bf16(S[kt][8 * s + 4], S[kt][8 * s + 5]); pw.w = pg8::cvt_pk_bf16(S[kt][8 * s + 6], S[kt][8 * s + 7]);
                const bf16x8 pf = __builtin_bit_cast(bf16x8, pw);
                const int kk0 = (tq - 128 + 32 * kt) - tk0 + 16 * s + 4 * hi;
#pragma unroll
                for (int dt = 0; dt < 2; ++dt) {
                    const LAS bf16* vp = Vt + (32 * dt + ql) * VT_STRIDE + kk0;
                    const v2u lo = *(const LAS v2u*)vp, hh = *(const LAS v2u*)(vp + 8);
                    const v4u vw = (v4u){lo.x, lo.y, hh.x, hh.y};
                    OT[dt] = __builtin_amdgcn_mfma_f32_32x32x16_bf16(__builtin_bit_cast(bf16x8, vw), pf, OT[dt], 0, 0, 0);
                }
                asm volatile("" ::: "memory"); __builtin_amdgcn_sched_barrier(0);
            }
        bf16* orow = AO + rowq * 1024 + head * 64;
#pragma unroll
        for (int dt = 0; dt < 2; ++dt)
#pragma unroll
            for (int g = 0; g < 4; ++g) { v2u w; w.x = pk2(OT[dt][4 * g] * inv, OT[dt][4 * g + 1] * inv); w.y = pk2(OT[dt][4 * g + 2] * inv, OT[dt][4 * g + 3] * inv);
                *(GAS v2u*)(orow + 32 * dt + 8 * g + 4 * hi) = w; }
    }
    __syncthreads();
}

__device__ __forceinline__ void sample_attn_wave(Frame& F, const Args& a, int s, int head, int wslot) {
    const bf16* Qb = (const bf16*)(a.ws + WS_QB); const bf16* Kb = (const bf16*)(a.ws + WS_KB); const bf16* Vb = (const bf16*)(a.ws + WS_VB);
    bf16* AO = (bf16*)(a.ws + WS_R1);
    const LAS float* tab = (const LAS float*)(F.lds + L4_TAB);
    LAS float* qs = (LAS float*)(F.lds + L4_SMP + wslot * 768); LAS float* ps = qs + 64;
    const int lane = F.lane, kvh = head >> 2; const int row = R_SAMPLE + s;
    qs[lane] = bf2f(Qb[(size_t)row * 512 + head * 64 + lane]);
    LDS_WAIT();
    const float* ck = a.in[2] + (size_t)s * 16384 + kvh * 64; const float* cv = a.in[3] + (size_t)s * 16384 + kvh * 64;
    float sc[2];
#pragma unroll
    for (int h = 0; h < 2; ++h) {
        const int i = lane + 64 * h; float acc = 0.f;
        const GAS f32x4* kp = (const GAS f32x4*)(ck + (size_t)(i < 127 ? i + 1 : 127) * 128);
#pragma unroll
        for (int d4 = 0; d4 < 16; ++d4) { const f32x4 kv = NT_LOAD(kp + d4); const f32x4 qv = *(const LAS f32x4*)(qs + 4 * d4); acc += (kv.x * qv.x + kv.y * qv.y) + (kv.z * qv.z + kv.w * qv.w); }
        sc[h] = acc;
    }
    { const float accn = wave_sum(bf2f(Kb[(size_t)row * 128 + kvh * 64 + lane]) * qs[lane]);
      if (lane == 63) sc[1] = accn; }
    sc[0] += tab[head * 192 + 32 + (127 - lane)]; sc[1] += tab[head * 192 + 32 + (63 - lane)];
    const float sink = a.in[15][head];
    const float mx = fmaxf(wave_max(fmaxf(sc[0], sc[1])), sink);
    const float p0 = __builtin_amdgcn_exp2f((sc[0] - mx) * pg8::LOG2E), p1 = __builtin_amdgcn_exp2f((sc[1] - mx) * pg8::LOG2E);
    const float den = wave_sum(p0 + p1) + __builtin_amdgcn_exp2f((sink - mx) * pg8::LOG2E);
    ps[lane] = p0; ps[lane + 64] = p1;
    LDS_WAIT();
    const int g = lane >> 4, d4 = lane & 15;
    f32x4 o = (f32x4){0.f, 0.f, 0.f, 0.f};
#pragma unroll
    for (int j = 0; j < 32; ++j) { const int i = 4 * j + g;
        f32x4 v = NT_LOAD((const GAS f32x4*)(cv + (size_t)(i < 127 ? i + 1 : 127) * 128 + 4 * d4));
        if (j == 31) { const v2u nw = *(const GAS v2u*)(Vb + (size_t)row * 128 + kvh * 64 + 4 * d4);
            const f32x4 nv = (f32x4){__uint_as_float(nw.x << 16), __uint_as_float(nw.x & 0xffff0000u), __uint_as_float(nw.y << 16), __uint_as_float(nw.y & 0xffff0000u)};
            v = (i == 127) ? nv : v; }
        o += v * ps[i]; }
#pragma unroll
    for (int e = 0; e < 4; ++e) { o[e] += __shfl_xor(o[e], 16); o[e] += __shfl_xor(o[e], 32); }
    const float inv = 1.0f / den;
    if (g == 0) { v2u w; w.x = pk2(o[0] * inv, o[1] * inv); w.y = pk2(o[2] * inv, o[3] * inv); *(GAS v2u*)(AO + (size_t)row * 1024 + head * 64 + 4 * d4) = w; }
    LDS_WAIT();
}

__device__ __forceinline__ void conv_ln_store(Frame& F, const Args& a, int row_base) {
    bf16* CA = (bf16*)(a.ws + WS_R1) + 512;
    const LAS float* Y = (const LAS float*)(F.lds + L4_Y);
    const f32x4 g0 = *(const GAS f32x4*)(a.in[19] + 4 * F.lane), g1 = *(const GAS f32x4*)(a.in[19] + 256 + 4 * F.lane);
    const f32x4 b0 = *(const GAS f32x4*)(a.in[20] + 4 * F.lane), b1 = *(const GAS f32x4*)(a.in[20] + 256 + 4 * F.lane);
#pragma unroll
    for (int k = 0; k < 4; ++k) {
        const int i = 4 * F.wave + k; const int row = row_base + i;
        f32x4 x0 = *(const LAS f32x4*)(Y + i * 512 + 4 * F.lane), x1 = *(const LAS f32x4*)(Y + i * 512 + 256 + 4 * F.lane);
        const float mean = wave_sum(pg8::sum4(x0) + pg8::sum4(x1)) * (1.0f / 512.0f);
        x0 = x0 - mean; x1 = x1 - mean;
        const float var = wave_sum(pg8::sumsq4(x0) + pg8::sumsq4(x1)) * (1.0f / 512.0f);
        const float rstd = __builtin_amdgcn_rsqf(var + EPS);
        f32x4 y0 = x0 * rstd * g0 + b0, y1 = x1 * rstd * g1 + b1;
#pragma unroll
        for (int j = 0; j < 4; ++j) { y0[j] = y0[j] * pg8::fast_sigmoid(y0[j]); y1[j] = y1[j] * pg8::fast_sigmoid(y1[j]); }
        if (row >= 0) {
            v2u w0, w1; w0.x = pk2(y0[0], y0[1]); w0.y = pk2(y0[2], y0[3]); w1.x = pk2(y1[0], y1[1]); w1.y = pk2(y1[2], y1[3]);
            *(GAS v2u*)(CA + (size_t)row * 1024 + 4 * F.lane) = w0; *(GAS v2u*)(CA + (size_t)row * 1024 + 256 + 4 * F.lane) = w1;
        }
    }
}
__device__ __forceinline__ void conv_fma32(const float (&w)[31], const float (&x)[62], float bias, LAS float* Ycol) {
#pragma unroll
    for (int ib = 0; ib < 32; ib += 8) {
        float s0 = bias, s1 = bias, s2 = bias, s3 = bias, s4 = bias, s5 = bias, s6 = bias, s7 = bias;
#pragma unroll
        for (int k = 0; k < 31; ++k) {
            s0 += w[k] * x[ib + 0 + k]; s1 += w[k] * x[ib + 1 + k]; s2 += w[k] * x[ib + 2 + k]; s3 += w[k] * x[ib + 3 + k];
            s4 += w[k] * x[ib + 4 + k]; s5 += w[k] * x[ib + 5 + k]; s6 += w[k] * x[ib + 6 + k]; s7 += w[k] * x[ib + 7 + k];
            asm volatile("" : "+v"(s0), "+v"(s1), "+v"(s2), "+v"(s3), "+v"(s4), "+v"(s5), "+v"(s6), "+v"(s7));
        }
        Ycol[(ib + 0) * 512] = s0; Ycol[(ib + 1) * 512] = s1; Ycol[(ib + 2) * 512] = s2; Ycol[(ib + 3) * 512] = s3;
        Ycol[(ib + 4) * 512] = s4; Ycol[(ib + 5) * 512] = s5; Ycol[(ib + 6) * 512] = s6; Ycol[(ib + 7) * 512] = s7;
    }
}
__device__ __forceinline__ void conv_win_load(const Args& a, int b, int t0, int tid, v4u (&g)[8]) {
    const bf16* GLU = (const bf16*)(a.ws + WS_GLU);
#pragma unroll
    for (int i = 0; i < 8; ++i) { const int ch = tid + 512 * i, r = ch >> 6, cc = ch & 63;
        const int row = tok_row(b, t0 - 30 + (r < 62 ? r : 61)); g[i] = *(const GAS v4u*)(GLU + (size_t)(row >= 0 ? row : 0) * 512 + cc * 8); }
}
__device__ __forceinline__ void conv_win_store(Frame& F, int b, int t0, int tid, const v4u (&g)[8]) {
    LAS bf16* WIN = (LAS bf16*)(F.lds + L4_WIN);
#pragma unroll
    for (int i = 0; i < 8; ++i) { const int ch = tid + 512 * i, r = ch >> 6, cc = ch & 63;
        if (r < 62) { const int row = tok_row(b, t0 - 30 + r); *(LAS v4u*)(WIN + r * 512 + cc * 8) = row >= 0 ? g[i] : (v4u){0u, 0u, 0u, 0u}; } }
}
__device__ __forceinline__ void conv_win_read(Frame& F, int c, float (&x)[62]) {
    const LAS bf16* WIN = (const LAS bf16*)(F.lds + L4_WIN);
#pragma unroll
    for (int r = 0; r < 62; ++r) x[r] = bf2f(WIN[r * 512 + c]);
}
__device__ __forceinline__ void conv_pair(Frame& F, const Args& a, int bA, int tA, int bB, int tB) {
    LAS float* Y = (LAS float*)(F.lds + L4_Y);
    const int c = F.tid;
    float w[31];
#pragma unroll
    for (int k = 0; k < 31; ++k) w[k] = a.in[17][k * 512 + c];
    const float bias = a.in[18][c];
    float x[62];
    { v4u g[8]; conv_win_load(a, bA, tA, F.tid, g); conv_win_store(F, bA, tA, F.tid, g); }
    __syncthreads();
    conv_win_read(F, c, x);
    v4u gB[8]; conv_win_load(a, bB, tB, F.tid, gB);
    conv_fma32(w, x, bias, Y + c);
    __syncthreads();
    conv_win_store(F, bB, tB, F.tid, gB);
    conv_ln_store(F, a, bA * SEQ + tA);
    __syncthreads();
    conv_win_read(F, c, x);
    conv_fma32(w, x, bias, Y + c);
    __syncthreads();
    conv_ln_store(F, a, bB * SEQ + tB);
    __syncthreads();
}
__device__ __forceinline__ void sample_conv_wave(Frame& F, const Args& a, int s) {
    const bf16* GLU = (const bf16*)(a.ws + WS_GLU); bf16* CA = (bf16*)(a.ws + WS_R1) + 512;
    const int c0 = 8 * F.lane;
    f32x4 acc0 = *(const GAS f32x4*)(a.in[18] + c0), acc1 = *(const GAS f32x4*)(a.in[18] + c0 + 4);
    const float* st = a.in[4] + (size_t)s * 15360 + c0; const float* wd = a.in[17] + c0;
#pragma unroll
    for (int k = 0; k < 30; ++k) {
        acc0 += *(const GAS f32x4*)(wd + k * 512) * NT_LOAD((const GAS f32x4*)(st + k * 512));
        acc1 += *(const GAS f32x4*)(wd + k * 512 + 4) * NT_LOAD((const GAS f32x4*)(st + k * 512 + 4));
    }
    { const v4u gw = *(const GAS v4u*)(GLU + (size_t)(R_SAMPLE + s) * 512 + c0);
      const f32x4 g0 = (f32x4){__uint_as_float(gw.x << 16), __uint_as_float(gw.x & 0xffff0000u), __uint_as_float(gw.y << 16), __uint_as_float(gw.y & 0xffff0000u)};
      const f32x4 g1 = (f32x4){__uint_as_float(gw.z << 16), __uint_as_float(gw.z & 0xffff0000u), __uint_as_float(gw.w << 16), __uint_as_float(gw.w & 0xffff0000u)};
      acc0 += *(const GAS f32x4*)(wd + 30 * 512) * g0; acc1 += *(const GAS f32x4*)(wd + 30 * 512 + 4) * g1; }
    const float mean = wave_sum(pg8::sum4(acc0) + pg8::sum4(acc1)) * (1.0f / 512.0f);
    acc0 = acc0 - mean; acc1 = acc1 - mean;
    const float var = wave_sum(pg8::sumsq4(acc0) + pg8::sumsq4(acc1)) * (1.0f / 512.0f);
    const float rstd = __builtin_amdgcn_rsqf(var + EPS);
    f32x4 y0 = acc0 * rstd * *(const GAS f32x4*)(a.in[19] + c0) + *(const GAS f32x4*)(a.in[20] + c0);
    f32x4 y1 = acc1 * rstd * *(const GAS f32x4*)(a.in[19] + c0 + 4) + *(const GAS f32x4*)(a.in[20] + c0 + 4);
#pragma unroll
    for (int j = 0; j < 4; ++j) { y0[j] = y0[j] * pg8::fast_sigmoid(y0[j]); y1[j] = y1[j] * pg8::fast_sigmoid(y1[j]); }
    *(GAS v4u*)(CA + (size_t)(R_SAMPLE + s) * 1024 + c0) = pg8::pack8(y0, y1);
}

constexpr int L_SIDE = 131072;
static_assert(L_SIDE + 3 * 8 * 1024 <= LDSCTL_OFF, "side scratch vs LDS control words");
template <int K, int LDA, int LDW> __device__ __forceinline__ f32x4 skinny_slice(const bf16* Arow0, const bf16* Wrow0, int lane, int wave) {
    constexpr int KS = K / 8;
    const int fr = lane & 15, fq = lane >> 4;
    const bf16* ap = Arow0 + (size_t)fr * LDA + wave * KS + 8 * fq; const bf16* wp = Wrow0 + (size_t)fr * LDW + wave * KS + 8 * fq;
    f32x4 acc0 = (f32x4){0.f, 0.f, 0.f, 0.f}, acc1 = acc0;
#pragma unroll
    for (int k0 = 0; k0 < KS; k0 += 32) {
        const bf16x8 av = *(const GAS bf16x8*)(ap + k0), wv = *(const GAS bf16x8*)(wp + k0);
        if ((k0 >> 5) & 1) acc1 = __builtin_amdgcn_mfma_f32_16x16x32_bf16(wv, av, acc1, 0, 0, 0); else acc0 = __builtin_amdgcn_mfma_f32_16x16x32_bf16(wv, av, acc0, 0, 0, 0);
    }
    return acc0 + acc1;
}
__device__ __forceinline__ v2u pack4(const f32x4& v) { v2u w; w.x = pg8::cvt_pk_bf16(v[0], v[1]); w.y = pg8::cvt_pk_bf16(v[2], v[3]); return w; }
__device__ __forceinline__ f32x4 unpack4(const v2u& w) { return (f32x4){__uint_as_float(w.x << 16), __uint_as_float(w.x & 0xffff0000u), __uint_as_float(w.y << 16), __uint_as_float(w.y & 0xffff0000u)}; }
__device__ __forceinline__ f32x4 side_reduce(const LAS f32x4* part, int slot, int lane) {
    f32x4 s = part[(slot * 8) * 64 + lane];
#pragma unroll
    for (int w = 1; w < 8; ++w) s += part[(slot * 8 + w) * 64 + lane];
    return s;
}
__device__ __forceinline__ void side_p2(Frame& F, const Args& a, float* ss) {
    const bf16* HID = (const bf16*)(a.ws + WS_R2); const bf16* W2 = (const bf16*)(a.ws + WS_W2A); bf16* HB = (bf16*)a.out;
    float* hside = (float*)(a.ws + WS_HSIDE);
    LAS f32x4* part = (LAS f32x4*)(F.lds + L_SIDE);
    const int fr = F.lane & 15, fq = F.lane >> 4; constexpr int NT = 9 * 64;
    for (int t0 = blockIdx.x; t0 < NT; t0 += 3 * F.G) {
#pragma unroll
    for (int j = 0; j < 3; ++j) { const int t = t0 + j * F.G; if (t < NT) { const int rt = t >> 6, cs = t & 63;
        part[(j * 8 + F.wave) * 64 + F.lane] = skinny_slice<DFF, DFF, DFF>(HID + (size_t)(R_META + 16 * rt) * DFF, W2 + (size_t)(16 * cs) * DFF, F.lane, F.wave); } }
    __syncthreads();
    { const int t = t0 + F.wave * F.G;
      if (F.wave < 3 && t < NT) {
        const int rt = t >> 6, cs = t & 63; const int row0 = R_META + 16 * rt, col = 16 * cs + 4 * fq, row = row0 + fr;
        const f32x4 acc = side_reduce(part, F.wave, F.lane);
        const float* src = rt == 0 ? a.in[5] + (size_t)fr * D : a.in[1] + (size_t)(16 * (rt - 1) + fr) * D;
        const f32x4 h = NT_LOAD((const GAS f32x4*)(src + col)) + acc * 0.5f;
        *(GAS f32x4*)(hside + (size_t)(row - R_META) * D + col) = h;
        *(GAS v2u*)(HB + (size_t)row * D + col) = pack4(h);
        float p = pg8::sumsq4(h); p += __shfl_xor(p, 16); p += __shfl_xor(p, 32);
        if (fq == 0) atomicAdd(ss + row, p);
      } }
    __syncthreads();
    }
}
__device__ __forceinline__ void side_p5(Frame& F, const Args& a) {
    const bf16* AO = (const bf16*)(a.ws + WS_R1); const bf16* CA = AO + 512; const bf16* Wm = (const bf16*)(a.ws + WS_WMIX);
    const bf16* GA = (const bf16*)(a.ws + WS_GA); const bf16* GC = (const bf16*)(a.ws + WS_GC); bf16* MIXB = (bf16*)(a.ws + WS_MIXB);
    LAS f32x4* part = (LAS f32x4*)(F.lds + L_SIDE);
    const int fr = F.lane & 15, fq = F.lane >> 4; constexpr int NT = 8 * 64;
    for (int t0 = blockIdx.x; t0 < NT; t0 += 2 * F.G) {
#pragma unroll
    for (int j = 0; j < 2; ++j) { const int t = t0 + j * F.G; if (t < NT) { const int rt = t >> 6, cs = t & 63; const int row0 = R_SAMPLE + 16 * rt, col = 16 * cs + 4 * fq, row = row0 + fr;
        const f32x4 p1 = skinny_slice<512, 1024, 1024>(AO + (size_t)row0 * 1024, Wm + (size_t)(16 * cs) * 1024, F.lane, F.wave);
        const f32x4 p2 = skinny_slice<512, 1024, 1024>(CA + (size_t)row0 * 1024, Wm + (size_t)(16 * cs) * 1024 + 512, F.lane, F.wave);
        const v2u gaw = *(const GAS v2u*)(GA + (size_t)row * D + col), gcw = *(const GAS v2u*)(GC + (size_t)row * D + col);
        part[(j * 8 + F.wave) * 64 + F.lane] = unpack4(gaw) * p1 + unpack4(gcw) * p2; } }
    __syncthreads();
    { const int t = t0 + F.wave * F.G;
      if (F.wave < 2 && t < NT) {
        const int rt = t >> 6, cs = t & 63; const int row0 = R_SAMPLE + 16 * rt, col = 16 * cs + 4 * fq, row = row0 + fr;
        *(GAS v2u*)(MIXB + (size_t)row * D + col) = pack4(side_reduce(part, F.wave, F.lane));
      } }
    __syncthreads();
    }
}
__device__ __forceinline__ void side_p6(Frame& F, const Args& a, float* ss) {
    const bf16* MIXB = (const bf16*)(a.ws + WS_MIXB); const bf16* Wo = (const bf16*)(a.ws + WS_WOUT); bf16* H2B = (bf16*)(a.ws + WS_R1);
    float* hside = (float*)(a.ws + WS_HSIDE);
    LAS f32x4* part = (LAS f32x4*)(F.lds + L_SIDE);
    const int fr = F.lane & 15, fq = F.lane >> 4; constexpr int NT = 8 * 64;
    for (int t0 = blockIdx.x; t0 < NT; t0 += 2 * F.G) {
#pragma unroll
    for (int j = 0; j < 2; ++j) { const int t = t0 + j * F.G; if (t < NT) { const int rt = t >> 6, cs = t & 63;
        part[(j * 8 + F.wave) * 64 + F.lane] = skinny_slice<D, D, D>(MIXB + (size_t)(R_SAMPLE + 16 * rt) * D, Wo + (size_t)(16 * cs) * D, F.lane, F.wave); } }
    __syncthreads();
    { const int t = t0 + F.wave * F.G;
      if (F.wave < 2 && t < NT) {
        const int rt = t >> 6, cs = t & 63; const int row0 = R_SAMPLE + 16 * rt, col = 16 * cs + 4 * fq, row = row0 + fr;
        const f32x4 acc = side_reduce(part, F.wave, F.lane);
        GAS f32x4* hp = (GAS f32x4*)(hside + (size_t)(row - R_META) * D + col);
        const f32x4 h = *hp + acc;
        *hp = h;
        *(GAS v2u*)(H2B + (size_t)row * D + col) = pack4(h);
        float p = pg8::sumsq4(h); p += __shfl_xor(p, 16); p += __shfl_xor(p, 32);
        if (fq == 0) atomicAdd(ss + row, p);
      } }
    __syncthreads();
    }
}
__device__ __forceinline__ void side_p8(Frame& F, const Args& a) {
    const bf16* HID = (const bf16*)(a.ws + WS_R2); const bf16* W2 = (const bf16*)(a.ws + WS_W2B);
    const float* hside = (const float*)(a.ws + WS_HSIDE);
    LAS f32x4* part = (LAS f32x4*)(F.lds + L_SIDE);
    const int fr = F.lane & 15, fq = F.lane >> 4; constexpr int NT = 8 * 64;
    for (int t0 = blockIdx.x; t0 < NT; t0 += 2 * F.G) {
#pragma unroll
    for (int j = 0; j < 2; ++j) { const int t = t0 + j * F.G; if (t < NT) { const int rt = t >> 6, cs = t & 63;
        part[(j * 8 + F.wave) * 64 + F.lane] = skinny_slice<DFF, DFF, DFF>(HID + (size_t)(R_SAMPLE + 16 * rt) * DFF, W2 + (size_t)(16 * cs) * DFF, F.lane, F.wave); } }
    __syncthreads();
    { const int t = t0 + F.wave * F.G;
      if (F.wave < 2 && t < NT) {
        const int rt = t >> 6, cs = t & 63; const int row0 = R_SAMPLE + 16 * rt, col = 16 * cs + 4 * fq, row = row0 + fr;
        const f32x4 acc = side_reduce(part, F.wave, F.lane);
        const f32x4 h = *(const GAS f32x4*)(hside + (size_t)(row - R_META) * D + col);
        *(GAS f32x4*)(a.out + O_YS + (size_t)(row - R_SAMPLE) * D + col) = h + acc * 0.5f;
      } }
    __syncthreads();
    }
}

__device__ __forceinline__ void p4_mixers(Frame& F, const Args& a) {
    { LAS float* tab = (LAS float*)(F.lds + L4_TAB);
      for (int i = F.tid; i < 8 * 192; i += NWAVES * 64) { const int h = i / 192, d = i % 192 - 32; tab[i] = (d >= 0 && d < 128) ? a.in[14][t5_bucket(d) * 8 + h] : -1e30f; }
      __syncthreads(); }
    const int G = F.G, c = blockIdx.x;
#ifdef P4_COPY
    { const v4u* q = (const v4u*)(a.ws + WS_QB); const v4u* g = (const v4u*)(a.ws + WS_GLU); v4u* ao = (v4u*)(a.ws + WS_R1); v4u* ca = ao + (size_t)MP * 64;
      for (size_t i = (size_t)c * 512 + F.tid; i < (size_t)MP * 64; i += (size_t)G * 512) { ao[i] = q[i]; ca[i] = g[i]; } return; }
#endif
#ifndef P4_MASK
#define P4_MASK 15
#endif
#ifndef P4_DUP
#define P4_DUP 0
#endif
    if (P4_MASK & 1) for (int u = c; u < ((P4_DUP & 1) ? 512 : 256); u += G) attn_unit(F, a, (u & 255) >> 7, (u >> 6) & 1, u & 63);
    if (P4_MASK & 2) for (int u = c; u < ((P4_DUP & 2) ? 512 : 256); u += G) { const int uA = 2 * (u & 255), uB = uA + 1; conv_pair(F, a, uA >> 8, 32 * (uA & 255), uB >> 8, 32 * (uB & 255)); }
    if (P4_MASK & 4) for (int t = c * 4 + (F.wave & 3); t < ((P4_DUP & 4) ? 2048 : 1024) && F.wave < 4; t += G * 4) sample_attn_wave(F, a, (t & 1023) >> 3, t & 7, F.wave);
    if (P4_MASK & 8) for (int t = c * 4 + (F.wave & 3); t < ((P4_DUP & 8) ? 1152 : 128) && F.wave >= 4; t += G * 4) sample_conv_wave(F, a, t & 127);
}

__global__ void __launch_bounds__(NWAVES * 64, 2) mk_fwd(Args args) {
    extern __shared__ __attribute__((aligned(16))) unsigned char lds[];
    Frame F;
    F.lds = (LAS unsigned char*)lds;
    F.MISC = (volatile LAS unsigned*)(F.lds + MISC_OFF);
    F.tid = threadIdx.x; F.lane = F.tid & 63; F.wave = __builtin_amdgcn_readfirstlane(F.tid >> 6);
    F.G = gridDim.x;
    unsigned char* ws = args.ws;
    F.ctl = (gu32*)(ws + WS_CTL);
    for (int u = F.tid; u < (LDS_BYTES - LDSCTL_OFF) / 4; u += NWAVES * 64) ((LAS unsigned*)(F.lds + LDSCTL_OFF))[u] = 0u;
    __syncthreads();
    XcdBarrier bar; bar.bar = (unsigned*)(F.ctl + CW_BAR); bar.x = 0; bar.st = nullptr;
    if (!MK_SPLIT) bar = xcd_barrier_post((unsigned*)(F.ctl + CW_BAR), F.MISC + 8);
    const int lo = args.ph_lo, hi = args.ph_hi;
#ifndef PH_MASK
#define PH_MASK 0x1ff
#endif
#define IN(k) (((PH_MASK >> (k)) & 1) && lo <= (k) && (k) < hi)
#define SEAM(k) do { if (IN(k) && IN((k) + 1)) xcd_barrier(bar); } while (0)
#ifndef MULTI_ALIGN
#define MULTI_ALIGN true
#endif
#ifndef MULTI_SP2
#define MULTI_SP2 true
#endif
#ifndef AUXA_DOWN
#define AUXA_DOWN 0
#endif
#ifndef DUP_MASK
#define DUP_MASK 0
#endif
#define REP(k) for (int rep_ = 0; rep_ < (((DUP_MASK >> (k)) & 1) ? 2 : 1); ++rep_)
    const int bx = blockIdx.x;
    float* const ss1 = (float*)(F.ctl + CW_SS1); float* const ss2 = (float*)(F.ctl + CW_SS2); float* const ss3 = (float*)(F.ctl + CW_SS3);
    float* const outy = args.out + O_Y; float* const outys = args.out + O_YS; float* const hside = (float*)(ws + WS_HSIDE);
    bf16* const R1 = (bf16*)(ws + WS_R1); bf16* const HID = (bf16*)(ws + WS_R2); bf16* const HB = (bf16*)args.out;

#ifdef PROBE_TWICE
    for (int whole_ = 0; whole_ < 2; ++whole_) {
    if (whole_ == 1) { xcd_barrier(bar); for (int i = bx * 512 + F.tid; i < 2 * MP; i += F.G * 512) ss2[i] = 0.f; xcd_barrier(bar); }
#endif
    if (IN(0)) REP(0) { p0_prologue(F, args);
#ifdef NO_IDLE_ITEMS
        p0_items(F, args, P0_B0, P0_C0 + P0_C_P3, bx, F.G);
#endif
#ifdef COPIES_IN_P0
        p0_copies(F, args, bx, F.G);
#endif
        SEAM(0); }
    if (IN(1)) REP(1) {
        pg8::Gemm g{R1, (const bf16*)(ws + WS_W13A), MP, 2 * DFF, D}; pg8::StaticOrder S; S.init(MP, 2 * DFF, F.G, bx);
        pg8::EpiUp E{HID, DFF, ss1};
        pg8::gemm_phase<pg8::EpiUp, pg8::StaticOrder, MULTI_ALIGN, MULTI_SP2>(F.lds, g, S, E);
        { const int nu = NTM * 22, rem = nu % F.G;
#ifndef NO_IDLE_ITEMS
          if (rem == 0) p0_items(F, args, P0_B0, P0_C0, bx, F.G); else if (bx >= rem) p0_items(F, args, P0_B0, P0_C0, bx - rem, F.G - rem);
#endif
        }
        SEAM(1);
    }
#ifdef PROBE_P1
    if (IN(1)) {
        pg8::Gemm g{R1, (const bf16*)(ws + WS_W13A), MP, 2 * DFF, D}; pg8::StaticOrder S; S.init(MP, 2 * DFF, F.G, bx);
        pg8::EpiUp E{HID, DFF, ss1};
        pg8::gemm_phase<pg8::EpiUp, pg8::StaticOrder, true, true>(F.lds, g, S, E);
        if (PROBE_P1 == 2) { const int nu = NTM * 22, rem = nu % F.G; if (bx >= rem) p0_items(F, args, P0_B0, P0_C0, bx - rem, F.G - rem); }
        xcd_barrier(bar);
    }
#endif
#ifdef PROBE_P2
    if (IN(2)) { float* const ssd = (PROBE_P2 >= 3) ? nullptr : (float*)(F.ctl + CW_SS3 + MP);
        if (PROBE_P2 == 1) side_p2(F, args, ssd);
        pg8::Gemm g{HID, (const bf16*)(ws + WS_W2A), NPROMPT, D, DFF}; pg8::StaticOrder S; S.init(NPROMPT, D, F.G, bx);
        pg8::EpiRes<0> E{nullptr, R1, nullptr, HB, ssd};
        pg8::gemm_phase<pg8::EpiRes<0>, pg8::StaticOrder, true, true>(F.lds, g, S, E);
        xcd_barrier(bar); }
#endif
#ifdef PROBE_P6
    if (IN(2)) { float* const ssd = (float*)(F.ctl + CW_SS3 + MP);
        pg8::Gemm g{HID, (const bf16*)(ws + WS_W2A), NPROMPT, D, D}; pg8::StaticOrder S; S.init(NPROMPT, D, F.G, bx);
        pg8::EpiRes<1> E{nullptr, R1, nullptr, (bf16*)(ws + WS_MIX), ssd};
        pg8::gemm_phase<pg8::EpiRes<1>, pg8::StaticOrder, true, true>(F.lds, g, S, E);
        xcd_barrier(bar); }
#endif
    if (IN(2)) REP(2) {
        pg8::Gemm g{HID, (const bf16*)(ws + WS_W2A), NPROMPT, D, DFF}; pg8::StaticOrder S; S.init(NPROMPT, D, F.G, bx);
        pg8::EpiRes<0> E{nullptr, R1, nullptr, HB, ss2};
        struct Post2 { Frame& F; const Args& a; float* ss; __device__ __forceinline__ void operator()() const { side_p2(F, a, ss); } } post{F, args, ss2};
        pg8::gemm_phase<pg8::EpiRes<0>, pg8::StaticOrder, true, true, Post2, AUXA_DOWN>(F.lds, g, S, E, post);
        SEAM(2);
    }
#ifdef PROBE_BAR
    if (IN(2)) { for (int i_ = 0; i_ < PROBE_BAR; ++i_) xcd_barrier(bar); }
#endif
#ifdef PROBE_GEMM
    if (IN(2)) {
        if (PROBE_GEMM == 2) { pg8::Gemm g{HID, (const bf16*)(ws + WS_W2A), NPROMPT, D, DFF}; pg8::StaticOrder S; S.init(NPROMPT, D, F.G, bx); pg8::EpiNull E{hside}; pg8::gemm_phase<pg8::EpiNull, pg8::StaticOrder, true, true>(F.lds, g, S, E); }
        if (PROBE_GEMM == 1) { pg8::Gemm g{HID, (const bf16*)(ws + WS_W13A), MP, 2 * DFF, D}; pg8::StaticOrder S; S.init(MP, 2 * DFF, F.G, bx); pg8::EpiNull E{hside}; pg8::gemm_phase<pg8::EpiNull, pg8::StaticOrder, true, true>(F.lds, g, S, E); }
        if (PROBE_GEMM == 6) { pg8::Gemm g{HID, (const bf16*)(ws + WS_WOUT), NPROMPT, D, D}; pg8::StaticOrder S; S.init(NPROMPT, D, F.G, bx); pg8::EpiNull E{hside}; pg8::gemm_phase<pg8::EpiNull, pg8::StaticOrder, true, true>(F.lds, g, S, E); }
        xcd_barrier(bar);
    }
#endif
#ifdef PROBE_P12
    if (IN(2)) { float* const ssd = (float*)(F.ctl + CW_SS3 + MP);
        { pg8::Gemm g{R1, (const bf16*)(ws + WS_W13A), MP, 2 * DFF, D}; pg8::StaticOrder S; S.init(MP, 2 * DFF, F.G, bx);
          pg8::EpiUp E{HID, DFF, ss1};
          pg8::gemm_phase<pg8::EpiUp, pg8::StaticOrder, true, true>(F.lds, g, S, E); }
        xcd_barrier(bar);
        { pg8::Gemm g{HID, (const bf16*)(ws + WS_W2A), NPROMPT, D, DFF}; pg8::StaticOrder S; S.init(NPROMPT, D, F.G, bx);
          pg8::EpiRes<0> E{nullptr, R1, nullptr, HB, ssd};
          pg8::gemm_phase<pg8::EpiRes<0>, pg8::StaticOrder, true, true>(F.lds, g, S, E); }
        xcd_barrier(bar);
    }
#endif
    if (IN(3)) REP(3) {
        pg8::Gemm g{HB, (const bf16*)(ws + WS_WIN), MP, NIN, D}; pg8::StaticOrder S; S.init(MP, NIN, F.G, bx);
        pg8::EpiWin E{ss2, args.in[12], args.in[13], ws, args.out};
        pg8::gemm_phase<pg8::EpiWin, pg8::StaticOrder, MULTI_ALIGN, MULTI_SP2>(F.lds, g, S, E);
        { const int nu = NTM * 15, rem = nu % F.G;
#ifndef NO_IDLE_ITEMS
          if (rem == 0) p0_items(F, args, P0_C0, P0_C0 + P0_C_P3, bx, F.G); else if (bx >= rem) p0_items(F, args, P0_C0, P0_C0 + P0_C_P3, bx - rem, F.G - rem);
#endif
        }
        SEAM(3);
    }
#ifdef PROBE_P3
    if (IN(3)) {
        pg8::Gemm g{HB, (const bf16*)(ws + WS_WIN), MP, NIN, D}; pg8::StaticOrder S; S.init(MP, NIN, F.G, bx);
        pg8::EpiWin E{ss2, args.in[12], args.in[13], ws, args.out};
        pg8::gemm_phase<pg8::EpiWin, pg8::StaticOrder, true, true>(F.lds, g, S, E);
        if (PROBE_P3 == 2) { const int nu = NTM * 15, rem = nu % F.G; if (bx >= rem) p0_items(F, args, P0_C0, P0_C0 + P0_C_P3, bx - rem, F.G - rem); }
        xcd_barrier(bar);
    }
#endif
    if (IN(4)) REP(4) { p4_mixers(F, args); VM_WAIT(); __syncthreads(); SEAM(4); }
#ifdef PROBE_P4
    if (IN(4)) { p4_mixers(F, args); VM_WAIT(); __syncthreads(); xcd_barrier(bar); }
#endif
    if (IN(5)) REP(5) {
        pg8::Gemm g{R1, (const bf16*)(ws + WS_WMIX), NPROMPT, D, D}; pg8::StaticOrder S; S.init(NPROMPT, D, F.G, bx);
        pg8::EpiMix E{(const bf16*)(ws + WS_GA), (const bf16*)(ws + WS_GC), (bf16*)(ws + WS_MIXB)};
        struct Post5 { Frame& F; const Args& a; __device__ __forceinline__ void operator()() const { side_p5(F, a); } } post{F, args};
        pg8::gemm_phase<pg8::EpiMix, pg8::StaticOrder, true, true, Post5>(F.lds, g, S, E, post);
        SEAM(5);
    }
#ifdef PROBE_P5
    if (IN(5)) {
        side_p5(F, args);
        pg8::Gemm g{R1, (const bf16*)(ws + WS_WMIX), NPROMPT, D, D}; pg8::StaticOrder S; S.init(NPROMPT, D, F.G, bx);
        pg8::EpiMix E{(const bf16*)(ws + WS_GA), (const bf16*)(ws + WS_GC), (bf16*)(ws + WS_MIXB)};
        pg8::gemm_phase<pg8::EpiMix, pg8::StaticOrder, true, true>(F.lds, g, S, E);
        SEAM(5);
    }
#endif
    if (IN(6)) REP(6) {
#ifdef P6_TEST
        pg8::Gemm g{(const bf16*)(ws + P6_TEST), (const bf16*)(ws + WS_WOUT), MP, D, D}; pg8::StaticOrder S; S.init(MP, D, F.G, bx);
        pg8::EpiRes<1> E{nullptr, HB, nullptr, (bf16*)(ws + WS_MIX), ss3};
#else
        pg8::Gemm g{(const bf16*)(ws + WS_MIXB), (const bf16*)(ws + WS_WOUT), NPROMPT, D, D}; pg8::StaticOrder S; S.init(NPROMPT, D, F.G, bx);
        pg8::EpiRes<1> E{nullptr, HB, nullptr, R1, ss3};
#endif
        struct Post6 { Frame& F; const Args& a; float* ss; __device__ __forceinline__ void operator()() const {
#ifndef P6_TEST
            side_p6(F, a, ss);
#endif
        } } post{F, args, ss3};
        pg8::gemm_phase<pg8::EpiRes<1>, pg8::StaticOrder, true, true, Post6>(F.lds, g, S, E, post);
        SEAM(6);
    }
#ifdef PROBE_P56
    if (IN(6)) { float* const ssd = (float*)(F.ctl + CW_SS3 + MP);
        xcd_barrier(bar);
        { side_p5(F, args);
          pg8::Gemm g{R1  , (const bf16*)(ws + WS_WMIX), NPROMPT, D, D}; pg8::StaticOrder S; S.init(NPROMPT, D, F.G, bx);
          pg8::EpiMix E{(const bf16*)(ws + WS_GA), (const bf16*)(ws + WS_GC), (bf16*)(ws + WS_MIX)};
          pg8::gemm_phase<pg8::EpiMix, pg8::StaticOrder, true, true>(F.lds, g, S, E); }
        xcd_barrier(bar);
        { pg8::Gemm g{(const bf16*)(ws + WS_MIX), (const bf16*)(ws + WS_WOUT), NPROMPT, D, D}; pg8::StaticOrder S; S.init(NPROMPT, D, F.G, bx);
          pg8::EpiRes<1> E{nullptr, HB, nullptr, (bf16*)(ws + WS_MIXB), ssd};
          pg8::gemm_phase<pg8::EpiRes<1>, pg8::StaticOrder, true, true>(F.lds, g, S, E); }
    }
#endif
    if (IN(7)) REP(7) {
        pg8::Gemm g{R1, (const bf16*)(ws + WS_W13B), MP, 2 * DFF, D}; pg8::StaticOrder S; S.init(MP, 2 * DFF, F.G, bx);
        pg8::EpiUp E{HID, DFF, ss3};
        pg8::gemm_phase<pg8::EpiUp, pg8::StaticOrder, MULTI_ALIGN, MULTI_SP2>(F.lds, g, S, E);
#ifndef COPIES_IN_P0
        { const int nu = NTM * 22, rem = nu % F.G;
          if (rem == 0) p0_copies(F, args, bx, F.G); else if (bx >= rem) p0_copies(F, args, bx - rem, F.G - rem); }
#endif
        SEAM(7);
    }
    if (IN(8)) REP(8) {
        pg8::Gemm g{HID, (const bf16*)(ws + WS_W2B), NPROMPT, D, DFF}; pg8::StaticOrder S; S.init(NPROMPT, D, F.G, bx);
        pg8::EpiRes<2> E{nullptr, R1, outy, nullptr, nullptr};
        struct Post8 { Frame& F; const Args& a; __device__ __forceinline__ void operator()() const { side_p8(F, a); } } post{F, args};
        pg8::gemm_phase<pg8::EpiRes<2>, pg8::StaticOrder, true, true, Post8, AUXA_DOWN>(F.lds, g, S, E, post);
    }
#ifdef PROBE_P8
    if (IN(8)) {
        xcd_barrier(bar);
        side_p8(F, args);
        pg8::Gemm g{HID, (const bf16*)(ws + WS_W2B), NPROMPT, D, DFF}; pg8::StaticOrder S; S.init(NPROMPT, D, F.G, bx);
        pg8::EpiRes<2> E{nullptr, R1, outy, nullptr, nullptr};
        pg8::gemm_phase<pg8::EpiRes<2>, pg8::StaticOrder, true, true>(F.lds, g, S, E);
    }
#endif
#ifdef PROBE_P0_END
    if (IN(8)) { xcd_barrier(bar); p0_prologue(F, args); }
#endif
#ifdef PROBE_TWICE
    }
#endif
#undef IN
#undef SEAM
}

extern "C" void kernel_launch(void* const* d_in, const int* in_sizes, int n_in, void* d_out, int out_size, void* d_ws, size_t ws_size, hipStream_t stream) {
    static int grid = 0;
    if (grid == 0) {
        if (n_in != 27 || ws_size < WS_END) { fprintf(stderr, "kernel_launch: unexpected n_in %d / ws %zu\n", n_in, ws_size); grid = -1; return; }
        int dev = 0, cus = 0, per_cu = 0;
        if (hipGetDevice(&dev) != hipSuccess || hipDeviceGetAttribute(&cus, hipDeviceAttributeMultiprocessorCount, dev) != hipSuccess) { grid = -1; return; }
        if (hipFuncSetAttribute((const void*)mk_fwd, hipFuncAttributeMaxDynamicSharedMemorySize, LDS_BYTES) != hipSuccess) { fprintf(stderr, "kernel_launch: hipFuncSetAttribute failed\n"); grid = -1; return; }
        if (hipOccupancyMaxActiveBlocksPerMultiprocessor(&per_cu, (const void*)mk_fwd, NWAVES * 64, LDS_BYTES) != hipSuccess || per_cu < 1) { fprintf(stderr, "kernel_launch: occupancy query failed (%d)\n", per_cu); (void)hipGetLastError(); per_cu = 1; }
        grid = cus * 1;
        fprintf(stderr, "kernel_launch: cus %d per_cu %d grid %d\n", cus, per_cu, grid);
    }
    if (grid < 0) return;
    (void)hipMemsetAsync((char*)d_ws + WS_CTL, 0, CTL_ZERO_BYTES, stream);
    Args a{};
    for (int i = 0; i < 27; ++i) a.in[i] = (const float*)d_in[i];
    a.out = (float*)d_out; a.ws = (unsigned char*)d_ws;
#if MK_SPLIT
    for (int p = 0; p < N_PHASES; ++p) { a.ph_lo = p; a.ph_hi = p + 1; hipLaunchKernelGGL(mk_fwd, dim3(grid), dim3(NWAVES * 64), LDS_BYTES, stream, a); }
#else
    a.ph_lo = 0; a.ph_hi = N_PHASES;
    void* kargs[] = {&a};
#ifdef PROBE_PLAIN_LAUNCH
    hipLaunchKernelGGL(mk_fwd, dim3(grid), dim3(NWAVES * 64), LDS_BYTES, stream, a); hipError_t e = hipSuccess; (void)kargs;
#else
    hipError_t e = hipLaunchCooperativeKernel((const void*)mk_fwd, dim3(grid), dim3(NWAVES * 64), kargs, LDS_BYTES, stream);
#endif
    if (e != hipSuccess) fprintf(stderr, "kernel_launch: cooperative launch failed: %s (grid %d)\n", hipGetErrorString(e), grid);
#ifdef PROBE_EMPTY_LAUNCH
    { Args a2 = a; a2.ph_lo = 0; a2.ph_hi = 0; void* kargs2[] = {&a2};
      (void)hipLaunchCooperativeKernel((const void*)mk_fwd, dim3(grid), dim3(NWAVES * 64), kargs2, LDS_BYTES, stream); }
#endif
#ifdef PROBE_2LAUNCH
    (void)hipMemsetAsync((char*)d_ws + WS_CTL, 0, CTL_ZERO_BYTES, stream);
    (void)hipLaunchCooperativeKernel((const void*)mk_fwd, dim3(grid), dim3(NWAVES * 64), kargs, LDS_BYTES, stream);
#endif
#endif
}
```

```cpp
#define MK_SPLIT 0
#include <hip/hip_runtime.h>
#include <cstdio>
#include <cstdint>

constexpr int NWAVES = 8;
#ifndef MK_SPLIT
#define MK_SPLIT 0
#endif
constexpr int N_PHASES = 9;

constexpr int D = 1024, DFF = 2816, SEQ = 8192, NPROMPT = 16384, R_META = 16384, R_SAMPLE = 16400, R_END = 16528, MP = 16640, NTM = 65;
constexpr int NIN = 3840;
constexpr float EPS = 1e-6f;
constexpr size_t O_Y = 0, O_YS = 16777216, O_NKP = 16908288, O_NVP = 16941056, O_NCP = 16973824, O_NKS = 17004544, O_NVS = 19101696, O_NCS = 21198848;

constexpr size_t MiB = 1u << 20;
constexpr size_t WS_CTL = 0, CTL_ZERO_BYTES = 1 * MiB;
constexpr size_t WS_HSIDE = 1 * MiB;
constexpr size_t WS_W13A = 2 * MiB, WS_W2A = 13 * MiB, WS_WIN = 19 * MiB, WS_WMIX = 27 * MiB, WS_WOUT = 29 * MiB, WS_W13B = 31 * MiB, WS_W2B = 42 * MiB;
constexpr size_t WS_R1 = 48 * MiB;
constexpr size_t WS_R2 = 81 * MiB;
constexpr size_t WS_R3 = 171 * MiB;
constexpr size_t SZ_ROWS1K = (size_t)MP * 1024 * 2;
constexpr size_t WS_GA = WS_R2, WS_GC = WS_R2 + SZ_ROWS1K;
constexpr size_t WS_QB = WS_R3, WS_KB = WS_QB + (size_t)MP * 512 * 2, WS_VB = WS_KB + (size_t)MP * 128 * 2, WS_GLU = WS_VB + (size_t)MP * 128 * 2;
constexpr size_t WS_MIXB = WS_R3, WS_MIX = WS_R3 + 41 * MiB;
constexpr size_t WS_END = 256 * MiB;
static_assert(WS_W2B + (size_t)1024 * 2816 * 2 <= WS_R1 && WS_R1 + SZ_ROWS1K <= WS_R2 && WS_R2 + (size_t)MP * 2816 * 2 <= WS_R3 && WS_GC + SZ_ROWS1K <= WS_R3, "ws map 1");
static_assert(WS_GLU + (size_t)MP * 512 * 2 <= WS_MIX && WS_MIXB + SZ_ROWS1K <= WS_MIX && WS_MIX + SZ_ROWS1K <= WS_END, "ws map 2");
constexpr int CW_TMO = 0;
constexpr int CW_BAR = 4096;
constexpr int CW_SS1 = 32768, CW_SS2 = CW_SS1 + MP, CW_SS3 = CW_SS2 + MP;
static_assert((CW_SS3 + MP) * 4 <= (int)CTL_ZERO_BYTES, "ctl");

constexpr int RING_BYTES = 131072, LDSCTL_OFF = 159744, MISC_OFF = LDSCTL_OFF + 320, LDS_BYTES = 163840;

#define GAS __attribute__((address_space(1)))
#define LAS __attribute__((address_space(3)))
typedef unsigned short bf16;
typedef unsigned v4u __attribute__((ext_vector_type(4)));
typedef unsigned v2u __attribute__((ext_vector_type(2)));
typedef float f32x4 __attribute__((ext_vector_type(4)));
typedef float f32x16 __attribute__((ext_vector_type(16)));
typedef short bf16x8 __attribute__((ext_vector_type(8)));
typedef GAS unsigned gu32;
#define RLX_AGENT __ATOMIC_RELAXED, __HIP_MEMORY_SCOPE_AGENT
#define LDS_WAIT() asm volatile("s_waitcnt lgkmcnt(0)" ::: "memory")
#define VM_WAIT() asm volatile("s_waitcnt vmcnt(0)" ::: "memory")
__device__ __forceinline__ unsigned f2bf(float f) { unsigned u = __builtin_bit_cast(unsigned, f); return (u + 0x7fffu + ((u >> 16) & 1u)) >> 16; }
__device__ __forceinline__ unsigned pk2(float lo, float hi) { return f2bf(lo) | (f2bf(hi) << 16); }
__device__ __forceinline__ float bf2f(unsigned short h) { return __uint_as_float((unsigned)h << 16); }
#ifndef PG8_WGM
#define PG8_WGM 8
#endif
namespace pg8 {
#define PG8_LAS __attribute__((address_space(3)))
typedef unsigned short bf16_t;
typedef short bf16x8 __attribute__((ext_vector_type(8)));
typedef float f32x4 __attribute__((ext_vector_type(4)));
typedef unsigned u32x4 __attribute__((ext_vector_type(4)));
constexpr int BM = 256, BK = 64, HALF = 128, HTB = HALF * BK * 2  , STAGE_BYTES = 8 * HTB, NXCD = 8, WGM = PG8_WGM;

__host__ __device__ __forceinline__ int lds_byte(int r, int c) { const int st = (r >> 4) * 2 + (c >> 5), rr = r & 15, cc = c & 31, ob = rr * 64 + cc * 2; return st * 1024 + (ob ^ (((ob >> 9) & 1) << 5)); }
__host__ __device__ __forceinline__ void stage_rc(int b, int& R, int& C) { const int st = b / 1024, sb = b % 1024, swz = sb ^ (((sb >> 9) & 1) << 5); R = (st >> 1) * 16 + swz / 64; C = (st & 1) * 32 + (swz % 64) / 2; }
__host__ __device__ __forceinline__ int perm32(int rho) { const int n = rho >> 4, i = rho & 15; return 8 * (i >> 2) + 4 * n + (i & 3); }

struct Unit { int pm, pn; };
struct Gemm { const bf16_t* A; const bf16_t* Bt; int M, N, K; };

struct StaticOrder {
    int nM, nN, nwg, G, c;
    __host__ __device__ void init(int M, int N, int G_, int c_) { nM = M / BM; nN = N / BM; nwg = nM * nN; G = G_; c = c_; }
    __host__ __device__ bool next(int i, Unit& u) const {
        const long L = (long)i * G + c; if (L >= nwg) return false;
        int wgid = (int)L; { const int q = nwg / NXCD, r = nwg % NXCD, xcd = wgid % NXCD, off = wgid / NXCD; wgid = (xcd < r ? xcd * (q + 1) : r * (q + 1) + (xcd - r) * q) + off; }
        const int nig = WGM * nN, gid = wgid / nig, fm = gid * WGM, gsz = (nM - fm) < WGM ? (nM - fm) : WGM;
        u.pm = fm + ((wgid % nig) % gsz); u.pn = (wgid % nig) / gsz; return true;
    }
    __device__ __forceinline__ void a_ready(const Unit&) const {}
    __device__ __forceinline__ void done(const Unit&) const {}
};
typedef float f32x2 __attribute__((ext_vector_type(2)));
typedef __bf16 bf16x2_t __attribute__((ext_vector_type(2)));
__device__ __forceinline__ unsigned cvt_pk_bf16(float lo, float hi) { const f32x2 v = {lo, hi}; const bf16x2_t b = __builtin_convertvector(v, bf16x2_t); return __builtin_bit_cast(unsigned, b); }

constexpr int ROWS_PROMPT = 16384, ROW_META = 16384, ROW_SAMPLE = 16400, ROW_END = 16528, MPAD = 16640, DM = 1024;
constexpr float LOG2E = 1.4426950408889634f;
__device__ __forceinline__ float fast_sigmoid(float x) { return __builtin_amdgcn_rcpf(1.0f + __builtin_amdgcn_exp2f(-x * LOG2E)); }
__device__ __forceinline__ u32x4 pack8(const f32x4& a, const f32x4& b) { u32x4 w; w.x = cvt_pk_bf16(a[0], a[1]); w.y = cvt_pk_bf16(a[2], a[3]); w.z = cvt_pk_bf16(b[0], b[1]); w.w = cvt_pk_bf16(b[2], b[3]); return w; }
#ifndef NT_RES
#define NT_RES 0
#endif
#ifndef NT_Y
#define NT_Y 1
#endif
#if NT_RES
#define RES_LOAD(p) __builtin_nontemporal_load(p)
#else
#define RES_LOAD(p) (*(p))
#endif
#if NT_Y
#define Y_STORE(v, p) __builtin_nontemporal_store((v), (p))
#else
#define Y_STORE(v, p) (*(p) = (v))
#endif
#ifndef MK_WT
#define MK_WT 16
#endif
__device__ __forceinline__ __amdgpu_buffer_rsrc_t mkrsrc(const void* p) { return __builtin_amdgcn_make_buffer_rsrc((void*)p, 0, 0x10000000, 0x00020000); }
#define ST16(rsrc, byteoff, v) __builtin_amdgcn_raw_buffer_store_b128((v), (rsrc), (unsigned)(byteoff), 0, MK_WT)
#ifndef MK_WT_MULTI
#define MK_WT_MULTI 0
#endif
#define ST16M(rsrc, byteoff, v) __builtin_amdgcn_raw_buffer_store_b128((v), (rsrc), (unsigned)(byteoff), 0, MK_WT_MULTI)
__device__ __forceinline__ float sum4(const f32x4& a) { return (a[0] + a[1]) + (a[2] + a[3]); }
__device__ __forceinline__ float sumsq4(const f32x4& a) { return (a[0] * a[0] + a[1] * a[1]) + (a[2] * a[2] + a[3] * a[3]); }

struct EpiUp {
    static constexpr bool PERM = true, AFTER_DRAIN = false; static constexpr int MID_T = 0;
    bf16_t* O; int ldc; const float* ss;
    __device__ __forceinline__ void operator()(const f32x4 (&acc)[2][2][4][2], const Unit& u, int wr, int wc, int fr, int fq) const {
        const int row0 = u.pm * BM + wr * 64 + fr, col0 = u.pn * 128 + wc * 32 + 8 * fq;
        const __amdgpu_buffer_rsrc_t rs = mkrsrc(O);
        float sv[2][4];
#pragma unroll
        for (int ai = 0; ai < 2; ++ai)
#pragma unroll
            for (int m = 0; m < 4; ++m) sv[ai][m] = ss[row0 + ai * HALF + m * 16];
#pragma unroll
        for (int ai = 0; ai < 2; ++ai)
#pragma unroll
            for (int m = 0; m < 4; ++m) {
                const int row = row0 + ai * HALF + m * 16;
                const float s = __builtin_amdgcn_rsqf(sv[ai][m] * (1.0f / 1024.0f) + 1e-6f);
                const float c = -s * LOG2E, s2 = s * s;
                f32x4 o[2];
#pragma unroll
                for (int n = 0; n < 2; ++n)
#pragma unroll
                    for (int j = 0; j < 4; j += 2) {
                        const f32x2 g = {acc[ai][0][m][n][j], acc[ai][0][m][n][j + 1]}, up = {acc[ai][1][m][n][j], acc[ai][1][m][n][j + 1]};
                        const f32x2 t = g * c; f32x2 e; e.x = __builtin_amdgcn_exp2f(t.x); e.y = __builtin_amdgcn_exp2f(t.y);
                        const f32x2 d = e + 1.0f; f32x2 r; r.x = __builtin_amdgcn_rcpf(d.x); r.y = __builtin_amdgcn_rcpf(d.y);
                        const f32x2 v = (g * up) * (r * s2);
                        o[n][j] = v.x; o[n][j + 1] = v.y;
                    }
                ST16M(rs, ((size_t)row * ldc + col0) * 2, pack8(o[0], o[1]));
            }
    }
};

template <int MODE> struct EpiRes {
    static constexpr bool PERM = true, AFTER_DRAIN = false; static constexpr int MID_T = 0;
    const float* xf; const bf16_t* xb; float* outy; bf16_t* ob; float* ss;
    __device__ __forceinline__ void operator()(const f32x4 (&acc)[2][2][4][2], const Unit& u, int wr, int wc, int fr, int fq) const {
        const int row0 = u.pm * BM + wr * 64 + fr, col0 = u.pn * BM + wc * 32 + 8 * fq;
        const float alpha = (MODE == 1) ? 1.0f : 0.5f;
        const __amdgpu_buffer_rsrc_t rs = mkrsrc(ob);
#pragma unroll
        for (int ai = 0; ai < 2; ++ai) {
            u32x4 rw[4][2];
#pragma unroll
            for (int m = 0; m < 4; ++m)
#pragma unroll
                for (int bj = 0; bj < 2; ++bj) rw[m][bj] = RES_LOAD((const u32x4*)(xb + (size_t)(row0 + ai * HALF + m * 16) * DM + col0 + bj * HALF));
            float parts[4];
#pragma unroll
            for (int m = 0; m < 4; ++m) {
                const size_t off = (size_t)(row0 + ai * HALF + m * 16) * DM + col0;
                float part = 0.f;
#pragma unroll
                for (int bj = 0; bj < 2; ++bj) {
                    const u32x4 w = rw[m][bj];
                    const f32x4 r0 = (f32x4){__uint_as_float(w.x << 16), __uint_as_float(w.x & 0xffff0000u), __uint_as_float(w.y << 16), __uint_as_float(w.y & 0xffff0000u)};
                    const f32x4 r1 = (f32x4){__uint_as_float(w.z << 16), __uint_as_float(w.z & 0xffff0000u), __uint_as_float(w.w << 16), __uint_as_float(w.w & 0xffff0000u)};
                    const f32x4 o0 = r0 + acc[ai][bj][m][0] * alpha, o1 = r1 + acc[ai][bj][m][1] * alpha;
                    if (MODE == 2) { Y_STORE(o0, (f32x4*)(outy + off + bj * HALF)); Y_STORE(o1, (f32x4*)(outy + off + bj * HALF + 4)); }
                    else { ST16(rs, (off + bj * HALF) * 2, pack8(o0, o1)); part += sumsq4(o0) + sumsq4(o1); }
                }
                if (MODE != 2) { part += __shfl_xor(part, 16); part += __shfl_xor(part, 32); }
                parts[m] = part;
            }
            if (MODE != 2 && ss) { const float mine = fq == 0 ? parts[0] : fq == 1 ? parts[1] : fq == 2 ? parts[2] : parts[3];
                atomicAdd(ss + (u.pm * BM + ai * HALF + wr * 64 + 16 * fq + fr), mine); }
        }
    }
};

struct EpiWin {
    static constexpr bool PERM = true, AFTER_DRAIN = false; static constexpr int MID_T = 0;
    const float* ss; const float *qn, *kn; unsigned char* ws; float* out;
    static constexpr size_t O_NKP = 16908288, O_NVP = 16941056, O_NCP = 16973824, O_NKS = 17004544, O_NVS = 19101696, O_NCS = 21198848;
    __device__ __forceinline__ void operator()(const f32x4 (&acc)[2][2][4][2], const Unit& u, int wr, int wc, int fr, int fq) const {
        const int row0 = u.pm * BM + wr * 64 + fr; const int pn = u.pn;
        const __amdgpu_buffer_rsrc_t rs = mkrsrc(ws);
        const bool side_rows = (u.pm == 31 || u.pm == 63 || u.pm == 64);
        float sv[2][4];
#pragma unroll
        for (int ai = 0; ai < 2; ++ai)
#pragma unroll
            for (int m = 0; m < 4; ++m) sv[ai][m] = ss[row0 + ai * HALF + m * 16];
#pragma unroll
        for (int ai = 0; ai < 2; ++ai)
#pragma unroll
            for (int m = 0; m < 4; ++m) {
                const int row = row0 + ai * HALF + m * 16;
                const float s = __builtin_amdgcn_rsqf(sv[ai][m] * (1.0f / 1024.0f) + 1e-6f);
                const float cexp = -s * LOG2E;
                f32x4 v[2][2];
                if (pn < 7) {
#pragma unroll
                    for (int bj = 0; bj < 2; ++bj)
#pragma unroll
                        for (int n = 0; n < 2; ++n) v[bj][n] = acc[ai][bj][m][n] * ((pn >= 3 && bj == 1) ? cexp : s);
                }
                if (pn < 3) {
                    const bool isv = (pn == 2 && wc >= 2), isq = (pn < 2);
                    if (!isv) {
                        float q = (sumsq4(v[0][0]) + sumsq4(v[0][1])) + (sumsq4(v[1][0]) + sumsq4(v[1][1]));
                        q += __shfl_xor(q, 16); q += __shfl_xor(q, 32);
                        const float r = __builtin_amdgcn_rsqf(q * (1.0f / 64.0f) + 1e-6f) * (isq ? 0.125f : 1.0f);
                        const float* gn = isq ? qn : kn;
#pragma unroll
                        for (int bj = 0; bj < 2; ++bj)
#pragma unroll
                            for (int n = 0; n < 2; ++n) { const f32x4 gv = *(const f32x4*)(gn + 32 * bj + 8 * fq + 4 * n); v[bj][n] = v[bj][n] * r * gv; }
                    }
                    size_t obase; int ocol; int ld;
                    if (isq) { obase = WS_QB; ld = 512; ocol = (4 * pn + wc) * 64; } else if (!isv) { obase = WS_KB; ld = 128; ocol = wc * 64; } else { obase = WS_VB; ld = 128; ocol = (wc - 2) * 64; }
#pragma unroll
                    for (int bj = 0; bj < 2; ++bj) ST16M(rs, obase + ((size_t)row * ld + ocol + 32 * bj + 8 * fq) * 2, pack8(v[bj][0], v[bj][1]));
                    if (!isq && side_rows) {
                        float* o = nullptr; const int kvh = isv ? wc - 2 : wc;
                        if (row < ROWS_PROMPT) { const int b = row >> 13, t = row & 8191; if (t >= 8064) o = out + (isv ? O_NVP : O_NKP) + (size_t)((b * 128 + (t - 8064)) * 2 + kvh) * 64; }
                        else if (row >= ROW_SAMPLE && row < ROW_END) o = out + (isv ? O_NVS : O_NKS) + (size_t)(((row - ROW_SAMPLE) * 128 + 127) * 2 + kvh) * 64;
                        if (o) {
#pragma unroll
                            for (int bj = 0; bj < 2; ++bj)
#pragma unroll
                                for (int n = 0; n < 2; ++n) *(f32x4*)(o + 32 * bj + 8 * fq + 4 * n) = v[bj][n];
                        }
                    }
                } else if (pn < 7) {
                    const int ch = 128 * (pn - 3) + 32 * wc + 8 * fq;
                    f32x4 g[2];
#pragma unroll
                    for (int n = 0; n < 2; ++n)
#pragma unroll
                        for (int j = 0; j < 4; ++j) g[n][j] = v[0][n][j] * __builtin_amdgcn_rcpf(1.0f + __builtin_amdgcn_exp2f(v[1][n][j]));
                    ST16M(rs, WS_GLU + ((size_t)row * 512 + ch) * 2, pack8(g[0], g[1]));
                    if (side_rows) {
                        float* o = nullptr;
                        if (row < ROWS_PROMPT) { const int b = row >> 13, t = row & 8191; if (t >= 8162) o = out + O_NCP + (size_t)(b * 30 + (t - 8162)) * 512; }
                        else if (row >= ROW_SAMPLE && row < ROW_END) o = out + O_NCS + (size_t)((row - ROW_SAMPLE) * 30 + 29) * 512;
                        if (o) { *(f32x4*)(o + ch) = g[0]; *(f32x4*)(o + ch + 4) = g[1]; }
                    }
                } else {
                    const size_t obase = pn < 11 ? WS_GA : WS_GC; const int col = 256 * (pn < 11 ? pn - 7 : pn - 11) + 32 * wc + 8 * fq;
#pragma unroll
                    for (int bj = 0; bj < 2; ++bj) {
                        f32x4 g[2];
#pragma unroll
                        for (int n = 0; n < 2; ++n)
#pragma unroll
                            for (int j = 0; j < 4; ++j) g[n][j] = __builtin_amdgcn_rcpf(1.0f + __builtin_amdgcn_exp2f(acc[ai][bj][m][n][j] * cexp));
                        ST16M(rs, obase + ((size_t)row * DM + col + bj * HALF) * 2, pack8(g[0], g[1]));
                    }
                }
            }
    }
};

struct EpiMix {
    static constexpr bool PERM = true, AFTER_DRAIN = false; static constexpr int MID_T = 8;
    const bf16_t *GA, *GC; bf16_t* MIXB;
    static __device__ __forceinline__ void unpack8(const u32x4& w, f32x4& a, f32x4& b) {
        a = (f32x4){__uint_as_float(w.x << 16), __uint_as_float(w.x & 0xffff0000u), __uint_as_float(w.y << 16), __uint_as_float(w.y & 0xffff0000u)};
        b = (f32x4){__uint_as_float(w.z << 16), __uint_as_float(w.z & 0xffff0000u), __uint_as_float(w.w << 16), __uint_as_float(w.w & 0xffff0000u)}; }
    __device__ __forceinline__ void mid(f32x4 (&acc)[2][2][4][2], const Unit& u, int wr, int wc, int fr, int fq) const {
        int lo = (u.pm * BM + wr * 64 + fr) * DM + u.pn * BM + wc * 32 + 8 * fq;
        asm volatile("" : "+v"(lo));
#pragma unroll
        for (int ai = 0; ai < 2; ++ai)
#pragma unroll
            for (int m = 0; m < 4; ++m) {
                const size_t off = (size_t)(unsigned)(lo + (ai * HALF + m * 16) * DM);
#pragma unroll
                for (int bj = 0; bj < 2; ++bj) {
                    const u32x4 gaw = *(const u32x4*)(GA + off + bj * HALF), gcw = *(const u32x4*)(GC + off + bj * HALF);
                    f32x4 a0, a1, c0, c1; unpack8(gaw, a0, a1); unpack8(gcw, c0, c1);
#pragma unroll
                    for (int j = 0; j < 4; ++j) { acc[ai][bj][m][0][j] *= a0[j] * __builtin_amdgcn_rcpf(c0[j]); acc[ai][bj][m][1][j] *= a1[j] * __builtin_amdgcn_rcpf(c1[j]); }
                }
                if (m & 1) { asm volatile("" ::: "memory"); __builtin_amdgcn_sched_barrier(0); }
            }
    }
    __device__ __forceinline__ void operator()(const f32x4 (&acc)[2][2][4][2], const Unit& u, int wr, int wc, int fr, int fq) const {
        int lo = (u.pm * BM + wr * 64 + fr) * DM + u.pn * BM + wc * 32 + 8 * fq;
        asm volatile("" : "+v"(lo));
        const __amdgpu_buffer_rsrc_t rs = mkrsrc(MIXB);
#pragma unroll
        for (int ai = 0; ai < 2; ++ai) {
            u32x4 gw[4][2];
#pragma unroll
            for (int m = 0; m < 4; ++m)
#pragma unroll
                for (int bj = 0; bj < 2; ++bj) gw[m][bj] = *(const u32x4*)(GC + (size_t)(unsigned)(lo + (ai * HALF + m * 16) * DM) + bj * HALF);
#pragma unroll
            for (int m = 0; m < 4; ++m) {
                const size_t off = (size_t)(unsigned)(lo + (ai * HALF + m * 16) * DM);
#pragma unroll
                for (int bj = 0; bj < 2; ++bj) {
                    f32x4 c0, c1; unpack8(gw[m][bj], c0, c1);
                    ST16(rs, (off + bj * HALF) * 2, pack8(acc[ai][bj][m][0] * c0, acc[ai][bj][m][1] * c1));
                }
            }
        }
    }
};
struct EpiNull {
    static constexpr bool PERM = true, AFTER_DRAIN = false; static constexpr int MID_T = 0;
    float* sink;
    __device__ __forceinline__ void operator()(const f32x4 (&acc)[2][2][4][2], const Unit& u, int wr, int wc, int fr, int fq) const {
        float s = 0.f;
#pragma unroll
        for (int ai = 0; ai < 2; ++ai)
#pragma unroll
            for (int bj = 0; bj < 2; ++bj)
#pragma unroll
                for (int m = 0; m < 4; ++m)
#pragma unroll
                    for (int n = 0; n < 2; ++n) s += sum4(acc[ai][bj][m][n]);
        if (s == 1.2345e38f) sink[0] = s;
    }
};
struct NoPost { __device__ __forceinline__ void operator()() const {} };
template <class Epi, class Sched, bool ALIGN_EPI = false, bool SP2 = false, class Post = NoPost, int AUX_A = 0>
__device__ __forceinline__ void gemm_phase(PG8_LAS unsigned char* lds, const Gemm g, const Sched& S, const Epi& E, const Post& post = Post()) {
    const int tid = threadIdx.x, wid = __builtin_amdgcn_readfirstlane(tid >> 6), lane = tid & 63, wr = wid >> 2, wc = wid & 3, fr = lane & 15, fq = lane >> 4;
    const int K = g.K, nt = K / BK;
    unsigned voffA[2], voffB[2];
#pragma unroll
    for (int i = 0; i < 2; ++i) { int R, C; stage_rc(tid * 16 + i * 8192, R, C); const int Rb = Epi::PERM ? ((R & ~31) + perm32(R & 31)) : R;
        voffA[i] = (unsigned)(R * K + C) * 2u; voffB[i] = (unsigned)(Rb * K + C) * 2u; }
    const size_t kstep = (size_t)(BK * 2);
    const size_t hstep = (size_t)HALF * K * 2;
    const size_t tstep = 2 * hstep;
    const unsigned ldsw = (unsigned)wid * 1024u;
    const int aoff = lds_byte(wr * 64 + fr, fq * 8), boff = lds_byte(wc * 32 + fr, fq * 8);
#define PG8_SA(b, h) (((b) * 2 + (h)) * HTB)
#define PG8_SB(b, h) ((4 + (b) * 2 + (h)) * HTB)
#define PG8_STAGE(bufoff, gbase, voff) do { _Pragma("unroll") for (int _i = 0; _i < 2; ++_i) { \
        if (AUX_A == 2 && (const void*)(voff) == (const void*)voffA) __builtin_amdgcn_global_load_lds((const unsigned*)((const char*)(gbase) + (voff)[_i]), (PG8_LAS unsigned*)(lds + (bufoff) + ldsw + _i * 8192), 16, 0, 2); \
        else __builtin_amdgcn_global_load_lds((const unsigned*)((const char*)(gbase) + (voff)[_i]), (PG8_LAS unsigned*)(lds + (bufoff) + ldsw + _i * 8192), 16, 0, 0); } } while (0)
#define PG8_LDA(dst, b, h) do { _Pragma("unroll") for (int m = 0; m < 4; ++m) _Pragma("unroll") for (int k = 0; k < 2; ++k) dst[m][k] = *(const PG8_LAS bf16x8*)(lds + PG8_SA(b, h) + aoff + m * 2048 + k * 1024); } while (0)
#define PG8_LDB(dst, b, h) do { _Pragma("unroll") for (int n = 0; n < 2; ++n) _Pragma("unroll") for (int k = 0; k < 2; ++k) dst[n][k] = *(const PG8_LAS bf16x8*)(lds + PG8_SB(b, h) + boff + n * 2048 + k * 1024); } while (0)
#define PG8_MMA(ai, bj, At, Bt) do { __builtin_amdgcn_s_setprio(1); _Pragma("unroll") for (int m = 0; m < 4; ++m) _Pragma("unroll") for (int n = 0; n < 2; ++n) _Pragma("unroll") for (int k = 0; k < 2; ++k) \
        acc[ai][bj][m][n] = __builtin_amdgcn_mfma_f32_16x16x32_bf16(Bt[n][k], At[m][k], acc[ai][bj][m][n], 0, 0, 0); __builtin_amdgcn_s_setprio(0); } while (0)
#define PG8_WAIT_V(n) asm volatile("s_waitcnt vmcnt(" #n ")" ::: "memory")
#define PG8_WAIT_L(n) asm volatile("s_waitcnt lgkmcnt(" #n ")" ::: "memory")
#define PG8_BAR __builtin_amdgcn_s_barrier()
#define PG8_SCHED __builtin_amdgcn_sched_barrier(0)
    Unit cur, nxt; int ui = 0;
    if (!S.next(0, cur)) return;
    f32x4 acc[2][2][4][2];
#pragma unroll
    for (int a = 0; a < 2; ++a)
#pragma unroll
        for (int b = 0; b < 2; ++b)
#pragma unroll
            for (int m = 0; m < 4; ++m)
#pragma unroll
                for (int n = 0; n < 2; ++n) acc[a][b][m][n] = (f32x4){0.f, 0.f, 0.f, 0.f};
    bf16x8 At[4][2], B0[2][2], B1[2][2];
    const char* cA = (const char*)g.A + (size_t)cur.pm * tstep; const char* cB = (const char*)g.Bt + (size_t)cur.pn * tstep;
    S.a_ready(cur);
    if constexpr (SP2) {
        PG8_STAGE(PG8_SB(0, 0), cB, voffB); PG8_STAGE(PG8_SB(0, 1), cB + hstep, voffB); PG8_STAGE(PG8_SA(0, 0), cA, voffA); PG8_STAGE(PG8_SA(0, 1), cA + hstep, voffA);
        if (wr == 1) PG8_BAR;
        PG8_WAIT_V(2); PG8_BAR;
        PG8_STAGE(PG8_SB(1, 0), cB + kstep, voffB); PG8_STAGE(PG8_SA(1, 0), cA + kstep, voffA); PG8_STAGE(PG8_SB(1, 1), cB + hstep + kstep, voffB);
        PG8_WAIT_V(6); PG8_BAR;
    } else {
        PG8_STAGE(PG8_SB(0, 0), cB, voffB); PG8_STAGE(PG8_SA(0, 0), cA, voffA); PG8_STAGE(PG8_SB(0, 1), cB + hstep, voffB); PG8_STAGE(PG8_SA(0, 1), cA + hstep, voffA);
        if (wr == 1) PG8_BAR;
        PG8_WAIT_V(4); PG8_BAR;
        PG8_STAGE(PG8_SB(1, 0), cB + kstep, voffB); PG8_STAGE(PG8_SA(1, 0), cA + kstep, voffA); PG8_STAGE(PG8_SB(1, 1), cB + hstep + kstep, voffB);
        PG8_WAIT_V(6); PG8_BAR;
    }
    for (;;) {
        const bool has_next = S.next(ui + 1, nxt);
        const char* nA = has_next ? (const char*)g.A + (size_t)nxt.pm * tstep : cA; const char* nB = has_next ? (const char*)g.Bt + (size_t)nxt.pn * tstep : cB;
        for (int t = 0; t < nt; t += 2) {
            if constexpr (Epi::MID_T > 0) { if (t == Epi::MID_T) E.mid(acc, cur, wr, wc, fr, fq); }
            const bool last = (t == nt - 2);
            const char* a1 = cA + (size_t)(t + 1) * kstep;
            const char* a2 = last ? nA : cA + (size_t)(t + 2) * kstep; const char* b2 = last ? nB : cB + (size_t)(t + 2) * kstep;
            const char* a3 = a2 + kstep; const char* b3 = b2 + kstep;
            if (last && has_next) S.a_ready(nxt);
            if constexpr (SP2) {
            PG8_LDB(B0, 0, 0); PG8_LDB(B1, 0, 1); PG8_SCHED; PG8_LDA(At, 0, 0); PG8_STAGE(PG8_SA(1, 1), a1 + hstep, voffA);
            PG8_WAIT_V(8); PG8_WAIT_L(0); PG8_BAR; PG8_MMA(0, 0, At, B0); PG8_MMA(0, 1, At, B1); PG8_BAR; PG8_SCHED;
            PG8_LDA(At, 0, 1); PG8_STAGE(PG8_SB(0, 0), b2, voffB); PG8_STAGE(PG8_SB(0, 1), b2 + hstep, voffB); PG8_STAGE(PG8_SA(0, 0), a2, voffA);
            PG8_WAIT_V(8); PG8_WAIT_L(0); PG8_BAR; PG8_MMA(1, 0, At, B0); PG8_MMA(1, 1, At, B1); PG8_BAR; PG8_SCHED;
            PG8_LDB(B0, 1, 0); PG8_LDB(B1, 1, 1); PG8_SCHED; PG8_LDA(At, 1, 0); PG8_STAGE(PG8_SA(0, 1), a2 + hstep, voffA);
            PG8_WAIT_V(8); PG8_WAIT_L(0); PG8_BAR; PG8_MMA(0, 0, At, B0); PG8_MMA(0, 1, At, B1); PG8_BAR; PG8_SCHED;
            PG8_LDA(At, 1, 1); PG8_STAGE(PG8_SB(1, 0), b3, voffB); PG8_STAGE(PG8_SB(1, 1), b3 + hstep, voffB); PG8_STAGE(PG8_SA(1, 0), a3, voffA);
            PG8_WAIT_V(8); PG8_WAIT_L(0); PG8_BAR; PG8_MMA(1, 0, At, B0); PG8_MMA(1, 1, At, B1); PG8_BAR; PG8_SCHED;
            } else {
            PG8_LDB(B0, 0, 0); PG8_SCHED; PG8_LDA(At, 0, 0); PG8_STAGE(PG8_SA(1, 1), a1 + hstep, voffA);
            PG8_WAIT_L(8); PG8_BAR; PG8_WAIT_L(0); PG8_MMA(0, 0, At, B0); PG8_BAR; PG8_SCHED;
            PG8_LDB(B1, 0, 1); PG8_STAGE(PG8_SB(0, 0), b2, voffB);
            PG8_BAR; PG8_WAIT_L(0); PG8_MMA(0, 1, At, B1); PG8_BAR;
            PG8_LDA(At, 0, 1); PG8_STAGE(PG8_SA(0, 0), a2, voffA);
            PG8_BAR; PG8_WAIT_L(0); PG8_MMA(1, 0, At, B0); PG8_BAR; PG8_SCHED;
            PG8_STAGE(PG8_SB(0, 1), b2 + hstep, voffB);
            PG8_WAIT_V(6); PG8_BAR; PG8_MMA(1, 1, At, B1); PG8_BAR;
            PG8_LDB(B0, 1, 0); PG8_SCHED; PG8_LDA(At, 1, 0); PG8_STAGE(PG8_SA(0, 1), a2 + hstep, voffA);
            PG8_WAIT_L(8); PG8_BAR; PG8_WAIT_L(0); PG8_MMA(0, 0, At, B0); PG8_BAR; PG8_SCHED;
            PG8_LDB(B1, 1, 1); PG8_STAGE(PG8_SB(1, 0), b3, voffB);
            PG8_BAR; PG8_WAIT_L(0); PG8_MMA(0, 1, At, B1); PG8_BAR;
            PG8_LDA(At, 1, 1); PG8_STAGE(PG8_SA(1, 0), a3, voffA);
            PG8_BAR; PG8_WAIT_L(0); PG8_MMA(1, 0, At, B0); PG8_BAR; PG8_SCHED;
            PG8_STAGE(PG8_SB(1, 1), b3 + hstep, voffB);
            PG8_WAIT_V(6); PG8_BAR; PG8_MMA(1, 1, At, B1); PG8_BAR;
            }
        }
        if constexpr (ALIGN_EPI) { if (wr == 0) PG8_BAR; }
        if constexpr (!Epi::AFTER_DRAIN) { E(acc, cur, wr, wc, fr, fq); S.done(cur); }
        if (!has_next) break;
#pragma unroll
        for (int a = 0; a < 2; ++a)
#pragma unroll
            for (int b = 0; b < 2; ++b)
#pragma unroll
                for (int m = 0; m < 4; ++m)
#pragma unroll
                    for (int n = 0; n < 2; ++n) acc[a][b][m][n] = (f32x4){0.f, 0.f, 0.f, 0.f};
        cur = nxt; cA = nA; cB = nB; ++ui;
        if constexpr (ALIGN_EPI) { if (wr == 1) PG8_BAR; }
    }
    if constexpr (ALIGN_EPI) post();
    PG8_WAIT_V(0);
    if constexpr (!ALIGN_EPI) { if (wr == 0) PG8_BAR; }
    PG8_BAR;
    if constexpr (Epi::AFTER_DRAIN) { E.fused(acc, cur, wr, wc, fr, fq, lds, wid, lane); S.done(cur); }
#undef PG8_SA
#undef PG8_SB
#undef PG8_STAGE
#undef PG8_LDA
#undef PG8_LDB
#undef PG8_MMA
#undef PG8_WAIT_V
#undef PG8_WAIT_L
#undef PG8_BAR
#undef PG8_SCHED
}
}
#define XB_TMO      128
#define XB_XCNT(j)  (256  + 64 * (j))
#define XB_XSUB(j)  (1280 + 64 * (j))
#define XB_XGEN(j)  (2304 + 64 * (j))
#define XB_TOP      3328
#define XB_TOPGEN   3392
#define XCD_BAR_WORDS 3456
#define XB_SPIN_CAP (1u << 18)

__device__ __forceinline__ unsigned xb_ld(unsigned* p)              { return __hip_atomic_load(p, __ATOMIC_RELAXED, __HIP_MEMORY_SCOPE_AGENT); }
__device__ __forceinline__ unsigned xb_add(unsigned* p, unsigned v) { return __hip_atomic_fetch_add(p, v, __ATOMIC_RELAXED, __HIP_MEMORY_SCOPE_AGENT); }
__device__ __forceinline__ unsigned xb_xcc_id() { return (unsigned)__builtin_amdgcn_s_getreg((3 << 11) | 20) & 0xFu; }
#define XB_SPIN(cond, bar) do { unsigned _sp = 0; while (cond) { __builtin_amdgcn_s_sleep(1); \
    if ((++_sp & 255u) == 0u) { if (xb_ld(&(bar)[XB_TMO])) break; if (_sp > XB_SPIN_CAP) { atomicAdd(&(bar)[XB_TMO], 1u); break; } } } } while (0)

struct XcdBarrier {
    unsigned* bar; unsigned x;
    volatile LAS unsigned* st;
};

__device__ __forceinline__ XcdBarrier xcd_barrier_post(unsigned* bar, volatile LAS unsigned* st) {
    XcdBarrier b; b.bar = bar; b.x = xb_xcc_id(); b.st = st;
    if (threadIdx.x == 0) (void)xb_add(&bar[XB_XCNT(b.x)], 1u);
    return b;
}
__device__ __forceinline__ void xcd_barrier_complete(unsigned* bar, unsigned x, unsigned& nloc, unsigned& nx) {
    const unsigned G = gridDim.x * gridDim.y * gridDim.z;
    unsigned sum, cnt, mine, sp = 0u;
    for (;;) {
        sum = 0u; cnt = 0u; mine = 0u;
#pragma unroll
        for (unsigned j = 0; j < 16; ++j) { const unsigned c = xb_ld(&bar[XB_XCNT(j)]); sum += c; cnt += (c > 0u) ? 1u : 0u; mine = (j == x) ? c : mine; }
        if (sum == G) break;
        __builtin_amdgcn_s_sleep(1);
        if ((++sp & 255u) == 0u) { if (xb_ld(&bar[XB_TMO])) break; if (sp > XB_SPIN_CAP) { atomicAdd(&bar[XB_TMO], 1u); break; } }
    }
    nloc = mine > 0u ? mine : 1u; nx = cnt > 0u ? cnt : 1u;
}

__device__ __forceinline__ void xcd_barrier(const XcdBarrier& b) {
    asm volatile("s_waitcnt vmcnt(0)" ::: "memory");
    __syncthreads();
    if (threadIdx.x == 0) {
        unsigned* bar = b.bar;
        __builtin_amdgcn_s_waitcnt(0);
        unsigned nloc = b.st[0], nx = b.st[1];
        if (nloc == 0u) { xcd_barrier_complete(bar, b.x, nloc, nx); b.st[0] = nloc; b.st[1] = nx; }
        const unsigned old = xb_add(&bar[XB_XSUB(b.x)], 1u);
        const unsigned gen = old / nloc;
        if (old + 1u == (gen + 1u) * nloc) {
            __builtin_amdgcn_fence(__ATOMIC_RELEASE, "agent");
            asm volatile("s_waitcnt vmcnt(0)" ::: "memory");
            const unsigned og = xb_add(&bar[XB_TOP], 1u);
            const unsigned tg = og / nx;
            if (og + 1u == (tg + 1u) * nx) xb_add(&bar[XB_TOPGEN], 1u);
            else XB_SPIN(xb_ld(&bar[XB_TOPGEN]) == tg, bar);
            __builtin_amdgcn_fence(__ATOMIC_ACQUIRE, "agent");
            xb_add(&bar[XB_XGEN(b.x)], 1u);
            asm volatile("s_waitcnt vmcnt(0)" ::: "memory");
        } else {
            XB_SPIN(xb_ld(&bar[XB_XGEN(b.x)]) == gen, bar);
            __builtin_amdgcn_fence(__ATOMIC_ACQUIRE, "agent");
            asm volatile("s_waitcnt vmcnt(0)" ::: "memory");
        }
    }
    __syncthreads();
}

struct Args {
    const float* in[27]; float* out; unsigned char* ws; int ph_lo, ph_hi;
};
struct Frame {
    LAS unsigned char* lds; volatile LAS unsigned* MISC; gu32* ctl;
    int tid, lane, wave, G;
};
__device__ __forceinline__ float wave_sum(float v) {
#pragma unroll
    for (int o = 1; o < 64; o <<= 1) v += __shfl_xor(v, o);
    return v;
}
__device__ __forceinline__ float wave_max(float v) {
#pragma unroll
    for (int o = 1; o < 64; o <<= 1) v = fmaxf(v, __shfl_xor(v, o));
    return v;
}

#ifndef MK_NT
#define MK_NT 1
#endif
#ifndef XROWS
#define XROWS 2
#endif
#ifndef NT_ITEMS
#define NT_ITEMS 0
#endif
#if NT_ITEMS
#define ITEM_STORE(v, p) __builtin_nontemporal_store((v), (p))
#else
#define ITEM_STORE(v, p) (*(p) = (v))
#endif
#if MK_NT
#define NT_LOAD(p) __builtin_nontemporal_load(p)
#define NT_STORE(v, p) __builtin_nontemporal_store((v), (p))
#else
#define NT_LOAD(p) (*(p))
#define NT_STORE(v, p) (*(p) = (v))
#endif
__device__ __forceinline__ void p0_transpose_item(const float* W, int K, int N, const float* gain, bf16* WT, int k0, int n0, int dra, int drb, LAS float* scr, int lane) {
    const int lr = lane >> 4, lc = 4 * (lane & 15);
    f32x4 w[8];
#pragma unroll
    for (int i = 0; i < 8; ++i) w[i] = NT_LOAD((const GAS f32x4*)(W + (size_t)(k0 + 4 * i + lr) * N + n0 + lc));
    if (gain) {
#pragma unroll
        for (int i = 0; i < 8; ++i) w[i] = w[i] * gain[k0 + 4 * i + lr];
    }
#pragma unroll
    for (int i = 0; i < 8; ++i) { LAS float* d = scr + (4 * i + lr) * 65 + lc; d[0] = w[i].x; d[1] = w[i].y; d[2] = w[i].z; d[3] = w[i].w; }
    LDS_WAIT(); asm volatile("" ::: "memory");
    const int c = lane & 3;
#pragma unroll
    for (int j = 0; j < 4; ++j) { const int n = (lane >> 2) + 16 * j; const LAS float* s = scr + (8 * c) * 65 + n;
        v4u o; o.x = pk2(s[0 * 65], s[1 * 65]); o.y = pk2(s[2 * 65], s[3 * 65]); o.z = pk2(s[4 * 65], s[5 * 65]); o.w = pk2(s[6 * 65], s[7 * 65]);
        const int dr = (j < 2 ? dra : drb) + (n & 31);
        ITEM_STORE(o, (GAS v4u*)(WT + (size_t)dr * K + k0 + 8 * c)); }
    LDS_WAIT(); asm volatile("" ::: "memory");
}
__device__ __forceinline__ int win_dest_row(int n0) {
    if (n0 < 512) { const int head = n0 >> 6, d = n0 & 63; return 256 * (head >> 2) + 128 * (d >> 5) + 32 * (head & 3); }
    if (n0 < 640) { const int kvh = (n0 - 512) >> 6, d = n0 & 63; return 512 + 128 * (d >> 5) + 32 * kvh; }
    if (n0 < 768) { const int vh = (n0 - 640) >> 6, d = n0 & 63; return 512 + 128 * (d >> 5) + 32 * (2 + vh); }
    if (n0 < 1792) { const int which = (n0 - 768) >> 9, ch = (n0 - 768) & 511; return 256 * (3 + (ch >> 7)) + 128 * which + (ch & 127); }
    return n0;
}
__device__ __forceinline__ int ffn_dest_row(int j0, int which) { return 256 * (j0 >> 7) + 128 * which + (j0 & 127); }

constexpr int I_W1 = 32 * 44, I_W2 = 88 * 16, I_WIN = 32 * 60, I_AO = 16 * 16, I_WO = 32 * 16;
constexpr int P0_A0 = 0, P0_B0 = 2 * I_W1, P0_C0 = P0_B0 + I_W2 + I_WIN + 2 * I_AO + I_WO, P0_NITEMS = P0_C0 + 2 * I_W1 + I_W2;
constexpr int P0_C_P3 = 2750;
__device__ __forceinline__ void p0_items(Frame& F, const Args& a, int lo, int hi, int rank, int nworkers) {
    unsigned char* ws = a.ws;
    LAS float* scr = (LAS float*)(F.lds + F.wave * 16384);
    for (int it = lo + rank * NWAVES + F.wave; it < hi; it += nworkers * NWAVES) {
        int r = it;
        if (r < P0_B0 || r >= P0_C0) {
            const bool f = r >= P0_C0; if (f) r -= P0_C0;
            const float* gain = a.in[f ? 23 : 6]; bf16* W13 = (bf16*)(ws + (f ? WS_W13B : WS_W13A)); bf16* W2 = (bf16*)(ws + (f ? WS_W2B : WS_W2A));
            if (r < I_W1) { const int kb = r / 44, nb = r % 44; p0_transpose_item(a.in[f ? 24 : 7], D, DFF, gain, W13, 32 * kb, 64 * nb, ffn_dest_row(64 * nb, 0), ffn_dest_row(64 * nb + 32, 0), scr, F.lane); continue; } r -= I_W1;
            if (r < I_W1) { const int kb = r / 44, nb = r % 44; p0_transpose_item(a.in[f ? 25 : 8], D, DFF, gain, W13, 32 * kb, 64 * nb, ffn_dest_row(64 * nb, 1), ffn_dest_row(64 * nb + 32, 1), scr, F.lane); continue; } r -= I_W1;
            { const int kb = r / 16, nb = r % 16; p0_transpose_item(a.in[26], DFF, D, nullptr, W2, 32 * kb, 64 * nb, 64 * nb, 64 * nb + 32, scr, F.lane); continue; }
        }
        r -= P0_B0;
        if (r < I_W2) { const int kb = r / 16, nb = r % 16; p0_transpose_item(a.in[9], DFF, D, nullptr, (bf16*)(ws + WS_W2A), 32 * kb, 64 * nb, 64 * nb, 64 * nb + 32, scr, F.lane); continue; } r -= I_W2;
        if (r < I_WIN) { const int kb = r / 60, nb = r % 60; p0_transpose_item(a.in[11], D, NIN, a.in[10], (bf16*)(ws + WS_WIN), 32 * kb, 64 * nb, win_dest_row(64 * nb), win_dest_row(64 * nb + 32), scr, F.lane); continue; } r -= I_WIN;
        if (r < I_AO) { const int kb = r / 16, nb = r % 16; p0_transpose_item(a.in[16], 1024, D, nullptr, (bf16*)(ws + WS_WMIX), 32 * kb, 64 * nb, 64 * nb, 64 * nb + 32, scr, F.lane); continue; } r -= I_AO;
        if (r < I_AO) { const int kb = r / 16, nb = r % 16; p0_transpose_item(a.in[21], 1024, D, nullptr, (bf16*)(ws + WS_WMIX) + 512, 32 * kb, 64 * nb, 64 * nb, 64 * nb + 32, scr, F.lane); continue; } r -= I_AO;
        { const int kb = r / 16, nb = r % 16; p0_transpose_item(a.in[22], D, D, nullptr, (bf16*)(ws + WS_WOUT), 32 * kb, 64 * nb, 64 * nb, 64 * nb + 32, scr, F.lane); }
    }
}
__device__ __forceinline__ void p0_copies(Frame& F, const Args& a, int rank, int nworkers) {
    const int gt = rank * (NWAVES * 64) + F.tid, NGT = nworkers * NWAVES * 64;
    for (int i = gt; i < 128 * 4064; i += NGT) { const int s = i / 4064, e = i % 4064;
        NT_STORE(NT_LOAD(((const GAS f32x4*)(a.in[2] + (size_t)s * 16384 + 128)) + e), ((GAS f32x4*)(a.out + O_NKS + (size_t)s * 16384)) + e);
        NT_STORE(NT_LOAD(((const GAS f32x4*)(a.in[3] + (size_t)s * 16384 + 128)) + e), ((GAS f32x4*)(a.out + O_NVS + (size_t)s * 16384)) + e); }
    for (int i = gt; i < 128 * 3712; i += NGT) { const int s = i / 3712, e = i % 3712;
        NT_STORE(NT_LOAD(((const GAS f32x4*)(a.in[4] + (size_t)s * 15360 + 512)) + e), ((GAS f32x4*)(a.out + O_NCS + (size_t)s * 15360)) + e); }
}
__device__ __forceinline__ void p0_prologue(Frame& F, const Args& a) {
    unsigned char* ws = a.ws;
#ifdef P0_ZERO_OUT
    { GAS f32x4* o = (GAS f32x4*)a.out; for (size_t i = (size_t)blockIdx.x * 512 + F.tid; i < (size_t)23164928 / 4; i += (size_t)F.G * 512) o[i] = (f32x4){0.f, 0.f, 0.f, 0.f}; }
#endif
    LAS float* scr = (LAS float*)(F.lds + F.wave * 16384);
    const int gw = blockIdx.x * NWAVES + F.wave, NGW = F.G * NWAVES;
    p0_items(F, a, P0_A0, P0_B0, blockIdx.x, F.G);
    p0_items(F, a, P0_C0 + P0_C_P3, P0_NITEMS, blockIdx.x, F.G);
    bf16* XB = (bf16*)(ws + WS_R1); float* ss1 = (float*)(F.ctl + CW_SS1);
    for (int row0 = gw; row0 < MP; row0 += XROWS * NGW) {
        f32x4 v[XROWS][4];
#pragma unroll
        for (int q = 0; q < XROWS; ++q) { const int row = row0 + q * NGW; const int rr = row < R_END ? row : 0;
            const float* src = rr < NPROMPT ? a.in[0] + (size_t)rr * D : rr < R_SAMPLE ? a.in[5] + (size_t)(rr - R_META) * D : a.in[1] + (size_t)(rr - R_SAMPLE) * D;
#pragma unroll
            for (int j = 0; j < 4; ++j) v[q][j] = NT_LOAD(((const GAS f32x4*)src) + F.lane + 64 * j); }
#pragma unroll
        for (int q = 0; q < XROWS; ++q) { const int row = row0 + q * NGW;
            if (row < MP) {
                float s = 0.f;
#pragma unroll
                for (int j = 0; j < 4; ++j) { if (row >= R_END) v[q][j] = (f32x4){0.f, 0.f, 0.f, 0.f}; s += (v[q][j].x * v[q][j].x + v[q][j].y * v[q][j].y) + (v[q][j].z * v[q][j].z + v[q][j].w * v[q][j].w); }
                s = wave_sum(s);
                GAS unsigned long long* o8 = (GAS unsigned long long*)(XB + (size_t)row * D) + F.lane;
#pragma unroll
                for (int j = 0; j < 4; ++j) o8[64 * j] = (unsigned long long)pk2(v[q][j].x, v[q][j].y) | ((unsigned long long)pk2(v[q][j].z, v[q][j].w) << 32);
                if (F.lane == 0) ss1[row] = s;
            } }
    }
}

constexpr int VT_STRIDE = 260;
constexpr int KS_STRIDE = 72;
constexpr int L4_VT = 0, L4_KS = 33792, L4_TAB = 131072, L4_Y = 0, L4_SMP = 137216, L4_WIN = 65536;
__device__ __forceinline__ int crow(int r, int hi) { return (r & 3) + 8 * (r >> 2) + 4 * hi; }
__device__ __forceinline__ int t5_bucket(int d) {
    if (d < 16) return d;
    int b = 16;
    b += (d >= 19); b += (d >= 21); b += (d >= 24); b += (d >= 27); b += (d >= 31); b += (d >= 35); b += (d >= 40); b += (d >= 46);
    b += (d >= 52); b += (d >= 59); b += (d >= 67); b += (d >= 77); b += (d >= 87); b += (d >= 99); b += (d >= 113);
    return b;
}
__device__ __forceinline__ int tok_row(int b, int t) { return t >= 0 ? b * SEQ + t : (t >= -16 ? R_META + 16 + t : -1); }

__device__ __forceinline__ void attn_unit(Frame& F, const Args& a, int b, int kvh, int jb) {
    const bf16* Qb = (const bf16*)(a.ws + WS_QB); const bf16* Kb = (const bf16*)(a.ws + WS_KB); const bf16* Vb = (const bf16*)(a.ws + WS_VB);
    bf16* AO = (bf16*)(a.ws + WS_R1);
    LAS bf16* Vt = (LAS bf16*)(F.lds + L4_VT); LAS bf16* Ks = (LAS bf16*)(F.lds + L4_KS); const LAS float* tab = (const LAS float*)(F.lds + L4_TAB);
    const int tid = F.tid, lane = F.lane, wid = F.wave, ql = lane & 31, hi = lane >> 5;
    const int tk0 = 128 * jb - 128;
    bf16x8 qfa[2][4];
    { const int hq_ = wid & 3, qh_ = wid >> 2;
#pragma unroll
      for (int qs = 0; qs < 2; ++qs)
#pragma unroll
        for (int s = 0; s < 4; ++s) qfa[qs][s] = *(const GAS bf16x8*)(Qb + ((size_t)b * SEQ + 128 * jb + 64 * qh_ + 32 * qs + ql) * 512 + (kvh * 4 + hq_) * 64 + 16 * s + 8 * hi); }
    for (int c = tid; c < 2048; c += NWAVES * 64) {
        const int kk = c >> 3, ch = c & 7; const int row = tok_row(b, tk0 + kk);
        const int rr = row >= 0 ? row : 0;
        v4u w = *(const GAS v4u*)(Vb + (size_t)rr * 128 + kvh * 64 + ch * 8), kw = *(const GAS v4u*)(Kb + (size_t)rr * 128 + kvh * 64 + ch * 8);
        if (row < 0) { w = (v4u){0u, 0u, 0u, 0u}; kw = w; }
        *(LAS v4u*)(Ks + kk * KS_STRIDE + ch * 8) = kw;
#pragma unroll
        for (int i = 0; i < 8; ++i) { const unsigned dw = w[i >> 1]; Vt[(ch * 8 + i) * VT_STRIDE + kk] = (bf16)((i & 1) ? (dw >> 16) : (dw & 0xffffu)); }
    }
    __syncthreads();
    const int hq = wid & 3, qh = wid >> 2, head = kvh * 4 + hq;
    const float sink = a.in[15][head];
#pragma unroll
    for (int qs = 0; qs < 2; ++qs) {
        const int tq = 128 * jb + 64 * qh + 32 * qs;
        const size_t rowq = (size_t)b * SEQ + tq + ql;
        bf16x8 qf[4];
#pragma unroll
        for (int s = 0; s < 4; ++s) qf[s] = qfa[qs][s];
        f32x16 S[5];
        float mx = -1e30f;
        const LAS float* tabq = tab + head * 192 + 1 + ql - 4 * hi;
#pragma unroll
        for (int kt = 0; kt < 5; ++kt) {
            const LAS bf16* kp = Ks + ((tq - 128 + 32 * kt) - tk0 + ql) * KS_STRIDE + 8 * hi;
            f32x16 acc = (f32x16){0.f, 0.f, 0.f, 0.f, 0.f, 0.f, 0.f, 0.f, 0.f, 0.f, 0.f, 0.f, 0.f, 0.f, 0.f, 0.f};
#pragma unroll
            for (int s = 0; s < 4; ++s) {
                const bf16x8 kf = *(const LAS bf16x8*)(kp + 16 * s);
                acc = __builtin_amdgcn_mfma_f32_32x32x16_bf16(kf, qf[s], acc, 0, 0, 0);
            }
            const int kb0 = tq - 128 + 32 * kt; const float pen_lo = kb0 >= -16 ? 0.f : -1e30f, pen_hi = kb0 + 16 >= -16 ? 0.f : -1e30f;
#pragma unroll
            for (int r = 0; r < 16; ++r) {
                const float x = acc[r] + tabq[159 - (32 * kt + (r & 3) + 8 * (r >> 2))] + (r < 8 ? pen_lo : pen_hi);
                acc[r] = x; mx = fmaxf(mx, x);
            }
            S[kt] = acc;
            asm volatile("" ::: "memory"); __builtin_amdgcn_sched_barrier(0);
        }
        mx = fmaxf(mx, __shfl_xor(mx, 32)); mx = fmaxf(mx, sink);
        float sum = 0.f;
#pragma unroll
        for (int kt = 0; kt < 5; ++kt)
#pragma unroll
            for (int r = 0; r < 16; ++r) { const float p = __builtin_amdgcn_exp2f((S[kt][r] - mx) * pg8::LOG2E); S[kt][r] = p; sum += p; }
        sum += __shfl_xor(sum, 32); sum += __builtin_amdgcn_exp2f((sink - mx) * pg8::LOG2E);
        const float inv = 1.0f / sum;
        f32x16 OT[2];
        OT[0] = (f32x16){0.f, 0.f, 0.f, 0.f, 0.f, 0.f, 0.f, 0.f, 0.f, 0.f, 0.f, 0.f, 0.f, 0.f, 0.f, 0.f}; OT[1] = OT[0];
#pragma unroll
        for (int kt = 0; kt < 5; ++kt)
#pragma unroll
            for (int s = 0; s < 2; ++s) {
                v4u pw; pw.x = pg8::cvt_pk_bf16(S[kt][8 * s + 0], S[kt][8 * s + 1]); pw.y = pg8::cvt_pk_bf16(S[kt][8 * s + 2], S[kt][8 * s + 3]);
                pw.z = pg8::cvt_pk_bf16(S[kt][8 * s + 4], S[kt][8 * s + 5]); pw.w = pg8::cvt_pk_bf16(S[kt][8 * s + 6], S[kt][8 * s + 7]);
                const bf16x8 pf = __builtin_bit_cast(bf16x8, pw);
                const int kk0 = (tq - 128 + 32 * kt) - tk0 + 16 * s + 4 * hi;
#pragma unroll
                for (int dt = 0; dt < 2; ++dt) {
                    const LAS bf16* vp = Vt + (32 * dt + ql) * VT_STRIDE + kk0;
                    const v2u lo = *(const LAS v2u*)vp, hh = *(const LAS v2u*)(vp + 8);
                    const v4u vw = (v4u){lo.x, lo.y, hh.x, hh.y};
                    OT[dt] = __builtin_amdgcn_mfma_f32_32x32x16_bf16(__builtin_bit_cast(bf16x8, vw), pf, OT[dt], 0, 0, 0);
                }
                asm volatile("" ::: "memory"); __builtin_amdgcn_sched_barrier(0);
            }
        bf16* orow = AO + rowq * 1024 + head * 64;
#pragma unroll
        for (int dt = 0; dt < 2; ++dt)
#pragma unroll
            for (int g = 0; g < 4; ++g) { v2u w; w.x = pk2(OT[dt][4 * g] * inv, OT[dt][4 * g + 1] * inv); w.y = pk2(OT[dt][4 * g + 2] * inv, OT[dt][4 * g + 3] * inv);
                *(GAS v2u*)(orow + 32 * dt + 8 * g + 4 * hi) = w; }
    }
    __syncthreads();
}

__device__ __forceinline__ void sample_attn_wave(Frame& F, const Args& a, int s, int head, int wslot) {
    const bf16* Qb = (const bf16*)(a.ws + WS_QB); const bf16* Kb = (const bf16*)(a.ws + WS_KB); const bf16* Vb = (const bf16*)(a.ws + WS_VB);
    bf16* AO = (bf16*)(a.ws + WS_R1);
    const LAS float* tab = (const LAS float*)(F.lds + L4_TAB);
    LAS float* qs = (LAS float*)(F.lds + L4_SMP + wslot * 768); LAS float* ps = qs + 64;
    const int lane = F.lane, kvh = head >> 2; const int row = R_SAMPLE + s;
    qs[lane] = bf2f(Qb[(size_t)row * 512 + head * 64 + lane]);
    LDS_WAIT();
    const float* ck = a.in[2] + (size_t)s * 16384 + kvh * 64; const float* cv = a.in[3] + (size_t)s * 16384 + kvh * 64;
    float sc[2];
#pragma unroll
    for (int h = 0; h < 2; ++h) {
        const int i = lane + 64 * h; float acc = 0.f;
        const GAS f32x4* kp = (const GAS f32x4*)(ck + (size_t)(i < 127 ? i + 1 : 127) * 128);
#pragma unroll
        for (int d4 = 0; d4 < 16; ++d4) { const f32x4 kv = NT_LOAD(kp + d4); const f32x4 qv = *(const LAS f32x4*)(qs + 4 * d4); acc += (kv.x * qv.x + kv.y * qv.y) + (kv.z * qv.z + kv.w * qv.w); }
        sc[h] = acc;
    }
    { const float accn = wave_sum(bf2f(Kb[(size_t)row * 128 + kvh * 64 + lane]) * qs[lane]);
      if (lane == 63) sc[1] = accn; }
    sc[0] += tab[head * 192 + 32 + (127 - lane)]; sc[1] += tab[head * 192 + 32 + (63 - lane)];
    const float sink = a.in[15][head];
    const float mx = fmaxf(wave_max(fmaxf(sc[0], sc[1])), sink);
    const float p0 = __builtin_amdgcn_exp2f((sc[0] - mx) * pg8::LOG2E), p1 = __builtin_amdgcn_exp2f((sc[1] - mx) * pg8::LOG2E);
    const float den = wave_sum(p0 + p1) + __builtin_amdgcn_exp2f((sink - mx) * pg8::LOG2E);
    ps[lane] = p0; ps[lane + 64] = p1;
    LDS_WAIT();
    const int g = lane >> 4, d4 = lane & 15;
    f32x4 o = (f32x4){0.f, 0.f, 0.f, 0.f};
#pragma unroll
    for (int j = 0; j < 32; ++j) { const int i = 4 * j + g;
        f32x4 v = NT_LOAD((const GAS f32x4*)(cv + (size_t)(i < 127 ? i + 1 : 127) * 128 + 4 * d4));
        if (j == 31) { const v2u nw = *(const GAS v2u*)(Vb + (size_t)row * 128 + kvh * 64 + 4 * d4);
            const f32x4 nv = (f32x4){__uint_as_float(nw.x << 16), __uint_as_float(nw.x & 0xffff0000u), __uint_as_float(nw.y << 16), __uint_as_float(nw.y & 0xffff0000u)};
            v = (i == 127) ? nv : v; }
        o += v * ps[i]; }
#pragma unroll
    for (int e = 0; e < 4; ++e) { o[e] += __shfl_xor(o[e], 16); o[e] += __shfl_xor(o[e], 32); }
    const float inv = 1.0f / den;
    if (g == 0) { v2u w; w.x = pk2(o[0] * inv, o[1] * inv); w.y = pk2(o[2] * inv, o[3] * inv); *(GAS v2u*)(AO + (size_t)row * 1024 + head * 64 + 4 * d4) = w; }
    LDS_WAIT();
}

__device__ __forceinline__ void conv_ln_store(Frame& F, const Args& a, int row_base) {
    bf16* CA = (bf16*)(a.ws + WS_R1) + 512;
    const LAS float* Y = (const LAS float*)(F.lds + L4_Y);
    const f32x4 g0 = *(const GAS f32x4*)(a.in[19] + 4 * F.lane), g1 = *(const GAS f32x4*)(a.in[19] + 256 + 4 * F.lane);
    const f32x4 b0 = *(const GAS f32x4*)(a.in[20] + 4 * F.lane), b1 = *(const GAS f32x4*)(a.in[20] + 256 + 4 * F.lane);
#pragma unroll
    for (int k = 0; k < 4; ++k) {
        const int i = 4 * F.wave + k; const int row = row_base + i;
        f32x4 x0 = *(const LAS f32x4*)(Y + i * 512 + 4 * F.lane), x1 = *(const LAS f32x4*)(Y + i * 512 + 256 + 4 * F.lane);
        const float mean = wave_sum(pg8::sum4(x0) + pg8::sum4(x1)) * (1.0f / 512.0f);
        x0 = x0 - mean; x1 = x1 - mean;
        const float var = wave_sum(pg8::sumsq4(x0) + pg8::sumsq4(x1)) * (1.0f / 512.0f);
        const float rstd = __builtin_amdgcn_rsqf(var + EPS);
        f32x4 y0 = x0 * rstd * g0 + b0, y1 = x1 * rstd * g1 + b1;
#pragma unroll
        for (int j = 0; j < 4; ++j) { y0[j] = y0[j] * pg8::fast_sigmoid(y0[j]); y1[j] = y1[j] * pg8::fast_sigmoid(y1[j]); }
        if (row >= 0) {
            v2u w0, w1; w0.x = pk2(y0[0], y0[1]); w0.y = pk2(y0[2], y0[3]); w1.x = pk2(y1[0], y1[1]); w1.y = pk2(y1[2], y1[3]);
            *(GAS v2u*)(CA + (size_t)row * 1024 + 4 * F.lane) = w0; *(GAS v2u*)(CA + (size_t)row * 1024 + 256 + 4 * F.lane) = w1;
        }
    }
}
__device__ __forceinline__ void conv_fma32(const float (&w)[31], const float (&x)[62], float bias, LAS float* Ycol) {
#pragma unroll
    for (int ib = 0; ib < 32; ib += 8) {
        float s0 = bias, s1 = bias, s2 = bias, s3 = bias, s4 = bias, s5 = bias, s6 = bias, s7 = bias;
#pragma unroll
        for (int k = 0; k < 31; ++k) {
            s0 += w[k] * x[ib + 0 + k]; s1 += w[k] * x[ib + 1 + k]; s2 += w[k] * x[ib + 2 + k]; s3 += w[k] * x[ib + 3 + k];
            s4 += w[k] * x[ib + 4 + k]; s5 += w[k] * x[ib + 5 + k]; s6 += w[k] * x[ib + 6 + k]; s7 += w[k] * x[ib + 7 + k];
            asm volatile("" : "+v"(s0), "+v"(s1), "+v"(s2), "+v"(s3), "+v"(s4), "+v"(s5), "+v"(s6), "+v"(s7));
        }
        Ycol[(ib + 0) * 512] = s0; Ycol[(ib + 1) * 512] = s1; Ycol[(ib + 2) * 512] = s2; Ycol[(ib + 3) * 512] = s3;
        Ycol[(ib + 4) * 512] = s4; Ycol[(ib + 5) * 512] = s5; Ycol[(ib + 6) * 512] = s6; Ycol[(ib + 7) * 512] = s7;
    }
}
__device__ __forceinline__ void conv_win_load(const Args& a, int b, int t0, int tid, v4u (&g)[8]) {
    const bf16* GLU = (const bf16*)(a.ws + WS_GLU);
#pragma unroll
    for (int i = 0; i < 8; ++i) { const int ch = tid + 512 * i, r = ch >> 6, cc = ch & 63;
        const int row = tok_row(b, t0 - 30 + (r < 62 ? r : 61)); g[i] = *(const GAS v4u*)(GLU + (size_t)(row >= 0 ? row : 0) * 512 + cc * 8); }
}
__device__ __forceinline__ void conv_win_store(Frame& F, int b, int t0, int tid, const v4u (&g)[8]) {
    LAS bf16* WIN = (LAS bf16*)(F.lds + L4_WIN);
#pragma unroll
    for (int i = 0; i < 8; ++i) { const int ch = tid + 512 * i, r = ch >> 6, cc = ch & 63;
        if (r < 62) { const int row = tok_row(b, t0 - 30 + r); *(LAS v4u*)(WIN + r * 512 + cc * 8) = row >= 0 ? g[i] : (v4u){0u, 0u, 0u, 0u}; } }
}
__device__ __forceinline__ void conv_win_read(Frame& F, int c, float (&x)[62]) {
    const LAS bf16* WIN = (const LAS bf16*)(F.lds + L4_WIN);
#pragma unroll
    for (int r = 0; r < 62; ++r) x[r] = bf2f(WIN[r * 512 + c]);
}
__device__ __forceinline__ void conv_pair(Frame& F, const Args& a, int bA, int tA, int bB, int tB) {
    LAS float* Y = (LAS float*)(F.lds + L4_Y);
    const int c = F.tid;
    float w[31];
#pragma unroll
    for (int k = 0; k < 31; ++k) w[k] = a.in[17][k * 512 + c];
    const float bias = a.in[18][c];
    float x[62];
    { v4u g[8]; conv_win_load(a, bA, tA, F.tid, g); conv_win_store(F, bA, tA, F.tid, g); }
    __syncthreads();
    conv_win_read(F, c, x);
    v4u gB[8]; conv_win_load(a, bB, tB, F.tid, gB);
    conv_fma32(w, x, bias, Y + c);
    __syncthreads();
    conv_win_store(F, bB, tB, F.tid, gB);
    conv_ln_store(F, a, bA * SEQ + tA);
    __syncthreads();
    conv_win_read(F, c, x);
    conv_fma32(w, x, bias, Y + c);
    __syncthreads();
    conv_ln_store(F, a, bB * SEQ + tB);
    __syncthreads();
}
__device__ __forceinline__ void sample_conv_wave(Frame& F, const Args& a, int s) {
    const bf16* GLU = (const bf16*)(a.ws + WS_GLU); bf16* CA = (bf16*)(a.ws + WS_R1) + 512;
    const int c0 = 8 * F.lane;
    f32x4 acc0 = *(const GAS f32x4*)(a.in[18] + c0), acc1 = *(const GAS f32x4*)(a.in[18] + c0 + 4);
    const float* st = a.in[4] + (size_t)s * 15360 + c0; const float* wd = a.in[17] + c0;
#pragma unroll
    for (int k = 0; k < 30; ++k) {
        acc0 += *(const GAS f32x4*)(wd + k * 512) * NT_LOAD((const GAS f32x4*)(st + k * 512));
        acc1 += *(const GAS f32x4*)(wd + k * 512 + 4) * NT_LOAD((const GAS f32x4*)(st + k * 512 + 4));
    }
    { const v4u gw = *(const GAS v4u*)(GLU + (size_t)(R_SAMPLE + s) * 512 + c0);
      const f32x4 g0 = (f32x4){__uint_as_float(gw.x << 16), __uint_as_float(gw.x & 0xffff0000u), __uint_as_float(gw.y << 16), __uint_as_float(gw.y & 0xffff0000u)};
      const f32x4 g1 = (f32x4){__uint_as_float(gw.z << 16), __uint_as_float(gw.z & 0xffff0000u), __uint_as_float(gw.w << 16), __uint_as_float(gw.w & 0xffff0000u)};
      acc0 += *(const GAS f32x4*)(wd + 30 * 512) * g0; acc1 += *(const GAS f32x4*)(wd + 30 * 512 + 4) * g1; }
    const float mean = wave_sum(pg8::sum4(acc0) + pg8::sum4(acc1)) * (1.0f / 512.0f);
    acc0 = acc0 - mean; acc1 = acc1 - mean;
    const float var = wave_sum(pg8::sumsq4(acc0) + pg8::sumsq4(acc1)) * (1.0f / 512.0f);
    const float rstd = __builtin_amdgcn_rsqf(var + EPS);
    f32x4 y0 = acc0 * rstd * *(const GAS f32x4*)(a.in[19] + c0) + *(const GAS f32x4*)(a.in[20] + c0);
    f32x4 y1 = acc1 * rstd * *(const GAS f32x4*)(a.in[19] + c0 + 4) + *(const GAS f32x4*)(a.in[20] + c0 + 4);
#pragma unroll
    for (int j = 0; j < 4; ++j) { y0[j] = y0[j] * pg8::fast_sigmoid(y0[j]); y1[j] = y1[j] * pg8::fast_sigmoid(y1[j]); }
    *(GAS v4u*)(CA + (size_t)(R_SAMPLE + s) * 1024 + c0) = pg8::pack8(y0, y1);
}

constexpr int L_SIDE = 131072;
static_assert(L_SIDE + 3 * 8 * 1024 <= LDSCTL_OFF, "side scratch vs LDS control words");
template <int K, int LDA, int LDW> __device__ __forceinline__ f32x4 skinny_slice(const bf16* Arow0, const bf16* Wrow0, int lane, int wave) {
    constexpr int KS = K / 8;
    const int fr = lane & 15, fq = lane >> 4;
    const bf16* ap = Arow0 + (size_t)fr * LDA + wave * KS + 8 * fq; const bf16* wp = Wrow0 + (size_t)fr * LDW + wave * KS + 8 * fq;
    f32x4 acc0 = (f32x4){0.f, 0.f, 0.f, 0.f}, acc1 = acc0;
#pragma unroll
    for (int k0 = 0; k0 < KS; k0 += 32) {
        const bf16x8 av = *(const GAS bf16x8*)(ap + k0), wv = *(const GAS bf16x8*)(wp + k0);
        if ((k0 >> 5) & 1) acc1 = __builtin_amdgcn_mfma_f32_16x16x32_bf16(wv, av, acc1, 0, 0, 0); else acc0 = __builtin_amdgcn_mfma_f32_16x16x32_bf16(wv, av, acc0, 0, 0, 0);
    }
    return acc0 + acc1;
}
__device__ __forceinline__ v2u pack4(const f32x4& v) { v2u w; w.x = pg8::cvt_pk_bf16(v[0], v[1]); w.y = pg8::cvt_pk_bf16(v[2], v[3]); return w; }
__device__ __forceinline__ f32x4 unpack4(const v2u& w) { return (f32x4){__uint_as_float(w.x << 16), __uint_as_float(w.x & 0xffff0000u), __uint_as_float(w.y << 16), __uint_as_float(w.y & 0xffff0000u)}; }
__device__ __forceinline__ f32x4 side_reduce(const LAS f32x4* part, int slot, int lane) {
    f32x4 s = part[(slot * 8) * 64 + lane];
#pragma unroll
    for (int w = 1; w < 8; ++w) s += part[(slot * 8 + w) * 64 + lane];
    return s;
}
__device__ __forceinline__ void side_p2(Frame& F, const Args& a, float* ss) {
    const bf16* HID = (const bf16*)(a.ws + WS_R2); const bf16* W2 = (const bf16*)(a.ws + WS_W2A); bf16* HB = (bf16*)a.out;
    float* hside = (float*)(a.ws + WS_HSIDE);
    LAS f32x4* part = (LAS f32x4*)(F.lds + L_SIDE);
    const int fr = F.lane & 15, fq = F.lane >> 4; constexpr int NT = 9 * 64;
    for (int t0 = blockIdx.x; t0 < NT; t0 += 3 * F.G) {
#pragma unroll
    for (int j = 0; j < 3; ++j) { const int t = t0 + j * F.G; if (t < NT) { const int rt = t >> 6, cs = t & 63;
        part[(j * 8 + F.wave) * 64 + F.lane] = skinny_slice<DFF, DFF, DFF>(HID + (size_t)(R_META + 16 * rt) * DFF, W2 + (size_t)(16 * cs) * DFF, F.lane, F.wave); } }
    __syncthreads();
    { const int t = t0 + F.wave * F.G;
      if (F.wave < 3 && t < NT) {
        const int rt = t >> 6, cs = t & 63; const int row0 = R_META + 16 * rt, col = 16 * cs + 4 * fq, row = row0 + fr;
        const f32x4 acc = side_reduce(part, F.wave, F.lane);
        const float* src = rt == 0 ? a.in[5] + (size_t)fr * D : a.in[1] + (size_t)(16 * (rt - 1) + fr) * D;
        const f32x4 h = NT_LOAD((const GAS f32x4*)(src + col)) + acc * 0.5f;
        *(GAS f32x4*)(hside + (size_t)(row - R_META) * D + col) = h;
        *(GAS v2u*)(HB + (size_t)row * D + col) = pack4(h);
        float p = pg8::sumsq4(h); p += __shfl_xor(p, 16); p += __shfl_xor(p, 32);
        if (fq == 0) atomicAdd(ss + row, p);
      } }
    __syncthreads();
    }
}
__device__ __forceinline__ void side_p5(Frame& F, const Args& a) {
    const bf16* AO = (const bf16*)(a.ws + WS_R1); const bf16* CA = AO + 512; const bf16* Wm = (const bf16*)(a.ws + WS_WMIX);
    const bf16* GA = (const bf16*)(a.ws + WS_GA); const bf16* GC = (const bf16*)(a.ws + WS_GC); bf16* MIXB = (bf16*)(a.ws + WS_MIXB);
    LAS f32x4* part = (LAS f32x4*)(F.lds + L_SIDE);
    const int fr = F.lane & 15, fq = F.lane >> 4; constexpr int NT = 8 * 64;
    for (int t0 = blockIdx.x; t0 < NT; t0 += 2 * F.G) {
#pragma unroll
    for (int j = 0; j < 2; ++j) { const int t = t0 + j * F.G; if (t < NT) { const int rt = t >> 6, cs = t & 63; const int row0 = R_SAMPLE + 16 * rt, col = 16 * cs + 4 * fq, row = row0 + fr;
        const f32x4 p1 = skinny_slice<512, 1024, 1024>(AO + (size_t)row0 * 1024, Wm + (size_t)(16 * cs) * 1024, F.lane, F.wave);
        const f32x4 p2 = skinny_slice<512, 1024, 1024>(CA + (size_t)row0 * 1024, Wm + (size_t)(16 * cs) * 1024 + 512, F.lane, F.wave);
        const v2u gaw = *(const GAS v2u*)(GA + (size_t)row * D + col), gcw = *(const GAS v2u*)(GC + (size_t)row * D + col);
        part[(j * 8 + F.wave) * 64 + F.lane] = unpack4(gaw) * p1 + unpack4(gcw) * p2; } }
    __syncthreads();
    { const int t = t0 + F.wave * F.G;
      if (F.wave < 2 && t < NT) {
        const int rt = t >> 6, cs = t & 63; const int row0 = R_SAMPLE + 16 * rt, col = 16 * cs + 4 * fq, row = row0 + fr;
        *(GAS v2u*)(MIXB + (size_t)row * D + col) = pack4(side_reduce(part, F.wave, F.lane));
      } }
    __syncthreads();
    }
}
__device__ __forceinline__ void side_p6(Frame& F, const Args& a, float* ss) {
    const bf16* MIXB = (const bf16*)(a.ws + WS_MIXB); const bf16* Wo = (const bf16*)(a.ws + WS_WOUT); bf16* H2B = (bf16*)(a.ws + WS_R1);
    float* hside = (float*)(a.ws + WS_HSIDE);
    LAS f32x4* part = (LAS f32x4*)(F.lds + L_SIDE);
    const int fr = F.lane & 15, fq = F.lane >> 4; constexpr int NT = 8 * 64;
    for (int t0 = blockIdx.x; t0 < NT; t0 += 2 * F.G) {
#pragma unroll
    for (int j = 0; j < 2; ++j) { const int t = t0 + j * F.G; if (t < NT) { const int rt = t >> 6, cs = t & 63;
        part[(j * 8 + F.wave) * 64 + F.lane] = skinny_slice<D, D, D>(MIXB + (size_t)(R_SAMPLE + 16 * rt) * D, Wo + (size_t)(16 * cs) * D, F.lane, F.wave); } }
    __syncthreads();
    { const int t = t0 + F.wave * F.G;
      if (F.wave < 2 && t < NT) {
        const int rt = t >> 6, cs = t & 63; const int row0 = R_SAMPLE + 16 * rt, col = 16 * cs + 4 * fq, row = row0 + fr;
        const f32x4 acc = side_reduce(part, F.wave, F.lane);
        GAS f32x4* hp = (GAS f32x4*)(hside + (size_t)(row - R_META) * D + col);
        const f32x4 h = *hp + acc;
        *hp = h;
        *(GAS v2u*)(H2B + (size_t)row * D + col) = pack4(h);
        float p = pg8::sumsq4(h); p += __shfl_xor(p, 16); p += __shfl_xor(p, 32);
        if (fq == 0) atomicAdd(ss + row, p);
      } }
    __syncthreads();
    }
}
__device__ __forceinline__ void side_p8(Frame& F, const Args& a) {
    const bf16* HID = (const bf16*)(a.ws + WS_R2); const bf16* W2 = (const bf16*)(a.ws + WS_W2B);
    const float* hside = (const float*)(a.ws + WS_HSIDE);
    LAS f32x4* part = (LAS f32x4*)(F.lds + L_SIDE);
    const int fr = F.lane & 15, fq = F.lane >> 4; constexpr int NT = 8 * 64;
    for (int t0 = blockIdx.x; t0 < NT; t0 += 2 * F.G) {
#pragma unroll
    for (int j = 0; j < 2; ++j) { const int t = t0 + j * F.G; if (t < NT) { const int rt = t >> 6, cs = t & 63;
        part[(j * 8 + F.wave) * 64 + F.lane] = skinny_slice<DFF, DFF, DFF>(HID + (size_t)(R_SAMPLE + 16 * rt) * DFF, W2 + (size_t)(16 * cs) * DFF, F.lane, F.wave); } }
    __syncthreads();
    { const int t = t0 + F.wave * F.G;
      if (F.wave < 2 && t < NT) {
        const int rt = t >> 6, cs = t & 63; const int row0 = R_SAMPLE + 16 * rt, col = 16 * cs + 4 * fq, row = row0 + fr;
        const f32x4 acc = side_reduce(part, F.wave, F.lane);
        const f32x4 h = *(const GAS f32x4*)(hside + (size_t)(row - R_META) * D + col);
        *(GAS f32x4*)(a.out + O_YS + (size_t)(row - R_SAMPLE) * D + col) = h + acc * 0.5f;
      } }
    __syncthreads();
    }
}

__device__ __forceinline__ void p4_mixers(Frame& F, const Args& a) {
    { LAS float* tab = (LAS float*)(F.lds + L4_TAB);
      for (int i = F.tid; i < 8 * 192; i += NWAVES * 64) { const int h = i / 192, d = i % 192 - 32; tab[i] = (d >= 0 && d < 128) ? a.in[14][t5_bucket(d) * 8 + h] : -1e30f; }
      __syncthreads(); }
    const int G = F.G, c = blockIdx.x;
#ifdef P4_COPY
    { const v4u* q = (const v4u*)(a.ws + WS_QB); const v4u* g = (const v4u*)(a.ws + WS_GLU); v4u* ao = (v4u*)(a.ws + WS_R1); v4u* ca = ao + (size_t)MP * 64;
      for (size_t i = (size_t)c * 512 + F.tid; i < (size_t)MP * 64; i += (size_t)G * 512) { ao[i] = q[i]; ca[i] = g[i]; } return; }
#endif
#ifndef P4_MASK
#define P4_MASK 15
#endif
#ifndef P4_DUP
#define P4_DUP 0
#endif
    if (P4_MASK & 1) for (int u = c; u < ((P4_DUP & 1) ? 512 : 256); u += G) attn_unit(F, a, (u & 255) >> 7, (u >> 6) & 1, u & 63);
    if (P4_MASK & 2) for (int u = c; u < ((P4_DUP & 2) ? 512 : 256); u += G) { const int uA = 2 * (u & 255), uB = uA + 1; conv_pair(F, a, uA >> 8, 32 * (uA & 255), uB >> 8, 32 * (uB & 255)); }
    if (P4_MASK & 4) for (int t = c * 4 + (F.wave & 3); t < ((P4_DUP & 4) ? 2048 : 1024) && F.wave < 4; t += G * 4) sample_attn_wave(F, a, (t & 1023) >> 3, t & 7, F.wave);
    if (P4_MASK & 8) for (int t = c * 4 + (F.wave & 3); t < ((P4_DUP & 8) ? 1152 : 128) && F.wave >= 4; t += G * 4) sample_conv_wave(F, a, t & 127);
}

__global__ void __launch_bounds__(NWAVES * 64, 2) mk_fwd(Args args) {
    extern __shared__ __attribute__((aligned(16))) unsigned char lds[];
    Frame F;
    F.lds = (LAS unsigned char*)lds;
    F.MISC = (volatile LAS unsigned*)(F.lds + MISC_OFF);
    F.tid = threadIdx.x; F.lane = F.tid & 63; F.wave = __builtin_amdgcn_readfirstlane(F.tid >> 6);
    F.G = gridDim.x;
    unsigned char* ws = args.ws;
    F.ctl = (gu32*)(ws + WS_CTL);
    for (int u = F.tid; u < (LDS_BYTES - LDSCTL_OFF) / 4; u += NWAVES * 64) ((LAS unsigned*)(F.lds + LDSCTL_OFF))[u] = 0u;
    __syncthreads();
    XcdBarrier bar; bar.bar = (unsigned*)(F.ctl + CW_BAR); bar.x = 0; bar.st = nullptr;
    if (!MK_SPLIT) bar = xcd_barrier_post((unsigned*)(F.ctl + CW_BAR), F.MISC + 8);
    const int lo = args.ph_lo, hi = args.ph_hi;
#ifndef PH_MASK
#define PH_MASK 0x1ff
#endif
#define IN(k) (((PH_MASK >> (k)) & 1) && lo <= (k) && (k) < hi)
#define SEAM(k) do { if (IN(k) && IN((k) + 1)) xcd_barrier(bar); } while (0)
#ifndef MULTI_ALIGN
#define MULTI_ALIGN true
#endif
#ifndef MULTI_SP2
#define MULTI_SP2 true
#endif
#ifndef AUXA_DOWN
#define AUXA_DOWN 0
#endif
#ifndef DUP_MASK
#define DUP_MASK 0
#endif
#define REP(k) for (int rep_ = 0; rep_ < (((DUP_MASK >> (k)) & 1) ? 2 : 1); ++rep_)
    const int bx = blockIdx.x;
    float* const ss1 = (float*)(F.ctl + CW_SS1); float* const ss2 = (float*)(F.ctl + CW_SS2); float* const ss3 = (float*)(F.ctl + CW_SS3);
    float* const outy = args.out + O_Y; float* const outys = args.out + O_YS; float* const hside = (float*)(ws + WS_HSIDE);
    bf16* const R1 = (bf16*)(ws + WS_R1); bf16* const HID = (bf16*)(ws + WS_R2); bf16* const HB = (bf16*)args.out;

#ifdef PROBE_TWICE
    for (int whole_ = 0; whole_ < 2; ++whole_) {
    if (whole_ == 1) { xcd_barrier(bar); for (int i = bx * 512 + F.tid; i < 2 * MP; i += F.G * 512) ss2[i] = 0.f; xcd_barrier(bar); }
#endif
    if (IN(0)) REP(0) { p0_prologue(F, args);
#ifdef NO_IDLE_ITEMS
        p0_items(F, args, P0_B0, P0_C0 + P0_C_P3, bx, F.G);
#endif
#ifdef COPIES_IN_P0
        p0_copies(F, args, bx, F.G);
#endif
        SEAM(0); }
    if (IN(1)) REP(1) {
        pg8::Gemm g{R1, (const bf16*)(ws + WS_W13A), MP, 2 * DFF, D}; pg8::StaticOrder S; S.init(MP, 2 * DFF, F.G, bx);
        pg8::EpiUp E{HID, DFF, ss1};
        pg8::gemm_phase<pg8::EpiUp, pg8::StaticOrder, MULTI_ALIGN, MULTI_SP2>(F.lds, g, S, E);
        { const int nu = NTM * 22, rem = nu % F.G;
#ifndef NO_IDLE_ITEMS
          if (rem == 0) p0_items(F, args, P0_B0, P0_C0, bx, F.G); else if (bx >= rem) p0_items(F, args, P0_B0, P0_C0, bx - rem, F.G - rem);
#endif
        }
        SEAM(1);
    }
#ifdef PROBE_P1
    if (IN(1)) {
        pg8::Gemm g{R1, (const bf16*)(ws + WS_W13A), MP, 2 * DFF, D}; pg8::StaticOrder S; S.init(MP, 2 * DFF, F.G, bx);
        pg8::EpiUp E{HID, DFF, ss1};
        pg8::gemm_phase<pg8::EpiUp, pg8::StaticOrder, true, true>(F.lds, g, S, E);
        if (PROBE_P1 == 2) { const int nu = NTM * 22, rem = nu % F.G; if (bx >= rem) p0_items(F, args, P0_B0, P0_C0, bx - rem, F.G - rem); }
        xcd_barrier(bar);
    }
#endif
#ifdef PROBE_P2
    if (IN(2)) { float* const ssd = (PROBE_P2 >= 3) ? nullptr : (float*)(F.ctl + CW_SS3 + MP);
        if (PROBE_P2 == 1) side_p2(F, args, ssd);
        pg8::Gemm g{HID, (const bf16*)(ws + WS_W2A), NPROMPT, D, DFF}; pg8::StaticOrder S; S.init(NPROMPT, D, F.G, bx);
        pg8::EpiRes<0> E{nullptr, R1, nullptr, HB, ssd};
        pg8::gemm_phase<pg8::EpiRes<0>, pg8::StaticOrder, true, true>(F.lds, g, S, E);
        xcd_barrier(bar); }
#endif
#ifdef PROBE_P6
    if (IN(2)) { float* const ssd = (float*)(F.ctl + CW_SS3 + MP);
        pg8::Gemm g{HID, (const bf16*)(ws + WS_W2A), NPROMPT, D, D}; pg8::StaticOrder S; S.init(NPROMPT, D, F.G, bx);
        pg8::EpiRes<1> E{nullptr, R1, nullptr, (bf16*)(ws + WS_MIX), ssd};
        pg8::gemm_phase<pg8::EpiRes<1>, pg8::StaticOrder, true, true>(F.lds, g, S, E);
        xcd_barrier(bar); }
#endif
    if (IN(2)) REP(2) {
        pg8::Gemm g{HID, (const bf16*)(ws + WS_W2A), NPROMPT, D, DFF}; pg8::StaticOrder S; S.init(NPROMPT, D, F.G, bx);
        pg8::EpiRes<0> E{nullptr, R1, nullptr, HB, ss2};
        struct Post2 { Frame& F; const Args& a; float* ss; __device__ __forceinline__ void operator()() const { side_p2(F, a, ss); } } post{F, args, ss2};
        pg8::gemm_phase<pg8::EpiRes<0>, pg8::StaticOrder, true, true, Post2, AUXA_DOWN>(F.lds, g, S, E, post);
        SEAM(2);
    }
#ifdef PROBE_BAR
    if (IN(2)) { for (int i_ = 0; i_ < PROBE_BAR; ++i_) xcd_barrier(bar); }
#endif
#ifdef PROBE_GEMM
    if (IN(2)) {
        if (PROBE_GEMM == 2) { pg8::Gemm g{HID, (const bf16*)(ws + WS_W2A), NPROMPT, D, DFF}; pg8::StaticOrder S; S.init(NPROMPT, D, F.G, bx); pg8::EpiNull E{hside}; pg8::gemm_phase<pg8::EpiNull, pg8::StaticOrder, true, true>(F.lds, g, S, E); }
        if (PROBE_GEMM == 1) { pg8::Gemm g{HID, (const bf16*)(ws + WS_W13A), MP, 2 * DFF, D}; pg8::StaticOrder S; S.init(MP, 2 * DFF, F.G, bx); pg8::EpiNull E{hside}; pg8::gemm_phase<pg8::EpiNull, pg8::StaticOrder, true, true>(F.lds, g, S, E); }
        if (PROBE_GEMM == 6) { pg8::Gemm g{HID, (const bf16*)(ws + WS_WOUT), NPROMPT, D, D}; pg8::StaticOrder S; S.init(NPROMPT, D, F.G, bx); pg8::EpiNull E{hside}; pg8::gemm_phase<pg8::EpiNull, pg8::StaticOrder, true, true>(F.lds, g, S, E); }
        xcd_barrier(bar);
    }
#endif
#ifdef PROBE_P12
    if (IN(2)) { float* const ssd = (float*)(F.ctl + CW_SS3 + MP);
        { pg8::Gemm g{R1, (const bf16*)(ws + WS_W13A), MP, 2 * DFF, D}; pg8::StaticOrder S; S.init(MP, 2 * DFF, F.G, bx);
          pg8::EpiUp E{HID, DFF, ss1};
          pg8::gemm_phase<pg8::EpiUp, pg8::StaticOrder, true, true>(F.lds, g, S, E); }
        xcd_barrier(bar);
        { pg8::Gemm g{HID, (const bf16*)(ws + WS_W2A), NPROMPT, D, DFF}; pg8::StaticOrder S; S.init(NPROMPT, D, F.G, bx);
          pg8::EpiRes<0> E{nullptr, R1, nullptr, HB, ssd};
          pg8::gemm_phase<pg8::EpiRes<0>, pg8::StaticOrder, true, true>(F.lds, g, S, E); }
        xcd_barrier(bar);
    }
#endif
    if (IN(3)) REP(3) {
        pg8::Gemm g{HB, (const bf16*)(ws + WS_WIN), MP, NIN, D}; pg8::StaticOrder S; S.init(MP, NIN, F.G, bx);
        pg8::EpiWin E{ss2, args.in[12], args.in[13], ws, args.out};
        pg8::gemm_phase<pg8::EpiWin, pg8::StaticOrder, MULTI_ALIGN, MULTI_SP2>(F.lds, g, S, E);
        { const int nu = NTM * 15, rem = nu % F.G;
#ifndef NO_IDLE_ITEMS
          if (rem == 0) p0_items(F, args, P0_C0, P0_C0 + P0_C_P3, bx, F.G); else if (bx >= rem) p0_items(F, args, P0_C0, P0_C0 + P0_C_P3, bx - rem, F.G - rem);
#endif
        }
        SEAM(3);
    }
#ifdef PROBE_P3
    if (IN(3)) {
        pg8::Gemm g{HB, (const bf16*)(ws + WS_WIN), MP, NIN, D}; pg8::StaticOrder S; S.init(MP, NIN, F.G, bx);
        pg8::EpiWin E{ss2, args.in[12], args.in[13], ws, args.out};
        pg8::gemm_phase<pg8::EpiWin, pg8::StaticOrder, true, true>(F.lds, g, S, E);
        if (PROBE_P3 == 2) { const int nu = NTM * 15, rem = nu % F.G; if (bx >= rem) p0_items(F, args, P0_C0, P0_C0 + P0_C_P3, bx - rem, F.G - rem); }
        xcd_barrier(bar);
    }
#endif
    if (IN(4)) REP(4) { p4_mixers(F, args); VM_WAIT(); __syncthreads(); SEAM(4); }
#ifdef PROBE_P4
    if (IN(4)) { p4_mixers(F, args); VM_WAIT(); __syncthreads(); xcd_barrier(bar); }
#endif
    if (IN(5)) REP(5) {
        pg8::Gemm g{R1, (const bf16*)(ws + WS_WMIX), NPROMPT, D, D}; pg8::StaticOrder S; S.init(NPROMPT, D, F.G, bx);
        pg8::EpiMix E{(const bf16*)(ws + WS_GA), (const bf16*)(ws + WS_GC), (bf16*)(ws + WS_MIXB)};
        struct Post5 { Frame& F; const Args& a; __device__ __forceinline__ void operator()() const { side_p5(F, a); } } post{F, args};
        pg8::gemm_phase<pg8::EpiMix, pg8::StaticOrder, true, true, Post5>(F.lds, g, S, E, post);
        SEAM(5);
    }
#ifdef PROBE_P5
    if (IN(5)) {
        side_p5(F, args);
        pg8::Gemm g{R1, (const bf16*)(ws + WS_WMIX), NPROMPT, D, D}; pg8::StaticOrder S; S.init(NPROMPT, D, F.G, bx);
        pg8::EpiMix E{(const bf16*)(ws + WS_GA), (const bf16*)(ws + WS_GC), (bf16*)(ws + WS_MIXB)};
        pg8::gemm_phase<pg8::EpiMix, pg8::StaticOrder, true, true>(F.lds, g, S, E);
        SEAM(5);
    }
#endif
    if (IN(6)) REP(6) {
#ifdef P6_TEST
        pg8::Gemm g{(const bf16*)(ws + P6_TEST), (const bf16*)(ws + WS_WOUT), MP, D, D}; pg8::StaticOrder S; S.init(MP, D, F.G, bx);
        pg8::EpiRes<1> E{nullptr, HB, nullptr, (bf16*)(ws + WS_MIX), ss3};
#else
        pg8::Gemm g{(const bf16*)(ws + WS_MIXB), (const bf16*)(ws + WS_WOUT), NPROMPT, D, D}; pg8::StaticOrder S; S.init(NPROMPT, D, F.G, bx);
        pg8::EpiRes<1> E{nullptr, HB, nullptr, R1, ss3};
#endif
        struct Post6 { Frame& F; const Args& a; float* ss; __device__ __forceinline__ void operator()() const {
#ifndef P6_TEST
            side_p6(F, a, ss);
#endif
        } } post{F, args, ss3};
        pg8::gemm_phase<pg8::EpiRes<1>, pg8::StaticOrder, true, true, Post6>(F.lds, g, S, E, post);
        SEAM(6);
    }
#ifdef PROBE_P56
    if (IN(6)) { float* const ssd = (float*)(F.ctl + CW_SS3 + MP);
        xcd_barrier(bar);
        { side_p5(F, args);
          pg8::Gemm g{R1  , (const bf16*)(ws + WS_WMIX), NPROMPT, D, D}; pg8::StaticOrder S; S.init(NPROMPT, D, F.G, bx);
          pg8::EpiMix E{(const bf16*)(ws + WS_GA), (const bf16*)(ws + WS_GC), (bf16*)(ws + WS_MIX)};
          pg8::gemm_phase<pg8::EpiMix, pg8::StaticOrder, true, true>(F.lds, g, S, E); }
        xcd_barrier(bar);
        { pg8::Gemm g{(const bf16*)(ws + WS_MIX), (const bf16*)(ws + WS_WOUT), NPROMPT, D, D}; pg8::StaticOrder S; S.init(NPROMPT, D, F.G, bx);
          pg8::EpiRes<1> E{nullptr, HB, nullptr, (bf16*)(ws + WS_MIXB), ssd};
          pg8::gemm_phase<pg8::EpiRes<1>, pg8::StaticOrder, true, true>(F.lds, g, S, E); }
    }
#endif
    if (IN(7)) REP(7) {
        pg8::Gemm g{R1, (const bf16*)(ws + WS_W13B), MP, 2 * DFF, D}; pg8::StaticOrder S; S.init(MP, 2 * DFF, F.G, bx);
        pg8::EpiUp E{HID, DFF, ss3};
        pg8::gemm_phase<pg8::EpiUp, pg8::StaticOrder, MULTI_ALIGN, MULTI_SP2>(F.lds, g, S, E);
#ifndef COPIES_IN_P0
        { const int nu = NTM * 22, rem = nu % F.G;
          if (rem == 0) p0_copies(F, args, bx, F.G); else if (bx >= rem) p0_copies(F, args, bx - rem, F.G - rem); }
#endif
        SEAM(7);
    }
    if (IN(8)) REP(8) {
        pg8::Gemm g{HID, (const bf16*)(ws + WS_W2B), NPROMPT, D, DFF}; pg8::StaticOrder S; S.init(NPROMPT, D, F.G, bx);
        pg8::EpiRes<2> E{nullptr, R1, outy, nullptr, nullptr};
        struct Post8 { Frame& F; const Args& a; __device__ __forceinline__ void operator()() const { side_p8(F, a); } } post{F, args};
        pg8::gemm_phase<pg8::EpiRes<2>, pg8::StaticOrder, true, true, Post8, AUXA_DOWN>(F.lds, g, S, E, post);
    }
#ifdef PROBE_P8
    if (IN(8)) {
        xcd_barrier(bar);
        side_p8(F, args);
        pg8::Gemm g{HID, (const bf16*)(ws + WS_W2B), NPROMPT, D, DFF}; pg8::StaticOrder S; S.init(NPROMPT, D, F.G, bx);
        pg8::EpiRes<2> E{nullptr, R1, outy, nullptr, nullptr};
        pg8::gemm_phase<pg8::EpiRes<2>, pg8::StaticOrder, true, true>(F.lds, g, S, E);
    }
#endif
#ifdef PROBE_P0_END
    if (IN(8)) { xcd_barrier(bar); p0_prologue(F, args); }
#endif
#ifdef PROBE_TWICE
    }
#endif
#undef IN
#undef SEAM
}

extern "C" void kernel_launch(void* const* d_in, const int* in_sizes, int n_in, void* d_out, int out_size, void* d_ws, size_t ws_size, hipStream_t stream) {
    static int grid = 0;
    if (grid == 0) {
        if (n_in != 27 || ws_size < WS_END) { fprintf(stderr, "kernel_launch: unexpected n_in %d / ws %zu\n", n_in, ws_size); grid = -1; return; }
        int dev = 0, cus = 0, per_cu = 0;
        if (hipGetDevice(&dev) != hipSuccess || hipDeviceGetAttribute(&cus, hipDeviceAttributeMultiprocessorCount, dev) != hipSuccess) { grid = -1; return; }
        if (hipFuncSetAttribute((const void*)mk_fwd, hipFuncAttributeMaxDynamicSharedMemorySize, LDS_BYTES) != hipSuccess) { fprintf(stderr, "kernel_launch: hipFuncSetAttribute failed\n"); grid = -1; return; }
        if (hipOccupancyMaxActiveBlocksPerMultiprocessor(&per_cu, (const void*)mk_fwd, NWAVES * 64, LDS_BYTES) != hipSuccess || per_cu < 1) { fprintf(stderr, "kernel_launch: occupancy query failed (%d)\n", per_cu); (void)hipGetLastError(); per_cu = 1; }
        grid = cus * 1;
        fprintf(stderr, "kernel_launch: cus %d per_cu %d grid %d\n", cus, per_cu, grid);
    }
    if (grid < 0) return;
    (void)hipMemsetAsync((char*)d_ws + WS_CTL, 0, CTL_ZERO_BYTES, stream);
    Args a{};
    for (int i = 0; i < 27; ++i) a.in[i] = (const float*)d_in[i];
    a.out = (float*)d_out; a.ws = (unsigned char*)d_ws;
#if MK_SPLIT
    for (int p = 0; p < N_PHASES; ++p) { a.ph_lo = p; a.ph_hi = p + 1; hipLaunchKernelGGL(mk_fwd, dim3(grid), dim3(NWAVES * 64), LDS_BYTES, stream, a); }
#else
    a.ph_lo = 0; a.ph_hi = N_PHASES;
    void* kargs[] = {&a};
#ifdef PROBE_PLAIN_LAUNCH
    hipLaunchKernelGGL(mk_fwd, dim3(grid), dim3(NWAVES * 64), LDS_BYTES, stream, a); hipError_t e = hipSuccess; (void)kargs;
#else
    hipError_t e = hipLaunchCooperativeKernel((const void*)mk_fwd, dim3(grid), dim3(NWAVES * 64), kargs, LDS_BYTES, stream);
#endif
    if (e != hipSuccess) fprintf(stderr, "kernel_launch: cooperative launch failed: %s (grid %d)\n", hipGetErrorString(e), grid);
#ifdef PROBE_EMPTY_LAUNCH
    { Args a2 = a; a2.ph_lo = 0; a2.ph_hi = 0; void* kargs2[] = {&a2};
      (void)hipLaunchCooperativeKernel((const void*)mk_fwd, dim3(grid), dim3(NWAVES * 64), kargs2, LDS_BYTES, stream); }
#endif
#ifdef PROBE_2LAUNCH
    (void)hipMemsetAsync((char*)d_ws + WS_CTL, 0, CTL_ZERO_BYTES, stream);
    (void)hipLaunchCooperativeKernel((const void*)mk_fwd, dim3(grid), dim3(NWAVES * 64), kargs, LDS_BYTES, stream);
#endif
#endif
}
```

```cpp
#define MK_SPLIT 0
#include <hip/hip_runtime.h>
#include <cstdio>
#include <cstdint>

constexpr int NWAVES = 8;
#ifndef MK_SPLIT
#define MK_SPLIT 0
#endif
constexpr int N_PHASES = 9;

constexpr int D = 1024, DFF = 2816, SEQ = 8192, NPROMPT = 16384, R_META = 16384, R_SAMPLE = 16400, R_END = 16528, MP = 16640, NTM = 65;
constexpr int NIN = 3840;
constexpr float EPS = 1e-6f;
constexpr size_t O_Y = 0, O_YS = 16777216, O_NKP = 16908288, O_NVP = 16941056, O_NCP = 16973824, O_NKS = 17004544, O_NVS = 19101696, O_NCS = 21198848;

constexpr size_t MiB = 1u << 20;
constexpr size_t WS_CTL = 0, CTL_ZERO_BYTES = 1 * MiB;
constexpr size_t WS_HSIDE = 1 * MiB;
constexpr size_t WS_W13A = 2 * MiB, WS_W2A = 13 * MiB, WS_WIN = 19 * MiB, WS_WMIX = 27 * MiB, WS_WOUT = 29 * MiB, WS_W13B = 31 * MiB, WS_W2B = 42 * MiB;
constexpr size_t WS_R1 = 48 * MiB;
constexpr size_t WS_R2 = 81 * MiB;
constexpr size_t WS_R3 = 171 * MiB;
constexpr size_t SZ_ROWS1K = (size_t)MP * 1024 * 2;
constexpr size_t WS_GA = WS_R2, WS_GC = WS_R2 + SZ_ROWS1K;
constexpr size_t WS_QB = WS_R3, WS_KB = WS_QB + (size_t)MP * 512 * 2, WS_VB = WS_KB + (size_t)MP * 128 * 2, WS_GLU = WS_VB + (size_t)MP * 128 * 2;
constexpr size_t WS_MIXB = WS_R3, WS_MIX = WS_R3 + 41 * MiB;
constexpr size_t WS_END = 256 * MiB;
static_assert(WS_W2B + (size_t)1024 * 2816 * 2 <= WS_R1 && WS_R1 + SZ_ROWS1K <= WS_R2 && WS_R2 + (size_t)MP * 2816 * 2 <= WS_R3 && WS_GC + SZ_ROWS1K <= WS_R3, "ws map 1");
static_assert(WS_GLU + (size_t)MP * 512 * 2 <= WS_MIX && WS_MIXB + SZ_ROWS1K <= WS_MIX && WS_MIX + SZ_ROWS1K <= WS_END, "ws map 2");
constexpr int CW_TMO = 0;
constexpr int CW_BAR = 4096;
constexpr int CW_SS1 = 32768, CW_SS2 = CW_SS1 + MP, CW_SS3 = CW_SS2 + MP;
static_assert((CW_SS3 + MP) * 4 <= (int)CTL_ZERO_BYTES, "ctl");

constexpr int RING_BYTES = 131072, LDSCTL_OFF = 159744, MISC_OFF = LDSCTL_OFF + 320, LDS_BYTES = 163840;

#define GAS __attribute__((address_space(1)))
#define LAS __attribute__((address_space(3)))
typedef unsigned short bf16;
typedef unsigned v4u __attribute__((ext_vector_type(4)));
typedef unsigned v2u __attribute__((ext_vector_type(2)));
typedef float f32x4 __attribute__((ext_vector_type(4)));
typedef float f32x16 __attribute__((ext_vector_type(16)));
typedef short bf16x8 __attribute__((ext_vector_type(8)));
typedef GAS unsigned gu32;
#define RLX_AGENT __ATOMIC_RELAXED, __HIP_MEMORY_SCOPE_AGENT
#define LDS_WAIT() asm volatile("s_waitcnt lgkmcnt(0)" ::: "memory")
#define VM_WAIT() asm volatile("s_waitcnt vmcnt(0)" ::: "memory")
__device__ __forceinline__ unsigned f2bf(float f) { unsigned u = __builtin_bit_cast(unsigned, f); return (u + 0x7fffu + ((u >> 16) & 1u)) >> 16; }
__device__ __forceinline__ unsigned pk2(float lo, float hi) { return f2bf(lo) | (f2bf(hi) << 16); }
__device__ __forceinline__ float bf2f(unsigned short h) { return __uint_as_float((unsigned)h << 16); }
#ifndef PG8_WGM
#define PG8_WGM 8
#endif
namespace pg8 {
#define PG8_LAS __attribute__((address_space(3)))
typedef unsigned short bf16_t;
typedef short bf16x8 __attribute__((ext_vector_type(8)));
typedef float f32x4 __attribute__((ext_vector_type(4)));
typedef unsigned u32x4 __attribute__((ext_vector_type(4)));
constexpr int BM = 256, BK = 64, HALF = 128, HTB = HALF * BK * 2  , STAGE_BYTES = 8 * HTB, NXCD = 8, WGM = PG8_WGM;

__host__ __device__ __forceinline__ int lds_byte(int r, int c) { const int st = (r >> 4) * 2 + (c >> 5), rr = r & 15, cc = c & 31, ob = rr * 64 + cc * 2; return st * 1024 + (ob ^ (((ob >> 9) & 1) << 5)); }
__host__ __device__ __forceinline__ void stage_rc(int b, int& R, int& C) { const int st = b / 1024, sb = b % 1024, swz = sb ^ (((sb >> 9) & 1) << 5); R = (st >> 1) * 16 + swz / 64; C = (st & 1) * 32 + (swz % 64) / 2; }
__host__ __device__ __forceinline__ int perm32(int rho) { const int n = rho >> 4, i = rho & 15; return 8 * (i >> 2) + 4 * n + (i & 3); }

struct Unit { int pm, pn; };
struct Gemm { const bf16_t* A; const bf16_t* Bt; int M, N, K; };

struct StaticOrder {
    int nM, nN, nwg, G, c;
    __host__ __device__ void init(int M, int N, int G_, int c_) { nM = M / BM; nN = N / BM; nwg = nM * nN; G = G_; c = c_; }
    __host__ __device__ bool next(int i, Unit& u) const {
        const long L = (long)i * G + c; if (L >= nwg) return false;
        int wgid = (int)L; { const int q = nwg / NXCD, r = nwg % NXCD, xcd = wgid % NXCD, off = wgid / NXCD; wgid = (xcd < r ? xcd * (q + 1) : r * (q + 1) + (xcd - r) * q) + off; }
        const int nig = WGM * nN, gid = wgid / nig, fm = gid * WGM, gsz = (nM - fm) < WGM ? (nM - fm) : WGM;
        u.pm = fm + ((wgid % nig) % gsz); u.pn = (wgid % nig) / gsz; return true;
    }
    __device__ __forceinline__ void a_ready(const Unit&) const {}
    __device__ __forceinline__ void done(const Unit&) const {}
};

struct MainSideOrder {
    static constexpr int PMS = 64;
    StaticOrder m; int nmain, sidepn; unsigned* seamw;
    __device__ __forceinline__ void init(int Mmain, int N, int G, int c, unsigned* seamw_, int& ir, int& nidle) {
        m.init(Mmain, N, G, c); seamw = seamw_;
        nmain = c < m.nwg ? (m.nwg - 1 - c) / G + 1 : 0;
        const int rem = m.nwg % G; nidle = rem == 0 ? G : G - rem; ir = rem == 0 ? c : c - rem;
        sidepn = (ir >= 0 && ir < m.nN) ? ir : -1;
    }
    __device__ __forceinline__ bool next(int i, Unit& u) const {
        if (i < nmain) return m.next(i, u);
        if (i > nmain || sidepn < 0) return false;
        u.pm = PMS; u.pn = sidepn; return true;
    }
    __device__ __forceinline__ void a_ready(const Unit& u) const {
        if (seamw && u.pm == PMS) {
            unsigned sp = 0;
            while (__hip_atomic_load(seamw, __ATOMIC_RELAXED, __HIP_MEMORY_SCOPE_AGENT) < 8u) { __builtin_amdgcn_s_sleep(1); if (++sp > (1u << 22)) break; }
            __builtin_amdgcn_fence(__ATOMIC_ACQUIRE, "agent");
            asm volatile("s_waitcnt vmcnt(0)" ::: "memory");
        }
    }
    __device__ __forceinline__ void done(const Unit&) const {}
};
typedef float f32x2 __attribute__((ext_vector_type(2)));
typedef __bf16 bf16x2_t __attribute__((ext_vector_type(2)));
__device__ __forceinline__ unsigned cvt_pk_bf16(float lo, float hi) { const f32x2 v = {lo, hi}; const bf16x2_t b = __builtin_convertvector(v, bf16x2_t); return __builtin_bit_cast(unsigned, b); }

constexpr int ROWS_PROMPT = 16384, ROW_META = 16384, ROW_SAMPLE = 16400, ROW_END = 16528, MPAD = 16640, DM = 1024;
constexpr float LOG2E = 1.4426950408889634f;
__device__ __forceinline__ float fast_sigmoid(float x) { return __builtin_amdgcn_rcpf(1.0f + __builtin_amdgcn_exp2f(-x * LOG2E)); }
__device__ __forceinline__ u32x4 pack8(const f32x4& a, const f32x4& b) { u32x4 w; w.x = cvt_pk_bf16(a[0], a[1]); w.y = cvt_pk_bf16(a[2], a[3]); w.z = cvt_pk_bf16(b[0], b[1]); w.w = cvt_pk_bf16(b[2], b[3]); return w; }
#ifndef MID_BATCH_MASK
#define MID_BATCH_MASK 1
#endif
#ifndef RES_WT
#define RES_WT 0
#endif
#ifndef MIX_WT
#define MIX_WT 0
#endif
#ifndef WIDE_ST
#define WIDE_ST 1
#endif
#ifndef Y_FULL_LINES
#define Y_FULL_LINES 1
#endif
#ifndef MIX_PRELOAD16
#define MIX_PRELOAD16 0
#endif
#ifndef PF_RES
#define PF_RES 0
#endif
#ifndef PF_MIX
#define PF_MIX 0
#endif
#ifndef NT_RES
#define NT_RES 0
#endif
#ifndef NT_Y
#define NT_Y 1
#endif
#if NT_RES
#define RES_LOAD(p) __builtin_nontemporal_load(p)
#else
#define RES_LOAD(p) (*(p))
#endif
#if NT_Y >= 2
#if NT_Y == 2
#define Y_FLAVOUR "sc1 nt"
#elif NT_Y == 3
#define Y_FLAVOUR "sc0 sc1 nt"
#elif NT_Y == 4
#define Y_FLAVOUR "sc0 sc1"
#else
#define Y_FLAVOUR "sc0 nt"
#endif
__device__ __forceinline__ void y_store_asm(const f32x4& v, f32x4* p) { asm volatile("global_store_dwordx4 %0, %1, off " Y_FLAVOUR "\n\ts_nop 1" :: "v"(p), "v"(v) : "memory"); }
#define Y_STORE(v, p) y_store_asm((v), (p))
#elif NT_Y
#define Y_STORE(v, p) __builtin_nontemporal_store((v), (p))
#else
#define Y_STORE(v, p) (*(p) = (v))
#endif
#ifndef MK_WT
#define MK_WT 16
#endif
__device__ __forceinline__ __amdgpu_buffer_rsrc_t mkrsrc(const void* p) { return __builtin_amdgcn_make_buffer_rsrc((void*)p, 0, 0x10000000, 0x00020000); }
#define ST16(rsrc, byteoff, v) __builtin_amdgcn_raw_buffer_store_b128((v), (rsrc), (unsigned)(byteoff), 0, MK_WT)
#ifndef MK_WT_MULTI
#define MK_WT_MULTI 0
#endif
#define ST16M(rsrc, byteoff, v) __builtin_amdgcn_raw_buffer_store_b128((v), (rsrc), (unsigned)(byteoff), 0, MK_WT_MULTI)
template <int AUX = MK_WT> __device__ __forceinline__ void st_wide(const __amdgpu_buffer_rsrc_t rs, size_t off_grp, int fr, const u32x4& p0, const u32x4& p1) {
    const bool lo8 = fr < 8;
    u32x4 dA, dB;
#pragma unroll
    for (int j = 0; j < 4; ++j) { const unsigned send = lo8 ? p1[j] : p0[j]; const unsigned got = (unsigned)__builtin_amdgcn_mov_dpp((int)send, 0x128, 0xf, 0xf, true);
        dA[j] = lo8 ? p0[j] : got; dB[j] = lo8 ? got : p1[j]; }
    const size_t o = off_grp + (size_t)(fr & 7) * DM + 8 * (fr >> 3);
    __builtin_amdgcn_raw_buffer_store_b128(dA, rs, (unsigned)(o * 2), 0, AUX); __builtin_amdgcn_raw_buffer_store_b128(dB, rs, (unsigned)((o + 8 * DM) * 2), 0, AUX);
}
__device__ __forceinline__ float sum4(const f32x4& a) { return (a[0] + a[1]) + (a[2] + a[3]); }
__device__ __forceinline__ float sumsq4(const f32x4& a) { return (a[0] * a[0] + a[1] * a[1]) + (a[2] * a[2] + a[3] * a[3]); }

template <int PAT = 0> struct EpiUpT {
    static constexpr bool PERM = true, AFTER_DRAIN = false, WIDE = false; static constexpr int MID_T = 0, PF_T = 0;
    bf16_t* O; int ldc; const float* ss;
    __device__ __forceinline__ void operator()(const f32x4 (&acc)[2][2][4][2], const Unit& u, int wr, int wc, int fr, int fq) const {
        const int row0 = u.pm * BM + wr * 64 + fr, col0 = u.pn * 128 + wc * 32 + 8 * fq;
        const __amdgpu_buffer_rsrc_t rs = mkrsrc(O);
        float sv[2][4];
#pragma unroll
        for (int ai = 0; ai < 2; ++ai)
#pragma unroll
            for (int m = 0; m < 4; ++m) sv[ai][m] = ss[row0 + ai * HALF + m * 16];
#pragma unroll
        for (int ai = 0; ai < 2; ++ai)
#pragma unroll
            for (int m = 0; m < 4; ++m) {
                const int row = row0 + ai * HALF + m * 16;
                const float s = __builtin_amdgcn_rsqf(sv[ai][m] * (1.0f / 1024.0f) + 1e-6f);
                const float c = -s * LOG2E, s2 = s * s;
                f32x4 o[2];
#pragma unroll
                for (int n = 0; n < 2; ++n)
#pragma unroll
                    for (int j = 0; j < 4; j += 2) {
                        const f32x2 g = {acc[ai][0][m][n][j], acc[ai][0][m][n][j + 1]}, up = {acc[ai][1][m][n][j], acc[ai][1][m][n][j + 1]};
                        const f32x2 t = g * c; f32x2 e; e.x = __builtin_amdgcn_exp2f(t.x); e.y = __builtin_amdgcn_exp2f(t.y);
                        const f32x2 d = e + 1.0f; f32x2 r; r.x = __builtin_amdgcn_rcpf(d.x); r.y = __builtin_amdgcn_rcpf(d.y);
                        const f32x2 v = (g * up) * (r * s2);
                        o[n][j] = v.x; o[n][j + 1] = v.y;
                    }
                if (PAT == 1) ST16M(rs, (size_t)((u.pm * 22 + u.pn) & 1023) * 65536 + (size_t)(((ai * 4 + m) * 8 + (wr * 4 + wc)) * 1024 + (fq * 16 + fr) * 16), pack8(o[0], o[1]));
                else ST16M(rs, ((size_t)row * ldc + col0) * 2, pack8(o[0], o[1]));
            }
    }
};
using EpiUp = EpiUpT<0>;

template <int MODE> struct EpiRes {
    static constexpr bool PERM = true, AFTER_DRAIN = false, WIDE = (WIDE_ST != 0) && MODE != 2; static constexpr int MID_T = 0, PF_T = PF_RES;
    const float* xf; const bf16_t* xb; float* outy; bf16_t* ob; float* ss;
    __device__ __forceinline__ void prefetch(const Unit& u, int wid, int lane, PG8_LAS unsigned char* dummy) const {
        int tid = wid * 64 + lane; asm volatile("" : "+v"(tid));
#pragma unroll
        for (int i = 0; i < 2; ++i) { const int L = tid + 512 * i;
            __builtin_amdgcn_global_load_lds((const unsigned*)(xb + (size_t)(u.pm * BM + (L >> 2)) * DM + u.pn * BM + (L & 3) * 64), (PG8_LAS unsigned*)(dummy + wid * 256), 4, 0, 0); }
    }
    __device__ __forceinline__ void operator()(const f32x4 (&acc)[2][2][4][2], const Unit& u, int wr, int wc, int fr, int fq) const {
        const int row0 = u.pm * BM + wr * 64 + fr, col0 = u.pn * BM + (WIDE ? wc * 64 + 16 * fq : wc * 32 + 8 * fq);
        constexpr int BJS = WIDE ? 8 : HALF;
        const float alpha = (MODE == 1) ? 1.0f : 0.5f;
        const __amdgpu_buffer_rsrc_t rs = mkrsrc(ob);
#pragma unroll
        for (int ai = 0; ai < 2; ++ai) {
            u32x4 rw[4][2];
#pragma unroll
            for (int m = 0; m < 4; ++m)
#pragma unroll
                for (int bj = 0; bj < 2; ++bj) rw[m][bj] = RES_LOAD((const u32x4*)(xb + (size_t)(row0 + ai * HALF + m * 16) * DM + col0 + bj * BJS));
            float parts[4];
#pragma unroll
            for (int m = 0; m < 4; ++m) {
                const size_t off = (size_t)(row0 + ai * HALF + m * 16) * DM + col0;
                float part = 0.f; u32x4 pw[2];
#pragma unroll
                for (int bj = 0; bj < 2; ++bj) {
                    const u32x4 w = rw[m][bj];
                    const f32x4 r0 = (f32x4){__uint_as_float(w.x << 16), __uint_as_float(w.x & 0xffff0000u), __uint_as_float(w.y << 16), __uint_as_float(w.y & 0xffff0000u)};
                    const f32x4 r1 = (f32x4){__uint_as_float(w.z << 16), __uint_as_float(w.z & 0xffff0000u), __uint_as_float(w.w << 16), __uint_as_float(w.w & 0xffff0000u)};
                    const f32x4 o0 = r0 + acc[ai][bj][m][0] * alpha, o1 = r1 + acc[ai][bj][m][1] * alpha;
                    if (MODE == 2) {
#if Y_FULL_LINES
                        const bool lo8 = fr < 8;
                        f32x4 keep, got;
#pragma unroll
                        for (int j = 0; j < 4; ++j) { keep[j] = lo8 ? o0[j] : o1[j]; const float send = lo8 ? o1[j] : o0[j];
                            got[j] = __int_as_float(__builtin_amdgcn_mov_dpp(__float_as_int(send), 0x128, 0xf, 0xf, true)); }
                        float* pA = outy + off - (size_t)(fr >> 3) * (8 * DM) + bj * HALF + (fr >> 3) * 4;
                        f32x4 dA, dB;
#pragma unroll
                        for (int j = 0; j < 4; ++j) { dA[j] = lo8 ? keep[j] : got[j]; dB[j] = lo8 ? got[j] : keep[j]; }
                        Y_STORE(dA, (f32x4*)pA); Y_STORE(dB, (f32x4*)(pA + 8 * DM));
#else
                        Y_STORE(o0, (f32x4*)(outy + off + bj * HALF)); Y_STORE(o1, (f32x4*)(outy + off + bj * HALF + 4));
#endif
                    }
                    else { if (WIDE) pw[bj] = pack8(o0, o1); else ST16(rs, (off + bj * HALF) * 2, pack8(o0, o1)); part += sumsq4(o0) + sumsq4(o1); }
                }
                if (MODE != 2 && WIDE) st_wide<RES_WT>(rs, off - (size_t)fr * DM, fr, pw[0], pw[1]);
                if (MODE != 2) { part += __shfl_xor(part, 16); part += __shfl_xor(part, 32); }
                parts[m] = part;
            }
            if (MODE != 2 && ss) { const float mine = fq == 0 ? parts[0] : fq == 1 ? parts[1] : fq == 2 ? parts[2] : parts[3];
                atomicAdd(ss + (u.pm * BM + ai * HALF + wr * 64 + 16 * fq + fr), mine); }
        }
    }
};

struct EpiWin {
    static constexpr bool PERM = true, AFTER_DRAIN = false, WIDE = false; static constexpr int MID_T = 0, PF_T = 0;
    const float* ss; const float *qn, *kn; unsigned char* ws; float* out;
    static constexpr size_t O_NKP = 16908288, O_NVP = 16941056, O_NCP = 16973824, O_NKS = 17004544, O_NVS = 19101696, O_NCS = 21198848;
    __device__ __forceinline__ void operator()(const f32x4 (&acc)[2][2][4][2], const Unit& u, int wr, int wc, int fr, int fq) const {
        const int row0 = u.pm * BM + wr * 64 + fr; const int pn = u.pn;
        const __amdgpu_buffer_rsrc_t rs = mkrsrc(ws);
        const bool side_rows = (u.pm == 31 || u.pm == 63 || u.pm == 64);
        float sv[2][4];
#pragma unroll
        for (int ai = 0; ai < 2; ++ai)
#pragma unroll
            for (int m = 0; m < 4; ++m) sv[ai][m] = ss[row0 + ai * HALF + m * 16];
#pragma unroll
        for (int ai = 0; ai < 2; ++ai)
#pragma unroll
            for (int m = 0; m < 4; ++m) {
                const int row = row0 + ai * HALF + m * 16;
                const float s = __builtin_amdgcn_rsqf(sv[ai][m] * (1.0f / 1024.0f) + 1e-6f);
                const float cexp = -s * LOG2E;
                f32x4 v[2][2];
                if (pn < 7) {
#pragma unroll
                    for (int bj = 0; bj < 2; ++bj)
#pragma unroll
                        for (int n = 0; n < 2; ++n) v[bj][n] = acc[ai][bj][m][n] * ((pn >= 3 && bj == 1) ? cexp : s);
                }
                if (pn < 3) {
                    const bool isv = (pn == 2 && wc >= 2), isq = (pn < 2);
                    if (!isv) {
                        float q = (sumsq4(v[0][0]) + sumsq4(v[0][1])) + (sumsq4(v[1][0]) + sumsq4(v[1][1]));
                        q += __shfl_xor(q, 16); q += __shfl_xor(q, 32);
                        const float r = __builtin_amdgcn_rsqf(q * (1.0f / 64.0f) + 1e-6f) * (isq ? 0.125f : 1.0f);
                        const float* gn = isq ? qn : kn;
#pragma unroll
                        for (int bj = 0; bj < 2; ++bj)
#pragma unroll
                            for (int n = 0; n < 2; ++n) { const f32x4 gv = *(const f32x4*)(gn + 32 * bj + 8 * fq + 4 * n); v[bj][n] = v[bj][n] * r * gv; }
                    }
                    size_t obase; int ocol; int ld;
                    if (isq) { obase = WS_QB; ld = 512; ocol = (4 * pn + wc) * 64; } else if (!isv) { obase = WS_KB; ld = 128; ocol = wc * 64; } else { obase = WS_VB; ld = 128; ocol = (wc - 2) * 64; }
#pragma unroll
                    for (int bj = 0; bj < 2; ++bj) ST16M(rs, obase + ((size_t)row * ld + ocol + 32 * bj + 8 * fq) * 2, pack8(v[bj][0], v[bj][1]));
                    if (!isq && side_rows) {
                        float* o = nullptr; const int kvh = isv ? wc - 2 : wc;
                        if (row < ROWS_PROMPT) { const int b = row >> 13, t = row & 8191; if (t >= 8064) o = out + (isv ? O_NVP : O_NKP) + (size_t)((b * 128 + (t - 8064)) * 2 + kvh) * 64; }
                        else if (row >= ROW_SAMPLE && row < ROW_END) o = out + (isv ? O_NVS : O_NKS) + (size_t)(((row - ROW_SAMPLE) * 128 + 127) * 2 + kvh) * 64;
                        if (o) {
#pragma unroll
                            for (int bj = 0; bj < 2; ++bj)
#pragma unroll
                                for (int n = 0; n < 2; ++n) *(f32x4*)(o + 32 * bj + 8 * fq + 4 * n) = v[bj][n];
                        }
                    }
                } else if (pn < 7) {
                    const int ch = 128 * (pn - 3) + 32 * wc + 8 * fq;
                    f32x4 g[2];
#pragma unroll
                    for (int n = 0; n < 2; ++n)
#pragma unroll
                        for (int j = 0; j < 4; ++j) g[n][j] = v[0][n][j] * __builtin_amdgcn_rcpf(1.0f + __builtin_amdgcn_exp2f(v[1][n][j]));
                    ST16M(rs, WS_GLU + ((size_t)row * 512 + ch) * 2, pack8(g[0], g[1]));
                    if (side_rows) {
                        float* o = nullptr;
                        if (row < ROWS_PROMPT) { const int b = row >> 13, t = row & 8191; if (t >= 8162) o = out + O_NCP + (size_t)(b * 30 + (t - 8162)) * 512; }
                        else if (row >= ROW_SAMPLE && row < ROW_END) o = out + O_NCS + (size_t)((row - ROW_SAMPLE) * 30 + 29) * 512;
                        if (o) { *(f32x4*)(o + ch) = g[0]; *(f32x4*)(o + ch + 4) = g[1]; }
                    }
                } else {
                    const size_t obase = pn < 11 ? WS_GA : WS_GC; const int col = 256 * (pn < 11 ? pn - 7 : pn - 11) + 32 * wc + 8 * fq;
#pragma unroll
                    for (int bj = 0; bj < 2; ++bj) {
                        f32x4 g[2];
#pragma unroll
                        for (int n = 0; n < 2; ++n)
#pragma unroll
                            for (int j = 0; j < 4; ++j) g[n][j] = __builtin_amdgcn_rcpf(1.0f + __builtin_amdgcn_exp2f(acc[ai][bj][m][n][j] * cexp));
                        ST16M(rs, obase + ((size_t)row * DM + col + bj * HALF) * 2, pack8(g[0], g[1]));
                    }
                }
            }
    }
};

template <int MIDT, int VAR = 0> struct EpiMixT {
    static constexpr bool PERM = true, AFTER_DRAIN = false, WIDE = (WIDE_ST != 0); static constexpr int MID_T = MIDT, PF_T = PF_MIX;
    const bf16_t *GA, *GC; bf16_t* MIXB;
    __device__ __forceinline__ void prefetch(const Unit& u, int wid, int lane, PG8_LAS unsigned char* dummy) const {
        int tid = wid * 64 + lane; asm volatile("" : "+v"(tid));
#pragma unroll
        for (int i = 0; i < 2; ++i) { const int L = tid + 512 * i; const size_t o = (size_t)(u.pm * BM + (L >> 2)) * DM + u.pn * BM + (L & 3) * 64;
            __builtin_amdgcn_global_load_lds((const unsigned*)(GA + o), (PG8_LAS unsigned*)(dummy + wid * 256), 4, 0, 0);
            __builtin_amdgcn_global_load_lds((const unsigned*)(GC + o), (PG8_LAS unsigned*)(dummy + wid * 256), 4, 0, 0); }
    }
    static __device__ __forceinline__ void unpack8(const u32x4& w, f32x4& a, f32x4& b) {
        a = (f32x4){__uint_as_float(w.x << 16), __uint_as_float(w.x & 0xffff0000u), __uint_as_float(w.y << 16), __uint_as_float(w.y & 0xffff0000u)};
        b = (f32x4){__uint_as_float(w.z << 16), __uint_as_float(w.z & 0xffff0000u), __uint_as_float(w.w << 16), __uint_as_float(w.w & 0xffff0000u)}; }
    __device__ __forceinline__ void mid(f32x4 (&acc)[2][2][4][2], const Unit& u, int wr, int wc, int fr, int fq) const {
        int lo = (u.pm * BM + wr * 64 + fr) * DM + u.pn * BM + (WIDE ? wc * 64 + 16 * fq : wc * 32 + 8 * fq);
        constexpr int BJS = WIDE ? 8 : HALF;
        asm volatile("" : "+v"(lo));
#pragma unroll
        for (int ai = 0; ai < 2; ++ai)
#pragma unroll
            for (int m = 0; m < 4; ++m) {
                const size_t off = (size_t)(unsigned)(lo + (ai * HALF + m * 16) * DM);
#pragma unroll
                for (int bj = 0; bj < 2; ++bj) {
                    const u32x4 gaw = *(const u32x4*)(GA + off + bj * BJS), gcw = *(const u32x4*)(GC + off + bj * BJS);
                    f32x4 a0, a1, c0, c1; unpack8(gaw, a0, a1); unpack8(gcw, c0, c1);
#pragma unroll
                    for (int j = 0; j < 4; ++j) { acc[ai][bj][m][0][j] *= a0[j] * __builtin_amdgcn_rcpf(c0[j]); acc[ai][bj][m][1][j] *= a1[j] * __builtin_amdgcn_rcpf(c1[j]); }
                }
                if ((m & MID_BATCH_MASK) == MID_BATCH_MASK) { asm volatile("" ::: "memory"); __builtin_amdgcn_sched_barrier(0); }
            }
    }
    __device__ __forceinline__ void operator()(const f32x4 (&acc)[2][2][4][2], const Unit& u, int wr, int wc, int fr, int fq) const {
        int lo = (u.pm * BM + wr * 64 + fr) * DM + u.pn * BM + (WIDE ? wc * 64 + 16 * fq : wc * 32 + 8 * fq);
        constexpr int BJS = WIDE ? 8 : HALF;
        asm volatile("" : "+v"(lo));
        const __amdgpu_buffer_rsrc_t rs = mkrsrc(MIXB);
#if MIX_PRELOAD16 == 2
#pragma unroll
        for (int ai = 0; ai < 2; ++ai)
#pragma unroll
            for (int mp = 0; mp < 2; ++mp) {
                u32x4 gw[2][2];
#pragma unroll
                for (int mm = 0; mm < 2; ++mm)
#pragma unroll
                    for (int bj = 0; bj < 2; ++bj) gw[mm][bj] = *(const u32x4*)(GC + (size_t)(unsigned)(lo + (ai * HALF + (2 * mp + mm) * 16) * DM) + bj * HALF);
#pragma unroll
                for (int mm = 0; mm < 2; ++mm) {
                    const int m = 2 * mp + mm;
                    const size_t off = (size_t)(unsigned)(lo + (ai * HALF + m * 16) * DM);
#pragma unroll
                    for (int bj = 0; bj < 2; ++bj) {
                        f32x4 c0, c1; unpack8(gw[mm][bj], c0, c1);
                        ST16(rs, (off + bj * HALF) * 2, pack8(acc[ai][bj][m][0] * c0, acc[ai][bj][m][1] * c1));
                    }
                }
            }
#elif MIX_PRELOAD16
        u32x4 gw[2][4][2];
#pragma unroll
        for (int ai = 0; ai < 2; ++ai)
#pragma unroll
            for (int m = 0; m < 4; ++m)
#pragma unroll
                for (int bj = 0; bj < 2; ++bj) gw[ai][m][bj] = *(const u32x4*)(GC + (size_t)(unsigned)(lo + (ai * HALF + m * 16) * DM) + bj * HALF);
#pragma unroll
        for (int ai = 0; ai < 2; ++ai)
#pragma unroll
            for (int m = 0; m < 4; ++m) {
                const size_t off = (size_t)(unsigned)(lo + (ai * HALF + m * 16) * DM);
#pragma unroll
                for (int bj = 0; bj < 2; ++bj) {
                    f32x4 c0, c1; unpack8(gw[ai][m][bj], c0, c1);
                    ST16(rs, (off + bj * HALF) * 2, pack8(acc[ai][bj][m][0] * c0, acc[ai][bj][m][1] * c1));
                }
            }
#else
#pragma unroll
        for (int ai = 0; ai < 2; ++ai) {
            u32x4 gw[4][2];
#pragma unroll
            for (int m = 0; m < 4; ++m)
#pragma unroll
                for (int bj = 0; bj < 2; ++bj) { if (VAR == 1 || VAR >= 3) gw[m][bj] = (u32x4){0x3f003f00u, 0x3f003f00u, 0x3f003f00u, 0x3f003f00u}; else gw[m][bj] = *(const u32x4*)(GC + (size_t)(unsigned)(lo + (ai * HALF + m * 16) * DM) + bj * BJS); }
            float sink_ = 0.f;
#pragma unroll
            for (int m = 0; m < 4; ++m) {
                const size_t off = (size_t)(unsigned)(lo + (ai * HALF + m * 16) * DM); u32x4 pw[2];
#pragma unroll
                for (int bj = 0; bj < 2; ++bj) {
                    f32x4 c0, c1; unpack8(gw[m][bj], c0, c1);
                    if (VAR == 2) sink_ += sum4(acc[ai][bj][m][0] * c0) + sum4(acc[ai][bj][m][1] * c1);
                    else if (VAR == 5) __builtin_amdgcn_raw_buffer_store_b128(pack8(acc[ai][bj][m][0] * c0, acc[ai][bj][m][1] * c1), rs, (unsigned)((off + bj * HALF) * 2), 0, 2);
                    else if (VAR == 6) __builtin_amdgcn_raw_buffer_store_b128(pack8(acc[ai][bj][m][0] * c0, acc[ai][bj][m][1] * c1), rs, (unsigned)((off + bj * HALF) * 2), 0, 0);
                    else if (VAR == 7) __builtin_amdgcn_raw_buffer_store_b128(pack8(acc[ai][bj][m][0] * c0, acc[ai][bj][m][1] * c1), rs, (unsigned)((off + bj * HALF) * 2), 0, 17);
                    else if (VAR == 9) { if (ai == 0) { const size_t rowb = (size_t)(u.pm * BM + wr * 64 + m * 16 + (fr & 7) + 8 * bj) * (DM * 2) + u.pn * 512;
                        ST16(rs, rowb + wc * 128 + fq * 32 + (fr >> 3) * 16, pack8(acc[ai][bj][m][0] * c0, acc[ai][bj][m][1] * c1)); } else sink_ += sum4(acc[ai][bj][m][0] * c0) + sum4(acc[ai][bj][m][1] * c1); }
                    else if (VAR == 10) { const size_t rowb = (size_t)((u.pm & 1) * BM + ai * HALF + wr * 64 + m * 16 + (fr & 7) + 8 * bj) * (DM * 2) + u.pn * 512;
                        ST16(rs, rowb + wc * 128 + fq * 32 + (fr >> 3) * 16, pack8(acc[ai][bj][m][0] * c0, acc[ai][bj][m][1] * c1)); }
                    else if (VAR == 8) { const size_t rowb = (size_t)(u.pm * BM + ai * HALF + wr * 64 + m * 16 + (fr & 7) + 8 * bj) * (DM * 2 + 128) + u.pn * 512;
                        ST16(rs, rowb + wc * 128 + fq * 32 + (fr >> 3) * 16, pack8(acc[ai][bj][m][0] * c0, acc[ai][bj][m][1] * c1)); }
                    else if (VAR == 3) { const size_t rowb = (size_t)(u.pm * BM + ai * HALF + wr * 64 + m * 16 + fr) * (DM * 2) + u.pn * 512;
                        ST16(rs, rowb + wc * 128 + fq * 32 + bj * 16, pack8(acc[ai][bj][m][0] * c0, acc[ai][bj][m][1] * c1)); }
                    else if (VAR == 4) { const size_t rowb = (size_t)(u.pm * BM + ai * HALF + wr * 64 + m * 16 + (fr & 7) + 8 * bj) * (DM * 2) + u.pn * 512;
                        ST16(rs, rowb + wc * 128 + fq * 32 + (fr >> 3) * 16, pack8(acc[ai][bj][m][0] * c0, acc[ai][bj][m][1] * c1)); }
                    else if (WIDE) pw[bj] = pack8(acc[ai][bj][m][0] * c0, acc[ai][bj][m][1] * c1);
                    else ST16(rs, (off + bj * HALF) * 2, pack8(acc[ai][bj][m][0] * c0, acc[ai][bj][m][1] * c1));
                }
                if (WIDE && VAR == 0) st_wide<MIX_WT>(rs, off - (size_t)fr * DM, fr, pw[0], pw[1]);
            }
            if ((VAR == 2 || VAR == 9) && sink_ == 1.2345e38f) ST16(rs, 0, gw[0][0]);
        }
#endif
    }
};
using EpiMix = EpiMixT<8>;
struct EpiNull {
    static constexpr bool PERM = true, AFTER_DRAIN = false, WIDE = false; static constexpr int MID_T = 0, PF_T = 0;
    float* sink;
    __device__ __forceinline__ void operator()(const f32x4 (&acc)[2][2][4][2], const Unit& u, int wr, int wc, int fr, int fq) const {
        float s = 0.f;
#pragma unroll
        for (int ai = 0; ai < 2; ++ai)
#pragma unroll
            for (int bj = 0; bj < 2; ++bj)
#pragma unroll
                for (int m = 0; m < 4; ++m)
#pragma unroll
                    for (int n = 0; n < 2; ++n) s += sum4(acc[ai][bj][m][n]);
        if (s == 1.2345e38f) sink[0] = s;
    }
};
constexpr int PF_DUMMY_OFF = 155648;
struct NoPost { __device__ __forceinline__ void operator()() const {} };
template <class Epi, class Sched, bool ALIGN_EPI = false, bool SP2 = false, class Post = NoPost, int AUX_A = 0>
__device__ __forceinline__ void gemm_phase(PG8_LAS unsigned char* lds, const Gemm g, const Sched& S, const Epi& E, const Post& post = Post()) {
    const int tid = threadIdx.x, wid = __builtin_amdgcn_readfirstlane(tid >> 6), lane = tid & 63, wr = wid >> 2, wc = wid & 3, fr = lane & 15, fq = lane >> 4;
    const int K = g.K, nt = K / BK;
    unsigned voffA[2], voffB[2];
#pragma unroll
    for (int i = 0; i < 2; ++i) { int R, C; stage_rc(tid * 16 + i * 8192, R, C); const int x32 = perm32(R & 31); const int Rb = Epi::PERM ? (Epi::WIDE ? (64 * (R >> 5) + 16 * (x32 >> 3) + (x32 & 7)) : ((R & ~31) + x32)) : R;
        voffA[i] = (unsigned)(R * K + C) * 2u; voffB[i] = (unsigned)(Rb * K + C) * 2u; }
    const size_t kstep = (size_t)(BK * 2);
    const size_t hstep = (size_t)HALF * K * 2;
    const size_t hstepB = Epi::WIDE ? (size_t)8 * K * 2 : hstep;
    const size_t tstep = 2 * hstep;
    const unsigned ldsw = (unsigned)wid * 1024u;
    const int aoff = lds_byte(wr * 64 + fr, fq * 8), boff = lds_byte(wc * 32 + fr, fq * 8);
#define PG8_SA(b, h) (((b) * 2 + (h)) * HTB)
#define PG8_SB(b, h) ((4 + (b) * 2 + (h)) * HTB)
#define PG8_STAGE(bufoff, gbase, voff) do { _Pragma("unroll") for (int _i = 0; _i < 2; ++_i) { \
        if (AUX_A == 2 && (const void*)(voff) == (const void*)voffA) __builtin_amdgcn_global_load_lds((const unsigned*)((const char*)(gbase) + (voff)[_i]), (PG8_LAS unsigned*)(lds + (bufoff) + ldsw + _i * 8192), 16, 0, 2); \
        else __builtin_amdgcn_global_load_lds((const unsigned*)((const char*)(gbase) + (voff)[_i]), (PG8_LAS unsigned*)(lds + (bufoff) + ldsw + _i * 8192), 16, 0, 0); } } while (0)
#define PG8_LDA(dst, b, h) do { _Pragma("unroll") for (int m = 0; m < 4; ++m) _Pragma("unroll") for (int k = 0; k < 2; ++k) dst[m][k] = *(const PG8_LAS bf16x8*)(lds + PG8_SA(b, h) + aoff + m * 2048 + k * 1024); } while (0)
#define PG8_LDB(dst, b, h) do { _Pragma("unroll") for (int n = 0; n < 2; ++n) _Pragma("unroll") for (int k = 0; k < 2; ++k) dst[n][k] = *(const PG8_LAS bf16x8*)(lds + PG8_SB(b, h) + boff + n * 2048 + k * 1024); } while (0)
#define PG8_MMA(ai, bj, At, Bt) do { __builtin_amdgcn_s_setprio(1); _Pragma("unroll") for (int m = 0; m < 4; ++m) _Pragma("unroll") for (int n = 0; n < 2; ++n) _Pragma("unroll") for (int k = 0; k < 2; ++k) \
        acc[ai][bj][m][n] = __builtin_amdgcn_mfma_f32_16x16x32_bf16(Bt[n][k], At[m][k], acc[ai][bj][m][n], 0, 0, 0); __builtin_amdgcn_s_setprio(0); } while (0)
#define PG8_WAIT_V(n) asm volatile("s_waitcnt vmcnt(" #n ")" ::: "memory")
#define PG8_WAIT_L(n) asm volatile("s_waitcnt lgkmcnt(" #n ")" ::: "memory")
#define PG8_BAR __builtin_amdgcn_s_barrier()
#define PG8_SCHED __builtin_amdgcn_sched_barrier(0)
    Unit cur, nxt; int ui = 0;
    if (!S.next(0, cur)) return;
    f32x4 acc[2][2][4][2];
#pragma unroll
    for (int a = 0; a < 2; ++a)
#pragma unroll
        for (int b = 0; b < 2; ++b)
#pragma unroll
            for (int m = 0; m < 4; ++m)
#pragma unroll
                for (int n = 0; n < 2; ++n) acc[a][b][m][n] = (f32x4){0.f, 0.f, 0.f, 0.f};
    bf16x8 At[4][2], B0[2][2], B1[2][2];
    const char* cA = (const char*)g.A + (size_t)cur.pm * tstep; const char* cB = (const char*)g.Bt + (size_t)cur.pn * tstep;
    S.a_ready(cur);
    if constexpr (SP2) {
        PG8_STAGE(PG8_SB(0, 0), cB, voffB); PG8_STAGE(PG8_SB(0, 1), cB + hstepB, voffB); PG8_STAGE(PG8_SA(0, 0), cA, voffA); PG8_STAGE(PG8_SA(0, 1), cA + hstep, voffA);
        if (wr == 1) PG8_BAR;
        PG8_WAIT_V(2); PG8_BAR;
        PG8_STAGE(PG8_SB(1, 0), cB + kstep, voffB); PG8_STAGE(PG8_SA(1, 0), cA + kstep, voffA); PG8_STAGE(PG8_SB(1, 1), cB + hstepB + kstep, voffB);
        PG8_WAIT_V(6); PG8_BAR;
    } else {
        PG8_STAGE(PG8_SB(0, 0), cB, voffB); PG8_STAGE(PG8_SA(0, 0), cA, voffA); PG8_STAGE(PG8_SB(0, 1), cB + hstepB, voffB); PG8_STAGE(PG8_SA(0, 1), cA + hstep, voffA);
        if (wr == 1) PG8_BAR;
        PG8_WAIT_V(4); PG8_BAR;
        PG8_STAGE(PG8_SB(1, 0), cB + kstep, voffB); PG8_STAGE(PG8_SA(1, 0), cA + kstep, voffA); PG8_STAGE(PG8_SB(1, 1), cB + hstepB + kstep, voffB);
        PG8_WAIT_V(6); PG8_BAR;
    }
    for (;;) {
        const bool has_next = S.next(ui + 1, nxt);
        const char* nA = has_next ? (const char*)g.A + (size_t)nxt.pm * tstep : cA; const char* nB = has_next ? (const char*)g.Bt + (size_t)nxt.pn * tstep : cB;
        for (int t = 0; t < nt; t += 2) {
            if constexpr (Epi::PF_T > 0) { if (t == (nt > Epi::PF_T ? nt - Epi::PF_T : 0)) E.prefetch(cur, wid, lane, lds + PF_DUMMY_OFF); }
            if constexpr (Epi::MID_T > 0) { if (t == Epi::MID_T) E.mid(acc, cur, wr, wc, fr, fq); }
            const bool last = (t == nt - 2);
            const char* a1 = cA + (size_t)(t + 1) * kstep;
            const char* a2 = last ? nA : cA + (size_t)(t + 2) * kstep; const char* b2 = last ? nB : cB + (size_t)(t + 2) * kstep;
            const char* a3 = a2 + kstep; const char* b3 = b2 + kstep;
            if (last && has_next) S.a_ready(nxt);
            if constexpr (SP2) {
            PG8_LDB(B0, 0, 0); PG8_LDB(B1, 0, 1); PG8_SCHED; PG8_LDA(At, 0, 0); PG8_STAGE(PG8_SA(1, 1), a1 + hstep, voffA);
            PG8_WAIT_V(8); PG8_WAIT_L(0); PG8_BAR; PG8_MMA(0, 0, At, B0); PG8_MMA(0, 1, At, B1); PG8_BAR; PG8_SCHED;
            PG8_LDA(At, 0, 1); PG8_STAGE(PG8_SB(0, 0), b2, voffB); PG8_STAGE(PG8_SB(0, 1), b2 + hstepB, voffB); PG8_STAGE(PG8_SA(0, 0), a2, voffA);
            PG8_WAIT_V(8); PG8_WAIT_L(0); PG8_BAR; PG8_MMA(1, 0, At, B0); PG8_MMA(1, 1, At, B1); PG8_BAR; PG8_SCHED;
            PG8_LDB(B0, 1, 0); PG8_LDB(B1, 1, 1); PG8_SCHED; PG8_LDA(At, 1, 0); PG8_STAGE(PG8_SA(0, 1), a2 + hstep, voffA);
            PG8_WAIT_V(8); PG8_WAIT_L(0); PG8_BAR; PG8_MMA(0, 0, At, B0); PG8_MMA(0, 1, At, B1); PG8_BAR; PG8_SCHED;
            PG8_LDA(At, 1, 1); PG8_STAGE(PG8_SB(1, 0), b3, voffB); PG8_STAGE(PG8_SB(1, 1), b3 + hstepB, voffB); PG8_STAGE(PG8_SA(1, 0), a3, voffA);
            PG8_WAIT_V(8); PG8_WAIT_L(0); PG8_BAR; PG8_MMA(1, 0, At, B0); PG8_MMA(1, 1, At, B1); PG8_BAR; PG8_SCHED;
            } else {
            PG8_LDB(B0, 0, 0); PG8_SCHED; PG8_LDA(At, 0, 0); PG8_STAGE(PG8_SA(1, 1), a1 + hstep, voffA);
            PG8_WAIT_L(8); PG8_BAR; PG8_WAIT_L(0); PG8_MMA(0, 0, At, B0); PG8_BAR; PG8_SCHED;
            PG8_LDB(B1, 0, 1); PG8_STAGE(PG8_SB(0, 0), b2, voffB);
            PG8_BAR; PG8_WAIT_L(0); PG8_MMA(0, 1, At, B1); PG8_BAR;
            PG8_LDA(At, 0, 1); PG8_STAGE(PG8_SA(0, 0), a2, voffA);
            PG8_BAR; PG8_WAIT_L(0); PG8_MMA(1, 0, At, B0); PG8_BAR; PG8_SCHED;
            PG8_STAGE(PG8_SB(0, 1), b2 + hstepB, voffB);
            PG8_WAIT_V(6); PG8_BAR; PG8_MMA(1, 1, At, B1); PG8_BAR;
            PG8_LDB(B0, 1, 0); PG8_SCHED; PG8_LDA(At, 1, 0); PG8_STAGE(PG8_SA(0, 1), a2 + hstep, voffA);
            PG8_WAIT_L(8); PG8_BAR; PG8_WAIT_L(0); PG8_MMA(0, 0, At, B0); PG8_BAR; PG8_SCHED;
            PG8_LDB(B1, 1, 1); PG8_STAGE(PG8_SB(1, 0), b3, voffB);
            PG8_BAR; PG8_WAIT_L(0); PG8_MMA(0, 1, At, B1); PG8_BAR;
            PG8_LDA(At, 1, 1); PG8_STAGE(PG8_SA(1, 0), a3, voffA);
            PG8_BAR; PG8_WAIT_L(0); PG8_MMA(1, 0, At, B0); PG8_BAR; PG8_SCHED;
            PG8_STAGE(PG8_SB(1, 1), b3 + hstepB, voffB);
            PG8_WAIT_V(6); PG8_BAR; PG8_MMA(1, 1, At, B1); PG8_BAR;
            }
        }
        if constexpr (ALIGN_EPI) { if (wr == 0) PG8_BAR; }
        if constexpr (!Epi::AFTER_DRAIN) { E(acc, cur, wr, wc, fr, fq); S.done(cur); }
        if (!has_next) break;
#pragma unroll
        for (int a = 0; a < 2; ++a)
#pragma unroll
            for (int b = 0; b < 2; ++b)
#pragma unroll
                for (int m = 0; m < 4; ++m)
#pragma unroll
                    for (int n = 0; n < 2; ++n) acc[a][b][m][n] = (f32x4){0.f, 0.f, 0.f, 0.f};
        cur = nxt; cA = nA; cB = nB; ++ui;
        if constexpr (ALIGN_EPI) { if (wr == 1) PG8_BAR; }
    }
    if constexpr (ALIGN_EPI) post();
    PG8_WAIT_V(0);
    if constexpr (!ALIGN_EPI) { if (wr == 0) PG8_BAR; }
    PG8_BAR;
    if constexpr (Epi::AFTER_DRAIN) { E.fused(acc, cur, wr, wc, fr, fq, lds, wid, lane); S.done(cur); }
#undef PG8_SA
#undef PG8_SB
#undef PG8_STAGE
#undef PG8_LDA
#undef PG8_LDB
#undef PG8_MMA
#undef PG8_WAIT_V
#undef PG8_WAIT_L
#undef PG8_BAR
#undef PG8_SCHED
}
}
#define XB_TMO      128
#define XB_XCNT(j)  (256  + 64 * (j))
#define XB_XSUB(j)  (1280 + 64 * (j))
#define XB_XGEN(j)  (2304 + 64 * (j))
#define XB_TOP      3328
#define XB_TOPGEN   3392
#define XB_SEAM(k)  (3456 + 64 * (k))
#define XCD_BAR_WORDS 3968
#define XB_SPIN_CAP (1u << 18)

__device__ __forceinline__ unsigned xb_ld(unsigned* p)              { return __hip_atomic_load(p, __ATOMIC_RELAXED, __HIP_MEMORY_SCOPE_AGENT); }
__device__ __forceinline__ unsigned xb_add(unsigned* p, unsigned v) { return __hip_atomic_fetch_add(p, v, __ATOMIC_RELAXED, __HIP_MEMORY_SCOPE_AGENT); }
__device__ __forceinline__ unsigned xb_xcc_id() { return (unsigned)__builtin_amdgcn_s_getreg((3 << 11) | 20) & 0xFu; }
#define XB_SPIN(cond, bar) do { unsigned _sp = 0; while (cond) { __builtin_amdgcn_s_sleep(1); \
    if ((++_sp & 255u) == 0u) { if (xb_ld(&(bar)[XB_TMO])) break; if (_sp > XB_SPIN_CAP) { atomicAdd(&(bar)[XB_TMO], 1u); break; } } } } while (0)

struct XcdBarrier {
    unsigned* bar; unsigned x;
    volatile LAS unsigned* st;
};

__device__ __forceinline__ XcdBarrier xcd_barrier_post(unsigned* bar, volatile LAS unsigned* st) {
    XcdBarrier b; b.bar = bar; b.x = xb_xcc_id(); b.st = st;
    if (threadIdx.x == 0) st[2] = xb_add(&bar[XB_XCNT(b.x)], 1u);
    return b;
}
__device__ __forceinline__ void xcd_barrier_complete(unsigned* bar, unsigned x, unsigned& nloc, unsigned& nx) {
    const unsigned G = gridDim.x * gridDim.y * gridDim.z;
    unsigned sum, cnt, mine, sp = 0u;
    for (;;) {
        sum = 0u; cnt = 0u; mine = 0u;
#pragma unroll
        for (unsigned j = 0; j < 16; ++j) { const unsigned c = xb_ld(&bar[XB_XCNT(j)]); sum += c; cnt += (c > 0u) ? 1u : 0u; mine = (j == x) ? c : mine; }
        if (sum == G) break;
        __builtin_amdgcn_s_sleep(1);
        if ((++sp & 255u) == 0u) { if (xb_ld(&bar[XB_TMO])) break; if (sp > XB_SPIN_CAP) { atomicAdd(&bar[XB_TMO], 1u); break; } }
    }
    nloc = mine > 0u ? mine : 1u; nx = cnt > 0u ? cnt : 1u;
}

__device__ __forceinline__ void xcd_barrier(const XcdBarrier& b) {
    asm volatile("s_waitcnt vmcnt(0)" ::: "memory");
    __syncthreads();
    if (threadIdx.x == 0) {
        unsigned* bar = b.bar;
        __builtin_amdgcn_s_waitcnt(0);
        unsigned nloc = b.st[0], nx = b.st[1];
        if (nloc == 0u) { xcd_barrier_complete(bar, b.x, nloc, nx); b.st[0] = nloc; b.st[1] = nx; }
        const unsigned old = xb_add(&bar[XB_XSUB(b.x)], 1u);
        const unsigned gen = old / nloc;
        if (old + 1u == (gen + 1u) * nloc) {
            __builtin_amdgcn_fence(__ATOMIC_RELEASE, "agent");
            asm volatile("s_waitcnt vmcnt(0)" ::: "memory");
            const unsigned og = xb_add(&bar[XB_TOP], 1u);
            const unsigned tg = og / nx;
            if (og + 1u == (tg + 1u) * nx) xb_add(&bar[XB_TOPGEN], 1u);
            else XB_SPIN(xb_ld(&bar[XB_TOPGEN]) == tg, bar);
            __builtin_amdgcn_fence(__ATOMIC_ACQUIRE, "agent");
            xb_add(&bar[XB_XGEN(b.x)], 1u);
            asm volatile("s_waitcnt vmcnt(0)" ::: "memory");
        } else {
            XB_SPIN(xb_ld(&bar[XB_XGEN(b.x)]) == gen, bar);
            __builtin_amdgcn_fence(__ATOMIC_ACQUIRE, "agent");
            asm volatile("s_waitcnt vmcnt(0)" ::: "memory");
        }
    }
    __syncthreads();
}

__device__ __forceinline__ void xcd_barrier_local(const XcdBarrier& b, int seam) {
    asm volatile("s_waitcnt vmcnt(0)" ::: "memory");
    __syncthreads();
    if (threadIdx.x == 0) {
        unsigned* bar = b.bar;
        __builtin_amdgcn_s_waitcnt(0);
        unsigned nloc = b.st[0], nx = b.st[1];
        if (nloc == 0u) { xcd_barrier_complete(bar, b.x, nloc, nx); b.st[0] = nloc; b.st[1] = nx; }
        const unsigned old = xb_add(&bar[XB_XSUB(b.x)], 1u);
        const unsigned gen = old / nloc;
        if (old + 1u == (gen + 1u) * nloc) { xb_add(&bar[XB_SEAM(seam)], 1u); xb_add(&bar[XB_XGEN(b.x)], 1u); }
        else XB_SPIN(xb_ld(&bar[XB_XGEN(b.x)]) == gen, bar);
        __builtin_amdgcn_fence(__ATOMIC_ACQUIRE, "agent");
        asm volatile("s_waitcnt vmcnt(0)" ::: "memory");
    }
    __syncthreads();
}
__device__ __forceinline__ void xcd_census(const XcdBarrier& b) {
    if (threadIdx.x == 0) { unsigned nloc = b.st[0], nx = b.st[1]; if (nloc == 0u) { xcd_barrier_complete(b.bar, b.x, nloc, nx); b.st[0] = nloc; b.st[1] = nx; } }
    __syncthreads();
}
__device__ __forceinline__ void xcd_seam_wait(const XcdBarrier& b, int seam) {
    if (threadIdx.x == 0) {
        unsigned* bar = b.bar; const unsigned nx = b.st[1];
        XB_SPIN(xb_ld(&bar[XB_SEAM(seam)]) < nx, bar);
        __builtin_amdgcn_fence(__ATOMIC_ACQUIRE, "agent");
        asm volatile("s_waitcnt vmcnt(0)" ::: "memory");
    }
    __syncthreads();
}
__device__ __forceinline__ bool xcd_layout_ok(const XcdBarrier& b, unsigned G) {
    bool ok = (G % 8u) == 0u;
#pragma unroll
    for (unsigned j = 0; j < 16; ++j) { const unsigned c = xb_ld(&b.bar[XB_XCNT(j)]); ok = ok && (c == (j < 8u ? G / 8u : 0u)); }
    return ok;
}

struct Args {
    const float* in[27]; float* out; unsigned char* ws; int ph_lo, ph_hi;
};
struct Frame {
    LAS unsigned char* lds; volatile LAS unsigned* MISC; gu32* ctl;
    int tid, lane, wave, G;
};
__device__ __forceinline__ float wave_sum(float v) {
#pragma unroll
    for (int o = 1; o < 64; o <<= 1) v += __shfl_xor(v, o);
    return v;
}
__device__ __forceinline__ float wave_max(float v) {
#pragma unroll
    for (int o = 1; o < 64; o <<= 1) v = fmaxf(v, __shfl_xor(v, o));
    return v;
}

#ifndef MK_NT
#define MK_NT 1
#endif
#ifndef LOCAL_SEAMS
#define LOCAL_SEAMS 1
#endif
#ifndef P0_WT
#define P0_WT 1
#endif
#ifndef P4_WT
#define P4_WT 1
#endif
#ifndef XROWS
#define XROWS 2
#endif
#ifndef NT_ITEMS
#define NT_ITEMS 2
#endif
#if NT_ITEMS == 2
__device__ __forceinline__ void item_store_sc1(v4u v, GAS v4u* p) { asm volatile("global_store_dwordx4 %0, %1, off sc1\n\ts_nop 1" :: "v"(p), "v"(v) : "memory"); }
#define ITEM_STORE(v, p) item_store_sc1((v), (p))
#elif NT_ITEMS
#define ITEM_STORE(v, p) __builtin_nontemporal_store((v), (p))
#else
#define ITEM_STORE(v, p) (*(p) = (v))
#endif
#if MK_NT
#define NT_LOAD(p) __builtin_nontemporal_load(p)
#define NT_STORE(v, p) __builtin_nontemporal_store((v), (p))
#else
#define NT_LOAD(p) (*(p))
#define NT_STORE(v, p) (*(p) = (v))
#endif
__device__ __forceinline__ void p0_transpose_item(const float* W, int K, int N, const float* gain, bf16* WT, int k0, int n0, int dra, int drb, LAS float* scr, int lane) {
    const int lr = lane >> 4, lc = 4 * (lane & 15);
    f32x4 w[8];
#pragma unroll
    for (int i = 0; i < 8; ++i) w[i] = NT_LOAD((const GAS f32x4*)(W + (size_t)(k0 + 4 * i + lr) * N + n0 + lc));
    if (gain) {
#pragma unroll
        for (int i = 0; i < 8; ++i) w[i] = w[i] * gain[k0 + 4 * i + lr];
    }
#pragma unroll
    for (int i = 0; i < 8; ++i) { LAS float* d = scr + (4 * i + lr) * 65 + lc; d[0] = w[i].x; d[1] = w[i].y; d[2] = w[i].z; d[3] = w[i].w; }
    LDS_WAIT(); asm volatile("" ::: "memory");
    const int c = lane & 3;
#pragma unroll
    for (int j = 0; j < 4; ++j) { const int n = (lane >> 2) + 16 * j; const LAS float* s = scr + (8 * c) * 65 + n;
        v4u o; o.x = pk2(s[0 * 65], s[1 * 65]); o.y = pk2(s[2 * 65], s[3 * 65]); o.z = pk2(s[4 * 65], s[5 * 65]); o.w = pk2(s[6 * 65], s[7 * 65]);
        const int dr = (j < 2 ? dra : drb) + (n & 31);
        ITEM_STORE(o, (GAS v4u*)(WT + (size_t)dr * K + k0 + 8 * c)); }
    LDS_WAIT(); asm volatile("" ::: "memory");
}
__device__ __forceinline__ int win_dest_row(int n0) {
    if (n0 < 512) { const int head = n0 >> 6, d = n0 & 63; return 256 * (head >> 2) + 128 * (d >> 5) + 32 * (head & 3); }
    if (n0 < 640) { const int kvh = (n0 - 512) >> 6, d = n0 & 63; return 512 + 128 * (d >> 5) + 32 * kvh; }
    if (n0 < 768) { const int vh = (n0 - 640) >> 6, d = n0 & 63; return 512 + 128 * (d >> 5) + 32 * (2 + vh); }
    if (n0 < 1792) { const int which = (n0 - 768) >> 9, ch = (n0 - 768) & 511; return 256 * (3 + (ch >> 7)) + 128 * which + (ch & 127); }
    return n0;
}
__device__ __forceinline__ int ffn_dest_row(int j0, int which) { return 256 * (j0 >> 7) + 128 * which + (j0 & 127); }

constexpr int I_W1 = 32 * 44, I_W2 = 88 * 16, I_WIN = 32 * 60, I_AO = 16 * 16, I_WO = 32 * 16;
constexpr int P0_A0 = 0, P0_B0 = 2 * I_W1, P0_C0 = P0_B0 + I_W2 + I_WIN + 2 * I_AO + I_WO, P0_NITEMS = P0_C0 + 2 * I_W1 + I_W2;
#ifndef W2B_IN_P7
#define W2B_IN_P7 0
#endif
constexpr int P0_C_P7 = W2B_IN_P7 ? P0_C0 + 2 * I_W1 : P0_NITEMS;
constexpr int P0_C_P3 = 2750;
__device__ __forceinline__ void p0_items(Frame& F, const Args& a, int lo, int hi, int rank, int nworkers) {
    unsigned char* ws = a.ws;
    LAS float* scr = (LAS float*)(F.lds + F.wave * 16384);
    for (int it = lo + rank * NWAVES + F.wave; it < hi; it += nworkers * NWAVES) {
        int r = it;
        if (r < P0_B0 || r >= P0_C0) {
            const bool f = r >= P0_C0; if (f) r -= P0_C0;
            const float* gain = a.in[f ? 23 : 6]; bf16* W13 = (bf16*)(ws + (f ? WS_W13B : WS_W13A)); bf16* W2 = (bf16*)(ws + (f ? WS_W2B : WS_W2A));
            if (r < I_W1) { const int kb = r / 44, nb = r % 44; p0_transpose_item(a.in[f ? 24 : 7], D, DFF, gain, W13, 32 * kb, 64 * nb, ffn_dest_row(64 * nb, 0), ffn_dest_row(64 * nb + 32, 0), scr, F.lane); continue; } r -= I_W1;
            if (r < I_W1) { const int kb = r / 44, nb = r % 44; p0_transpose_item(a.in[f ? 25 : 8], D, DFF, gain, W13, 32 * kb, 64 * nb, ffn_dest_row(64 * nb, 1), ffn_dest_row(64 * nb + 32, 1), scr, F.lane); continue; } r -= I_W1;
            { const int kb = r / 16, nb = r % 16; p0_transpose_item(a.in[26], DFF, D, nullptr, W2, 32 * kb, 64 * nb, 64 * nb, 64 * nb + 32, scr, F.lane); continue; }
        }
        r -= P0_B0;
        if (r < I_W2) { const int kb = r / 16, nb = r % 16; p0_transpose_item(a.in[9], DFF, D, nullptr, (bf16*)(ws + WS_W2A), 32 * kb, 64 * nb, 64 * nb, 64 * nb + 32, scr, F.lane); continue; } r -= I_W2;
        if (r < I_WIN) { const int kb = r / 60, nb = r % 60; p0_transpose_item(a.in[11], D, NIN, a.in[10], (bf16*)(ws + WS_WIN), 32 * kb, 64 * nb, win_dest_row(64 * nb), win_dest_row(64 * nb + 32), scr, F.lane); continue; } r -= I_WIN;
        if (r < I_AO) { const int kb = r / 16, nb = r % 16; p0_transpose_item(a.in[16], 1024, D, nullptr, (bf16*)(ws + WS_WMIX), 32 * kb, 64 * nb, 64 * nb, 64 * nb + 32, scr, F.lane); continue; } r -= I_AO;
        if (r < I_AO) { const int kb = r / 16, nb = r % 16; p0_transpose_item(a.in[21], 1024, D, nullptr, (bf16*)(ws + WS_WMIX) + 512, 32 * kb, 64 * nb, 64 * nb, 64 * nb + 32, scr, F.lane); continue; } r -= I_AO;
        { const int kb = r / 16, nb = r % 16; p0_transpose_item(a.in[22], D, D, nullptr, (bf16*)(ws + WS_WOUT), 32 * kb, 64 * nb, 64 * nb, 64 * nb + 32, scr, F.lane); }
    }
}
__device__ __forceinline__ void p0_copies(Frame& F, const Args& a, int rank, int nworkers) {
    const int gt = rank * (NWAVES * 64) + F.tid, NGT = nworkers * NWAVES * 64;
    for (int i = gt; i < 128 * 4064; i += NGT) { const int s = i / 4064, e = i % 4064;
        NT_STORE(NT_LOAD(((const GAS f32x4*)(a.in[2] + (size_t)s * 16384 + 128)) + e), ((GAS f32x4*)(a.out + O_NKS + (size_t)s * 16384)) + e);
        NT_STORE(NT_LOAD(((const GAS f32x4*)(a.in[3] + (size_t)s * 16384 + 128)) + e), ((GAS f32x4*)(a.out + O_NVS + (size_t)s * 16384)) + e); }
    for (int i = gt; i < 128 * 3712; i += NGT) { const int s = i / 3712, e = i % 3712;
        NT_STORE(NT_LOAD(((const GAS f32x4*)(a.in[4] + (size_t)s * 15360 + 512)) + e), ((GAS f32x4*)(a.out + O_NCS + (size_t)s * 15360)) + e); }
}
__device__ __forceinline__ void p0_prologue(Frame& F, const Args& a) {
    unsigned char* ws = a.ws;
#ifdef P0_ZERO_OUT
    { GAS f32x4* o = (GAS f32x4*)a.out; for (size_t i = (size_t)blockIdx.x * 512 + F.tid; i < (size_t)23164928 / 4; i += (size_t)F.G * 512) o[i] = (f32x4){0.f, 0.f, 0.f, 0.f}; }
#endif
    LAS float* scr = (LAS float*)(F.lds + F.wave * 16384);
    const int gw = blockIdx.x * NWAVES + F.wave, NGW = F.G * NWAVES;
    p0_items(F, a, P0_A0, P0_B0, blockIdx.x, F.G);
    p0_items(F, a, P0_C0 + P0_C_P3, P0_C_P7, blockIdx.x, F.G);
}
template <bool LAZY> __device__ __forceinline__ void p0_rows(Frame& F, const Args& a, int base, int stride, int count) {
    unsigned char* ws = a.ws;
    for (int k0 = 0; k0 < count; k0 += XROWS) {
        f32x4 v[XROWS][4];
#pragma unroll
        for (int q = 0; q < XROWS; ++q) { const int row = base + (k0 + q) * stride; const int rr = (k0 + q < count && row < R_END) ? row : 0;
            const float* src = rr < NPROMPT ? a.in[0] + (size_t)rr * D : rr < R_SAMPLE ? a.in[5] + (size_t)(rr - R_META) * D : a.in[1] + (size_t)(rr - R_SAMPLE) * D;
#pragma unroll
            for (int j = 0; j < 4; ++j) v[q][j] = NT_LOAD(((const GAS f32x4*)src) + F.lane + 64 * j); }
#pragma unroll
        for (int q = 0; q < XROWS; ++q) { const int row = base + (k0 + q) * stride;
            if (k0 + q < count && row < MP) {
                float s = 0.f;
#pragma unroll
                for (int j = 0; j < 4; ++j) { if (row >= R_END) v[q][j] = (f32x4){0.f, 0.f, 0.f, 0.f}; s += (v[q][j].x * v[q][j].x + v[q][j].y * v[q][j].y) + (v[q][j].z * v[q][j].z + v[q][j].w * v[q][j].w); }
                s = wave_sum(s);
#pragma unroll
                for (int j = 0; j < 4; ++j) {
                    v2u w2; w2.x = pk2(v[q][j].x, v[q][j].y); w2.y = pk2(v[q][j].z, v[q][j].w);
                    __builtin_amdgcn_raw_buffer_store_b64(w2, pg8::mkrsrc(ws), (unsigned)(WS_R1 + (size_t)row * (D * 2) + F.lane * 8 + 512 * j), 0, LAZY ? 0 : 16);
                }
                if (F.lane == 0) __builtin_amdgcn_raw_buffer_store_b32(__float_as_uint(s), pg8::mkrsrc(ws), (unsigned)((CW_SS1 + row) * 4), 0, 16);
            } }
    }
}

constexpr int VT_STRIDE = 260;
constexpr int KS_STRIDE = 72;
constexpr int L4_VT = 0, L4_KS = 33792, L4_TAB = 131072, L4_Y = 0, L4_SMP = 137216, L4_WIN = 65536;
__device__ __forceinline__ int crow(int r, int hi) { return (r & 3) + 8 * (r >> 2) + 4 * hi; }
__device__ __forceinline__ int t5_bucket(int d) {
    if (d < 16) return d;
    int b = 16;
    b += (d >= 19); b += (d >= 21); b += (d >= 24); b += (d >= 27); b += (d >= 31); b += (d >= 35); b += (d >= 40); b += (d >= 46);
    b += (d >= 52); b += (d >= 59); b += (d >= 67); b += (d >= 77); b += (d >= 87); b += (d >= 99); b += (d >= 113);
    return b;
}
__device__ __forceinline__ int tok_row(int b, int t) { return t >= 0 ? b * SEQ + t : (t >= -16 ? R_META + 16 + t : -1); }

__device__ __forceinline__ void attn_unit(Frame& F, const Args& a, int b, int kvh, int jb) {
    const bf16* Qb = (const bf16*)(a.ws + WS_QB); const bf16* Kb = (const bf16*)(a.ws + WS_KB); const bf16* Vb = (const bf16*)(a.ws + WS_VB);
    bf16* AO = (bf16*)(a.ws + WS_R1);
    LAS bf16* Vt = (LAS bf16*)(F.lds + L4_VT); LAS bf16* Ks = (LAS bf16*)(F.lds + L4_KS); const LAS float* tab = (const LAS float*)(F.lds + L4_TAB);
    const int tid = F.tid, lane = F.lane, wid = F.wave, ql = lane & 31, hi = lane >> 5;
    const int tk0 = 128 * jb - 128;
    bf16x8 qfa[2][4];
    { const int hq_ = wid & 3, qh_ = wid >> 2;
#pragma unroll
      for (int qs = 0; qs < 2; ++qs)
#pragma unroll
        for (int s = 0; s < 4; ++s) qfa[qs][s] = *(const GAS bf16x8*)(Qb + ((size_t)b * SEQ + 128 * jb + 64 * qh_ + 32 * qs + ql) * 512 + (kvh * 4 + hq_) * 64 + 16 * s + 8 * hi); }
    for (int c = tid; c < 2048; c += NWAVES * 64) {
        const int kk = c >> 3, ch = c & 7; const int row = tok_row(b, tk0 + kk);
        const int rr = row >= 0 ? row : 0;
        v4u w = *(const GAS v4u*)(Vb + (size_t)rr * 128 + kvh * 64 + ch * 8), kw = *(const GAS v4u*)(Kb + (size_t)rr * 128 + kvh * 64 + ch * 8);
        if (row < 0) { w = (v4u){0u, 0u, 0u, 0u}; kw = w; }
        *(LAS v4u*)(Ks + kk * KS_STRIDE + ch * 8) = kw;
#pragma unroll
        for (int i = 0; i < 8; ++i) { const unsigned dw = w[i >> 1]; Vt[(ch * 8 + i) * VT_STRIDE + kk] = (bf16)((i & 1) ? (dw >> 16) : (dw & 0xffffu)); }
    }
    __syncthreads();
    const int hq = wid & 3, qh = wid >> 2, head = kvh * 4 + hq;
    const float sink = a.in[15][head];
#pragma unroll
    for (int qs = 0; qs < 2; ++qs) {
        const int tq = 128 * jb + 64 * qh + 32 * qs;
        const size_t rowq = (size_t)b * SEQ + tq + ql;
        bf16x8 qf[4];
#pragma unroll
        for (int s = 0; s < 4; ++s) qf[s] = qfa[qs][s];
        f32x16 S[5];
        float mx = -1e30f;
        const LAS float* tabq = tab + head * 192 + 1 + ql - 4 * hi;
#pragma unroll
        for (int kt = 0; kt < 5; ++kt) {
            const LAS bf16* kp = Ks + ((tq - 128 + 32 * kt) - tk0 + ql) * KS_STRIDE + 8 * hi;
            f32x16 acc = (f32x16){0.f, 0.f, 0.f, 0.f, 0.f, 0.f, 0.f, 0.f, 0.f, 0.f, 0.f, 0.f, 0.f, 0.f, 0.f, 0.f};
#pragma unroll
            for (int s = 0; s < 4; ++s) {
                const bf16x8 kf = *(const LAS bf16x8*)(kp + 16 * s);
                acc = __builtin_amdgcn_mfma_f32_32x32x16_bf16(kf, qf[s], acc, 0, 0, 0);
            }
            const int kb0 = tq - 128 + 32 * kt; const float pen_lo = kb0 >= -16 ? 0.f : -1e30f, pen_hi = kb0 + 16 >= -16 ? 0.f : -1e30f;
#pragma unroll
            for (int r = 0; r < 16; ++r) {
                const float x = acc[r] + tabq[159 - (32 * kt + (r & 3) + 8 * (r >> 2))] + (r < 8 ? pen_lo : pen_hi);
                acc[r] = x; mx = fmaxf(mx, x);
            }
            S[kt] = acc;
            asm volatile("" ::: "memory"); __builtin_amdgcn_sched_barrier(0);
        }
        mx = fmaxf(mx, __shfl_xor(mx, 32)); mx = fmaxf(mx, sink);
        float sum = 0.f;
#pragma unroll
        for (int kt = 0; kt < 5; ++kt)
#pragma unroll
            for (int r = 0; r < 16; ++r) { const float p = __builtin_amdgcn_exp2f((S[kt][r] - mx) * pg8::LOG2E); S[kt][r] = p; sum += p; }
        sum += __shfl_xor(sum, 32); sum += __builtin_amdgcn_exp2f((sink - mx) * pg8::LOG2E);
        const float inv = 1.0f / sum;
        f32x16 OT[2];
        OT[0] = (f32x16){0.f, 0.f, 0.f, 0.f, 0.f, 0.f, 0.f, 0.f, 0.f, 0.f, 0.f, 0.f, 0.f, 0.f, 0.f, 0.f}; OT[1] = OT[0];
#pragma unroll
        for (int kt = 0; kt < 5; ++kt)
#pragma unroll
            for (int s = 0; s < 2; ++s) {
                v4u pw; pw.x = pg8::cvt_pk_bf16(S[kt][8 * s + 0], S[kt][8 * s + 1]); pw.y = pg8::cvt_pk_bf16(S[kt][8 * s + 2], S[kt][8 * s + 3]);
                pw.z = pg8::cvt_pk_bf16(S[kt][8 * s + 4], S[kt][8 * s + 5]); pw.w = pg8::cvt_pk_bf16(S[kt][8 * s + 6], S[kt][8 * s + 7]);
                const bf16x8 pf = __builtin_bit_cast(bf16x8, pw);
                const int kk0 = (tq - 128 + 32 * kt) - tk0 + 16 * s + 4 * hi;
#pragma unroll
                for (int dt = 0; dt < 2; ++dt) {
                    const LAS bf16* vp = Vt + (32 * dt + ql) * VT_STRIDE + kk0;
                    const v2u lo = *(const LAS v2u*)vp, hh = *(const LAS v2u*)(vp + 8);
                    const v4u vw = (v4u){lo.x, lo.y, hh.x, hh.y};
                    OT[dt] = __builtin_amdgcn_mfma_f32_32x32x16_bf16(__builtin_bit_cast(bf16x8, vw), pf, OT[dt], 0, 0, 0);
                }
                asm volatile("" ::: "memory"); __builtin_amdgcn_sched_barrier(0);
            }
        bf16* orow = AO + rowq * 1024 + head * 64;
#pragma unroll
        for (int dt = 0; dt < 2; ++dt)
#pragma unroll
            for (int g = 0; g < 4; ++g) { v2u w; w.x = pk2(OT[dt][4 * g] * inv, OT[dt][4 * g + 1] * inv); w.y = pk2(OT[dt][4 * g + 2] * inv, OT[dt][4 * g + 3] * inv);
                *(GAS v2u*)(orow + 32 * dt + 8 * g + 4 * hi) = w; }
    }
    __syncthreads();
}

__device__ __forceinline__ void sample_attn_wave(Frame& F, const Args& a, int s, int head, int wslot) {
    const bf16* Qb = (const bf16*)(a.ws + WS_QB); const bf16* Kb = (const bf16*)(a.ws + WS_KB); const bf16* Vb = (const bf16*)(a.ws + WS_VB);
    bf16* AO = (bf16*)(a.ws + WS_R1);
    const LAS float* tab = (const LAS float*)(F.lds + L4_TAB);
    LAS float* qs = (LAS float*)(F.lds + L4_SMP + wslot * 768); LAS float* ps = qs + 64;
    const int lane = F.lane, kvh = head >> 2; const int row = R_SAMPLE + s;
    qs[lane] = bf2f(Qb[(size_t)row * 512 + head * 64 + lane]);
    LDS_WAIT();
    const float* ck = a.in[2] + (size_t)s * 16384 + kvh * 64; const float* cv = a.in[3] + (size_t)s * 16384 + kvh * 64;
    float sc[2];
#pragma unroll
    for (int h = 0; h < 2; ++h) {
        const int i = lane + 64 * h; float acc = 0.f;
        const GAS f32x4* kp = (const GAS f32x4*)(ck + (size_t)(i < 127 ? i + 1 : 127) * 128);
#pragma unroll
        for (int d4 = 0; d4 < 16; ++d4) { const f32x4 kv = NT_LOAD(kp + d4); const f32x4 qv = *(const LAS f32x4*)(qs + 4 * d4); acc += (kv.x * qv.x + kv.y * qv.y) + (kv.z * qv.z + kv.w * qv.w); }
        sc[h] = acc;
    }
    { const float accn = wave_sum(bf2f(Kb[(size_t)row * 128 + kvh * 64 + lane]) * qs[lane]);
      if (lane == 63) sc[1] = accn; }
    sc[0] += tab[head * 192 + 32 + (127 - lane)]; sc[1] += tab[head * 192 + 32 + (63 - lane)];
    const float sink = a.in[15][head];
    const float mx = fmaxf(wave_max(fmaxf(sc[0], sc[1])), sink);
    const float p0 = __builtin_amdgcn_exp2f((sc[0] - mx) * pg8::LOG2E), p1 = __builtin_amdgcn_exp2f((sc[1] - mx) * pg8::LOG2E);
    const float den = wave_sum(p0 + p1) + __builtin_amdgcn_exp2f((sink - mx) * pg8::LOG2E);
    ps[lane] = p0; ps[lane + 64] = p1;
    LDS_WAIT();
    const int g = lane >> 4, d4 = lane & 15;
    f32x4 o = (f32x4){0.f, 0.f, 0.f, 0.f};
#pragma unroll
    for (int j = 0; j < 32; ++j) { const int i = 4 * j + g;
        f32x4 v = NT_LOAD((const GAS f32x4*)(cv + (size_t)(i < 127 ? i + 1 : 127) * 128 + 4 * d4));
        if (j == 31) { const v2u nw = *(const GAS v2u*)(Vb + (size_t)row * 128 + kvh * 64 + 4 * d4);
            const f32x4 nv = (f32x4){__uint_as_float(nw.x << 16), __uint_as_float(nw.x & 0xffff0000u), __uint_as_float(nw.y << 16), __uint_as_float(nw.y & 0xffff0000u)};
            v = (i == 127) ? nv : v; }
        o += v * ps[i]; }
#pragma unroll
    for (int e = 0; e < 4; ++e) { o[e] += __shfl_xor(o[e], 16); o[e] += __shfl_xor(o[e], 32); }
    const float inv = 1.0f / den;
    if (g == 0) { v2u w; w.x = pk2(o[0] * inv, o[1] * inv); w.y = pk2(o[2] * inv, o[3] * inv);
        __builtin_amdgcn_raw_buffer_store_b64(w, pg8::mkrsrc(a.ws), (unsigned)((const char*)(AO + (size_t)row * 1024 + head * 64 + 4 * d4) - (const char*)a.ws), 0, 16); }
    LDS_WAIT();
}

__device__ __forceinline__ void conv_ln_store(Frame& F, const Args& a, int row_base) {
    bf16* CA = (bf16*)(a.ws + WS_R1) + 512;
    const LAS float* Y = (const LAS float*)(F.lds + L4_Y);
    const f32x4 g0 = *(const GAS f32x4*)(a.in[19] + 4 * F.lane), g1 = *(const GAS f32x4*)(a.in[19] + 256 + 4 * F.lane);
    const f32x4 b0 = *(const GAS f32x4*)(a.in[20] + 4 * F.lane), b1 = *(const GAS f32x4*)(a.in[20] + 256 + 4 * F.lane);
#pragma unroll
    for (int k = 0; k < 4; ++k) {
        const int i = 4 * F.wave + k; const int row = row_base + i;
        f32x4 x0 = *(const LAS f32x4*)(Y + i * 512 + 4 * F.lane), x1 = *(const LAS f32x4*)(Y + i * 512 + 256 + 4 * F.lane);
        const float mean = wave_sum(pg8::sum4(x0) + pg8::sum4(x1)) * (1.0f / 512.0f);
        x0 = x0 - mean; x1 = x1 - mean;
        const float var = wave_sum(pg8::sumsq4(x0) + pg8::sumsq4(x1)) * (1.0f / 512.0f);
        const float rstd = __builtin_amdgcn_rsqf(var + EPS);
        f32x4 y0 = x0 * rstd * g0 + b0, y1 = x1 * rstd * g1 + b1;
#pragma unroll
        for (int j = 0; j < 4; ++j) { y0[j] = y0[j] * pg8::fast_sigmoid(y0[j]); y1[j] = y1[j] * pg8::fast_sigmoid(y1[j]); }
        if (row >= 0) {
            v2u w0, w1; w0.x = pk2(y0[0], y0[1]); w0.y = pk2(y0[2], y0[3]); w1.x = pk2(y1[0], y1[1]); w1.y = pk2(y1[2], y1[3]);
#if P4_WT
            { const unsigned bo = (unsigned)((const char*)(CA + (size_t)row * 1024 + 4 * F.lane) - (const char*)a.ws);
              __builtin_amdgcn_raw_buffer_store_b64(w0, pg8::mkrsrc(a.ws), bo, 0, 16); __builtin_amdgcn_raw_buffer_store_b64(w1, pg8::mkrsrc(a.ws), bo + 512, 0, 16); }
#else
            *(GAS v2u*)(CA + (size_t)row * 1024 + 4 * F.lane) = w0; *(GAS v2u*)(CA + (size_t)row * 1024 + 256 + 4 * F.lane) = w1;
#endif
        }
    }
}
__device__ __forceinline__ void conv_fma32(const float (&w)[31], const float (&x)[62], float bias, LAS float* Ycol) {
#pragma unroll
    for (int ib = 0; ib < 32; ib += 8) {
        float s0 = bias, s1 = bias, s2 = bias, s3 = bias, s4 = bias, s5 = bias, s6 = bias, s7 = bias;
#pragma unroll
        for (int k = 0; k < 31; ++k) {
            s0 += w[k] * x[ib + 0 + k]; s1 += w[k] * x[ib + 1 + k]; s2 += w[k] * x[ib + 2 + k]; s3 += w[k] * x[ib + 3 + k];
            s4 += w[k] * x[ib + 4 + k]; s5 += w[k] * x[ib + 5 + k]; s6 += w[k] * x[ib + 6 + k]; s7 += w[k] * x[ib + 7 + k];
            asm volatile("" : "+v"(s0), "+v"(s1), "+v"(s2), "+v"(s3), "+v"(s4), "+v"(s5), "+v"(s6), "+v"(s7));
        }
        Ycol[(ib + 0) * 512] = s0; Ycol[(ib + 1) * 512] = s1; Ycol[(ib + 2) * 512] = s2; Ycol[(ib + 3) * 512] = s3;
        Ycol[(ib + 4) * 512] = s4; Ycol[(ib + 5) * 512] = s5; Ycol[(ib + 6) * 512] = s6; Ycol[(ib + 7) * 512] = s7;
    }
}
__device__ __forceinline__ void conv_win_load(const Args& a, int b, int t0, int tid, v4u (&g)[8]) {
    const bf16* GLU = (const bf16*)(a.ws + WS_GLU);
#pragma unroll
    for (int i = 0; i < 8; ++i) { const int ch = tid + 512 * i, r = ch >> 6, cc = ch & 63;
        const int row = tok_row(b, t0 - 30 + (r < 62 ? r : 61)); g[i] = *(const GAS v4u*)(GLU + (size_t)(row >= 0 ? row : 0) * 512 + cc * 8); }
}
__device__ __forceinline__ void conv_win_store(Frame& F, int b, int t0, int tid, const v4u (&g)[8]) {
    LAS bf16* WIN = (LAS bf16*)(F.lds + L4_WIN);
#pragma unroll
    for (int i = 0; i < 8; ++i) { const int ch = tid + 512 * i, r = ch >> 6, cc = ch & 63;
        if (r < 62) { const int row = tok_row(b, t0 - 30 + r); *(LAS v4u*)(WIN + r * 512 + cc * 8) = row >= 0 ? g[i] : (v4u){0u, 0u, 0u, 0u}; } }
}
__device__ __forceinline__ void conv_win_read(Frame& F, int c, float (&x)[62]) {
    const LAS bf16* WIN = (const LAS bf16*)(F.lds + L4_WIN);
#pragma unroll
    for (int r = 0; r < 62; ++r) x[r] = bf2f(WIN[r * 512 + c]);
}
__device__ __forceinline__ void conv_pair(Frame& F, const Args& a, int bA, int tA, int bB, int tB) {
    LAS float* Y = (LAS float*)(F.lds + L4_Y);
    const int c = F.tid;
    float w[31];
#pragma unroll
    for (int k = 0; k < 31; ++k) w[k] = a.in[17][k * 512 + c];
    const float bias = a.in[18][c];
    float x[62];
    { v4u g[8]; conv_win_load(a, bA, tA, F.tid, g); conv_win_store(F, bA, tA, F.tid, g); }
    __syncthreads();
    conv_win_read(F, c, x);
    v4u gB[8]; conv_win_load(a, bB, tB, F.tid, gB);
    conv_fma32(w, x, bias, Y + c);
    __syncthreads();
    conv_win_store(F, bB, tB, F.tid, gB);
    conv_ln_store(F, a, bA * SEQ + tA);
    __syncthreads();
    conv_win_read(F, c, x);
    conv_fma32(w, x, bias, Y + c);
    __syncthreads();
    conv_ln_store(F, a, bB * SEQ + tB);
    __syncthreads();
}
__device__ __forceinline__ void sample_conv_wave(Frame& F, const Args& a, int s) {
    const bf16* GLU = (const bf16*)(a.ws + WS_GLU); bf16* CA = (bf16*)(a.ws + WS_R1) + 512;
    const int c0 = 8 * F.lane;
    f32x4 acc0 = *(const GAS f32x4*)(a.in[18] + c0), acc1 = *(const GAS f32x4*)(a.in[18] + c0 + 4);
    const float* st = a.in[4] + (size_t)s * 15360 + c0; const float* wd = a.in[17] + c0;
#pragma unroll
    for (int k = 0; k < 30; ++k) {
        acc0 += *(const GAS f32x4*)(wd + k * 512) * NT_LOAD((const GAS f32x4*)(st + k * 512));
        acc1 += *(const GAS f32x4*)(wd + k * 512 + 4) * NT_LOAD((const GAS f32x4*)(st + k * 512 + 4));
    }
    { const v4u gw = *(const GAS v4u*)(GLU + (size_t)(R_SAMPLE + s) * 512 + c0);
      const f32x4 g0 = (f32x4){__uint_as_float(gw.x << 16), __uint_as_float(gw.x & 0xffff0000u), __uint_as_float(gw.y << 16), __uint_as_float(gw.y & 0xffff0000u)};
      const f32x4 g1 = (f32x4){__uint_as_float(gw.z << 16), __uint_as_float(gw.z & 0xffff0000u), __uint_as_float(gw.w << 16), __uint_as_float(gw.w & 0xffff0000u)};
      acc0 += *(const GAS f32x4*)(wd + 30 * 512) * g0; acc1 += *(const GAS f32x4*)(wd + 30 * 512 + 4) * g1; }
    const float mean = wave_sum(pg8::sum4(acc0) + pg8::sum4(acc1)) * (1.0f / 512.0f);
    acc0 = acc0 - mean; acc1 = acc1 - mean;
    const float var = wave_sum(pg8::sumsq4(acc0) + pg8::sumsq4(acc1)) * (1.0f / 512.0f);
    const float rstd = __builtin_amdgcn_rsqf(var + EPS);
    f32x4 y0 = acc0 * rstd * *(const GAS f32x4*)(a.in[19] + c0) + *(const GAS f32x4*)(a.in[20] + c0);
    f32x4 y1 = acc1 * rstd * *(const GAS f32x4*)(a.in[19] + c0 + 4) + *(const GAS f32x4*)(a.in[20] + c0 + 4);
#pragma unroll
    for (int j = 0; j < 4; ++j) { y0[j] = y0[j] * pg8::fast_sigmoid(y0[j]); y1[j] = y1[j] * pg8::fast_sigmoid(y1[j]); }
    __builtin_amdgcn_raw_buffer_store_b128(pg8::pack8(y0, y1), pg8::mkrsrc(a.ws), (unsigned)((const char*)(CA + (size_t)(R_SAMPLE + s) * 1024 + c0) - (const char*)a.ws), 0, 16);
}

constexpr int L_SIDE = 131072;
static_assert(L_SIDE + 3 * 8 * 1024 <= LDSCTL_OFF, "side scratch vs LDS control words");
template <int K, int LDA, int LDW> __device__ __forceinline__ f32x4 skinny_slice(const bf16* Arow0, const bf16* Wrow0, int lane, int wave) {
    constexpr int KS = K / 8;
    const int fr = lane & 15, fq = lane >> 4;
    const bf16* ap = Arow0 + (size_t)fr * LDA + wave * KS + 8 * fq; const bf16* wp = Wrow0 + (size_t)fr * LDW + wave * KS + 8 * fq;
    f32x4 acc0 = (f32x4){0.f, 0.f, 0.f, 0.f}, acc1 = acc0;
#pragma unroll
    for (int k0 = 0; k0 < KS; k0 += 32) {
        const bf16x8 av = *(const GAS bf16x8*)(ap + k0), wv = *(const GAS bf16x8*)(wp + k0);
        if ((k0 >> 5) & 1) acc1 = __builtin_amdgcn_mfma_f32_16x16x32_bf16(wv, av, acc1, 0, 0, 0); else acc0 = __builtin_amdgcn_mfma_f32_16x16x32_bf16(wv, av, acc0, 0, 0, 0);
    }
    return acc0 + acc1;
}
__device__ __forceinline__ v2u pack4(const f32x4& v) { v2u w; w.x = pg8::cvt_pk_bf16(v[0], v[1]); w.y = pg8::cvt_pk_bf16(v[2], v[3]); return w; }
__device__ __forceinline__ f32x4 unpack4(const v2u& w) { return (f32x4){__uint_as_float(w.x << 16), __uint_as_float(w.x & 0xffff0000u), __uint_as_float(w.y << 16), __uint_as_float(w.y & 0xffff0000u)}; }
__device__ __forceinline__ f32x4 side_reduce(const LAS f32x4* part, int slot, int lane) {
    f32x4 s = part[(slot * 8) * 64 + lane];
#pragma unroll
    for (int w = 1; w < 8; ++w) s += part[(slot * 8 + w) * 64 + lane];
    return s;
}
__device__ __forceinline__ void side_p2(Frame& F, const Args& a, float* ss) {
    const bf16* HID = (const bf16*)(a.ws + WS_R2); const bf16* W2 = (const bf16*)(a.ws + WS_W2A); bf16* HB = (bf16*)a.out;
    float* hside = (float*)(a.ws + WS_HSIDE);
    LAS f32x4* part = (LAS f32x4*)(F.lds + L_SIDE);
    const int fr = F.lane & 15, fq = F.lane >> 4; constexpr int NT = 9 * 64;
    for (int t0 = blockIdx.x; t0 < NT; t0 += 3 * F.G) {
#pragma unroll
    for (int j = 0; j < 3; ++j) { const int t = t0 + j * F.G; if (t < NT) { const int rt = t >> 6, cs = t & 63;
        part[(j * 8 + F.wave) * 64 + F.lane] = skinny_slice<DFF, DFF, DFF>(HID + (size_t)(R_META + 16 * rt) * DFF, W2 + (size_t)(16 * cs) * DFF, F.lane, F.wave); } }
    __syncthreads();
    { const int t = t0 + F.wave * F.G;
      if (F.wave < 3 && t < NT) {
        const int rt = t >> 6, cs = t & 63; const int row0 = R_META + 16 * rt, col = 16 * cs + 4 * fq, row = row0 + fr;
        const f32x4 acc = side_reduce(part, F.wave, F.lane);
        const float* src = rt == 0 ? a.in[5] + (size_t)fr * D : a.in[1] + (size_t)(16 * (rt - 1) + fr) * D;
        const f32x4 h = NT_LOAD((const GAS f32x4*)(src + col)) + acc * 0.5f;
        *(GAS f32x4*)(hside + (size_t)(row - R_META) * D + col) = h;
        __builtin_amdgcn_raw_buffer_store_b64(pack4(h), pg8::mkrsrc(a.out), (unsigned)(((size_t)row * D + col) * 2), 0, 16);
        float p = pg8::sumsq4(h); p += __shfl_xor(p, 16); p += __shfl_xor(p, 32);
        if (fq == 0) atomicAdd(ss + row, p);
      } }
    __syncthreads();
    }
}
__device__ __forceinline__ void side_p5(Frame& F, const Args& a) {
    const bf16* AO = (const bf16*)(a.ws + WS_R1); const bf16* CA = AO + 512; const bf16* Wm = (const bf16*)(a.ws + WS_WMIX);
    const bf16* GA = (const bf16*)(a.ws + WS_GA); const bf16* GC = (const bf16*)(a.ws + WS_GC); bf16* MIXB = (bf16*)(a.ws + WS_MIXB);
    LAS f32x4* part = (LAS f32x4*)(F.lds + L_SIDE);
    const int fr = F.lane & 15, fq = F.lane >> 4; constexpr int NT = 8 * 64;
    for (int t0 = blockIdx.x; t0 < NT; t0 += 2 * F.G) {
#pragma unroll
    for (int j = 0; j < 2; ++j) { const int t = t0 + j * F.G; if (t < NT) { const int rt = t >> 6, cs = t & 63; const int row0 = R_SAMPLE + 16 * rt, col = 16 * cs + 4 * fq, row = row0 + fr;
        const f32x4 p1 = skinny_slice<512, 1024, 1024>(AO + (size_t)row0 * 1024, Wm + (size_t)(16 * cs) * 1024, F.lane, F.wave);
        const f32x4 p2 = skinny_slice<512, 1024, 1024>(CA + (size_t)row0 * 1024, Wm + (size_t)(16 * cs) * 1024 + 512, F.lane, F.wave);
        const v2u gaw = *(const GAS v2u*)(GA + (size_t)row * D + col), gcw = *(const GAS v2u*)(GC + (size_t)row * D + col);
        part[(j * 8 + F.wave) * 64 + F.lane] = unpack4(gaw) * p1 + unpack4(gcw) * p2; } }
    __syncthreads();
    { const int t = t0 + F.wave * F.G;
      if (F.wave < 2 && t < NT) {
        const int rt = t >> 6, cs = t & 63; const int row0 = R_SAMPLE + 16 * rt, col = 16 * cs + 4 * fq, row = row0 + fr;
        __builtin_amdgcn_raw_buffer_store_b64(pack4(side_reduce(part, F.wave, F.lane)), pg8::mkrsrc(a.ws), (unsigned)(WS_MIXB + ((size_t)row * D + col) * 2), 0, 16);
      } }
    __syncthreads();
    }
}
__device__ __forceinline__ void side_p6(Frame& F, const Args& a, float* ss) {
    const bf16* MIXB = (const bf16*)(a.ws + WS_MIXB); const bf16* Wo = (const bf16*)(a.ws + WS_WOUT); bf16* H2B = (bf16*)(a.ws + WS_R1);
    float* hside = (float*)(a.ws + WS_HSIDE);
    LAS f32x4* part = (LAS f32x4*)(F.lds + L_SIDE);
    const int fr = F.lane & 15, fq = F.lane >> 4; constexpr int NT = 8 * 64;
    for (int t0 = blockIdx.x; t0 < NT; t0 += 2 * F.G) {
#pragma unroll
    for (int j = 0; j < 2; ++j) { const int t = t0 + j * F.G; if (t < NT) { const int rt = t >> 6, cs = t & 63;
        part[(j * 8 + F.wave) * 64 + F.lane] = skinny_slice<D, D, D>(MIXB + (size_t)(R_SAMPLE + 16 * rt) * D, Wo + (size_t)(16 * cs) * D, F.lane, F.wave); } }
    __syncthreads();
    { const int t = t0 + F.wave * F.G;
      if (F.wave < 2 && t < NT) {
        const int rt = t >> 6, cs = t & 63; const int row0 = R_SAMPLE + 16 * rt, col = 16 * cs + 4 * fq, row = row0 + fr;
        const f32x4 acc = side_reduce(part, F.wave, F.lane);
        GAS f32x4* hp = (GAS f32x4*)(hside + (size_t)(row - R_META) * D + col);
        const f32x4 h = *hp + acc;
        __builtin_amdgcn_raw_buffer_store_b128(__builtin_bit_cast(v4u, h), pg8::mkrsrc(a.ws), (unsigned)(WS_HSIDE + ((size_t)(row - R_META) * D + col) * 4), 0, 16);
        __builtin_amdgcn_raw_buffer_store_b64(pack4(h), pg8::mkrsrc(a.ws), (unsigned)(WS_R1 + ((size_t)row * D + col) * 2), 0, 16);
        float p = pg8::sumsq4(h); p += __shfl_xor(p, 16); p += __shfl_xor(p, 32);
        if (fq == 0) atomicAdd(ss + row, p);
      } }
    __syncthreads();
    }
}
__device__ __forceinline__ void flush_block_wt(Frame& F, const Args& a, size_t off0, int nrows, int cb, int ldb) {
    const int per = cb / 16;
    for (int i = F.tid; i < nrows * per; i += NWAVES * 64) { const int r = i / per, c = i % per; const size_t o = off0 + (size_t)r * ldb + c * 16;
        const v4u v = *(const GAS v4u*)(a.ws + o);
        __builtin_amdgcn_raw_buffer_store_b128(v, pg8::mkrsrc(a.ws), (unsigned)o, 0, 16); }
}
__device__ __forceinline__ void side_p8(Frame& F, const Args& a) {
    const bf16* HID = (const bf16*)(a.ws + WS_R2); const bf16* W2 = (const bf16*)(a.ws + WS_W2B);
    const float* hside = (const float*)(a.ws + WS_HSIDE);
    LAS f32x4* part = (LAS f32x4*)(F.lds + L_SIDE);
    const int fr = F.lane & 15, fq = F.lane >> 4; constexpr int NT = 8 * 64;
    for (int t0 = blockIdx.x; t0 < NT; t0 += 2 * F.G) {
#pragma unroll
    for (int j = 0; j < 2; ++j) { const int t = t0 + j * F.G; if (t < NT) { const int rt = t >> 6, cs = t & 63;
        part[(j * 8 + F.wave) * 64 + F.lane] = skinny_slice<DFF, DFF, DFF>(HID + (size_t)(R_SAMPLE + 16 * rt) * DFF, W2 + (size_t)(16 * cs) * DFF, F.lane, F.wave); } }
    __syncthreads();
    { const int t = t0 + F.wave * F.G;
      if (F.wave < 2 && t < NT) {
        const int rt = t >> 6, cs = t & 63; const int row0 = R_SAMPLE + 16 * rt, col = 16 * cs + 4 * fq, row = row0 + fr;
        const f32x4 acc = side_reduce(part, F.wave, F.lane);
        const f32x4 h = *(const GAS f32x4*)(hside + (size_t)(row - R_META) * D + col);
        *(GAS f32x4*)(a.out + O_YS + (size_t)(row - R_SAMPLE) * D + col) = h + acc * 0.5f;
      } }
    __syncthreads();
    }
}

__device__ __forceinline__ void p4_mixers(Frame& F, const Args& a, int vx = -1) {
    { LAS float* tab = (LAS float*)(F.lds + L4_TAB);
      for (int i = F.tid; i < 8 * 192; i += NWAVES * 64) { const int h = i / 192, d = i % 192 - 32; tab[i] = (d >= 0 && d < 128) ? a.in[14][t5_bucket(d) * 8 + h] : -1e30f; }
      __syncthreads(); }
    const int G = F.G, c = blockIdx.x;
#ifdef P4_COPY
    { const v4u* q = (const v4u*)(a.ws + WS_QB); const v4u* g = (const v4u*)(a.ws + WS_GLU); v4u* ao = (v4u*)(a.ws + WS_R1); v4u* ca = ao + (size_t)MP * 64;
      for (size_t i = (size_t)c * 512 + F.tid; i < (size_t)MP * 64; i += (size_t)G * 512) { ao[i] = q[i]; ca[i] = g[i]; } return; }
#endif
#ifndef P4_MASK
#define P4_MASK 15
#endif
#ifndef P4_DUP
#define P4_DUP 0
#endif
    if (P4_MASK & 1) for (int u = vx >= 0 ? vx : c; u < 256; u += G) {
        int b, kvh, jb;
        if (vx >= 0) { const int x = u & 7, r = u >> 3; b = x >> 2; kvh = r & 1; jb = 16 * (x & 3) + (r >> 1); } else { b = u >> 7; kvh = (u >> 6) & 1; jb = u & 63; }
        attn_unit(F, a, b, kvh, jb); }
    if (P4_MASK & 2) for (int u = vx >= 0 ? vx : c; u < 256; u += G) {
        int bA, tA, bB, tB;
        if (vx >= 0) { const int x = u & 7, r = u >> 3; bA = bB = x >> 2; tA = 2048 * (x & 3) + 64 * r; tB = tA + 32; } else { const int uA = 2 * u, uB = uA + 1; bA = uA >> 8; tA = 32 * (uA & 255); bB = uB >> 8; tB = 32 * (uB & 255); }
        conv_pair(F, a, bA, tA, bB, tB); }
    if (P4_MASK & 4) for (int t = c * 4 + (F.wave & 3); t < ((P4_DUP & 4) ? 2048 : 1024) && F.wave < 4; t += G * 4) sample_attn_wave(F, a, (t & 1023) >> 3, t & 7, F.wave);
    if (P4_MASK & 8) for (int t = c * 4 + (F.wave & 3); t < ((P4_DUP & 8) ? 1152 : 128) && F.wave >= 4; t += G * 4) sample_conv_wave(F, a, t & 127);
}

__global__ void __launch_bounds__(NWAVES * 64, 2) mk_fwd(Args args) {
    extern __shared__ __attribute__((aligned(16))) unsigned char lds[];
    Frame F;
    F.lds = (LAS unsigned char*)lds;
    F.MISC = (volatile LAS unsigned*)(F.lds + MISC_OFF);
    F.tid = threadIdx.x; F.lane = F.tid & 63; F.wave = __builtin_amdgcn_readfirstlane(F.tid >> 6);
    F.G = gridDim.x;
    unsigned char* ws = args.ws;
    F.ctl = (gu32*)(ws + WS_CTL);
    for (int u = F.tid; u < (LDS_BYTES - LDSCTL_OFF) / 4; u += NWAVES * 64) ((LAS unsigned*)(F.lds + LDSCTL_OFF))[u] = 0u;
    __syncthreads();
    XcdBarrier bar; bar.bar = (unsigned*)(F.ctl + CW_BAR); bar.x = 0; bar.st = nullptr;
    if (!MK_SPLIT) bar = xcd_barrier_post((unsigned*)(F.ctl + CW_BAR), F.MISC + 8);
    const int lo = args.ph_lo, hi = args.ph_hi;
#ifndef PH_MASK
#define PH_MASK 0x1ff
#endif
#define IN(k) (((PH_MASK >> (k)) & 1) && lo <= (k) && (k) < hi)
#define SEAM(k) do { if (IN(k) && IN((k) + 1)) xcd_barrier(bar); } while (0)
#ifndef MULTI_ALIGN
#define MULTI_ALIGN true
#endif
#ifndef MULTI_SP2
#define MULTI_SP2 true
#endif
#ifndef AUXA_DOWN
#define AUXA_DOWN 0
#endif
#ifndef DUP_MASK
#define DUP_MASK 0
#endif
#ifndef SEAM0_LOCAL
#define SEAM0_LOCAL 1
#endif
#ifndef SEAM4_LOCAL
#define SEAM4_LOCAL 0
#endif
#ifndef FLUSH7
#define FLUSH7 1
#endif
#ifndef SEAM7_LOCAL
#define SEAM7_LOCAL 0
#endif
#ifndef SEAMW3
#define SEAMW3 (xloc ? bar.bar + XB_SEAM(2) : nullptr)
#endif
#ifndef SEAMW7
#define SEAMW7 (xloc ? bar.bar + XB_SEAM(6) : nullptr)
#endif
#define MK_STR2(x) #x
#define MK_STR(x) MK_STR2(x)
#define REP(k) for (int rep_ = 0; rep_ < (((DUP_MASK >> (k)) & 1) ? 2 : 1); ++rep_)
    const int bx = blockIdx.x;
    float* const ss1 = (float*)(F.ctl + CW_SS1); float* const ss2 = (float*)(F.ctl + CW_SS2); float* const ss3 = (float*)(F.ctl + CW_SS3);
    float* const outy = args.out + O_Y; float* const outys = args.out + O_YS; float* const hside = (float*)(ws + WS_HSIDE);
    bf16* const R1 = (bf16*)(ws + WS_R1); bf16* const HID = (bf16*)(ws + WS_R2); bf16* const HB = (bf16*)args.out;

#ifdef PROBE_TWICE
    for (int whole_ = 0; whole_ < 2; ++whole_) {
    if (whole_ == 1) { xcd_barrier(bar); for (int i = bx * 512 + F.tid; i < 2 * MP; i += F.G * 512) ss2[i] = 0.f; xcd_barrier(bar); }
#endif
    if (IN(0)) { p0_prologue(F, args); }
    bool xloc = false; int vx = bx;
#if LOCAL_SEAMS
    if (!MK_SPLIT && IN(0) && IN(1)) {
        xcd_census(bar);
        if (F.tid == 0) F.MISC[11] = xcd_layout_ok(bar, (unsigned)F.G) ? 1u : 0u;
        __syncthreads();
        xloc = F.MISC[11] != 0u;
        if (xloc) vx = (int)bar.x + 8 * (int)F.MISC[10];
#ifdef PROBE_XLOC
        if (xloc) { const unsigned long long t0_ = __builtin_amdgcn_s_memrealtime(); while (__builtin_amdgcn_s_memrealtime() - t0_ < PROBE_XLOC) __builtin_amdgcn_s_sleep(8); }
#endif
    }
#endif
    if (IN(0)) {
        if (xloc && SEAM0_LOCAL) {
            p0_rows<true>(F, args, 2048 * (vx & 7) + (vx >> 3) * NWAVES + F.wave, (F.G / 8) * NWAVES, 2048 / ((F.G / 8) * NWAVES));
            p0_rows<false>(F, args, NPROMPT + vx * NWAVES + F.wave, F.G * NWAVES, (MP - NPROMPT + F.G * NWAVES - 1) / (F.G * NWAVES));
        } else p0_rows<false>(F, args, bx * NWAVES + F.wave, F.G * NWAVES, (MP + F.G * NWAVES - 1) / (F.G * NWAVES));
        if (IN(1)) { if (xloc && SEAM0_LOCAL) { xcd_barrier_local(bar, 0); xcd_seam_wait(bar, 0); } else xcd_barrier(bar); }
    }
    if (IN(1)) REP(1) {
        pg8::Gemm g{R1, (const bf16*)(ws + WS_W13A), MP, 2 * DFF, D}; pg8::MainSideOrder S; int ir, nidle; S.init(NPROMPT, 2 * DFF, F.G, vx, nullptr, ir, nidle);
        pg8::EpiUp E{HID, DFF, ss1};
        pg8::gemm_phase<pg8::EpiUp, pg8::MainSideOrder, MULTI_ALIGN, MULTI_SP2>(F.lds, g, S, E);
#ifndef NO_IDLE_ITEMS
        if (ir >= 22) p0_items(F, args, P0_B0, P0_C0, ir - 22, nidle - 22);
#endif
        SEAM(1);
    }
#ifdef PROBE_P1
    if (IN(1)) {
        pg8::Gemm g{R1, (const bf16*)(ws + WS_W13A), MP, 2 * DFF, D}; pg8::StaticOrder S; S.init(MP, 2 * DFF, F.G, bx);
        if (PROBE_P1 == 3) { pg8::EpiUpT<1> E{(bf16*)(ws + WS_R3), DFF, ss1}; pg8::gemm_phase<pg8::EpiUpT<1>, pg8::StaticOrder, true, true>(F.lds, g, S, E); }
        else { pg8::EpiUp E{HID, DFF, ss1};
        pg8::gemm_phase<pg8::EpiUp, pg8::StaticOrder, true, true>(F.lds, g, S, E); }
        if (PROBE_P1 == 2) { const int nu = NTM * 22, rem = nu % F.G; if (bx >= rem) p0_items(F, args, P0_B0, P0_C0, bx - rem, F.G - rem); }
        xcd_barrier(bar);
    }
#endif
#ifdef PROBE_P2
    if (IN(2)) { float* const ssd = (PROBE_P2 >= 3) ? nullptr : (float*)(F.ctl + CW_SS3 + MP);
        if (PROBE_P2 == 1) side_p2(F, args, ssd);
        pg8::Gemm g{HID, (const bf16*)(ws + WS_W2A), NPROMPT, D, DFF}; pg8::StaticOrder S; S.init(NPROMPT, D, F.G, bx);
        pg8::EpiRes<0> E{nullptr, R1, nullptr, HB, ssd};
        pg8::gemm_phase<pg8::EpiRes<0>, pg8::StaticOrder, true, true>(F.lds, g, S, E);
        xcd_barrier(bar); }
#endif
#ifdef PROBE_P6
    if (IN(2)) { float* const ssd = (float*)(F.ctl + CW_SS3 + MP);
        pg8::Gemm g{HID, (const bf16*)(ws + WS_W2A), NPROMPT, D, D}; pg8::StaticOrder S; S.init(NPROMPT, D, F.G, bx);
        pg8::EpiRes<1> E{nullptr, R1, nullptr, (bf16*)(ws + WS_MIX), ssd};
        pg8::gemm_phase<pg8::EpiRes<1>, pg8::StaticOrder, true, true>(F.lds, g, S, E);
        xcd_barrier(bar); }
#endif
    if (IN(2)) REP(2) {
        pg8::Gemm g{HID, (const bf16*)(ws + WS_W2A), NPROMPT, D, DFF}; pg8::StaticOrder S; S.init(NPROMPT, D, F.G, vx);
        pg8::EpiRes<0> E{nullptr, R1, nullptr, HB, ss2};
        struct Post2 { Frame& F; const Args& a; float* ss; __device__ __forceinline__ void operator()() const { side_p2(F, a, ss); } } post{F, args, ss2};
        pg8::gemm_phase<pg8::EpiRes<0>, pg8::StaticOrder, true, true, Post2, AUXA_DOWN>(F.lds, g, S, E, post);
        if (xloc) xcd_barrier_local(bar, 2); else SEAM(2);
    }
#ifdef PROBE_BAR
    if (IN(2)) { for (int i_ = 0; i_ < PROBE_BAR; ++i_) xcd_barrier(bar); }
#endif
#ifdef PROBE_GEMM
    if (IN(2)) {
        if (PROBE_GEMM == 2) { pg8::Gemm g{HID, (const bf16*)(ws + WS_W2A), NPROMPT, D, DFF}; pg8::StaticOrder S; S.init(NPROMPT, D, F.G, bx); pg8::EpiNull E{hside}; pg8::gemm_phase<pg8::EpiNull, pg8::StaticOrder, true, true>(F.lds, g, S, E); }
        if (PROBE_GEMM == 1) { pg8::Gemm g{HID, (const bf16*)(ws + WS_W13A), MP, 2 * DFF, D}; pg8::StaticOrder S; S.init(MP, 2 * DFF, F.G, bx); pg8::EpiNull E{hside}; pg8::gemm_phase<pg8::EpiNull, pg8::StaticOrder, true, true>(F.lds, g, S, E); }
        if (PROBE_GEMM == 6) { pg8::Gemm g{HID, (const bf16*)(ws + WS_WOUT), NPROMPT, D, D}; pg8::StaticOrder S; S.init(NPROMPT, D, F.G, bx); pg8::EpiNull E{hside}; pg8::gemm_phase<pg8::EpiNull, pg8::StaticOrder, true, true>(F.lds, g, S, E); }
        xcd_barrier(bar);
    }
#endif
#ifdef PROBE_P12
    if (IN(2)) { float* const ssd = (float*)(F.ctl + CW_SS3 + MP);
        { pg8::Gemm g{R1, (const bf16*)(ws + WS_W13A), MP, 2 * DFF, D}; pg8::StaticOrder S; S.init(MP, 2 * DFF, F.G, bx);
          pg8::EpiUp E{HID, DFF, ss1};
          pg8::gemm_phase<pg8::EpiUp, pg8::StaticOrder, true, true>(F.lds, g, S, E); }
        xcd_barrier(bar);
        { pg8::Gemm g{HID, (const bf16*)(ws + WS_W2A), NPROMPT, D, DFF}; pg8::StaticOrder S; S.init(NPROMPT, D, F.G, bx);
          pg8::EpiRes<0> E{nullptr, R1, nullptr, HB, ssd};
          pg8::gemm_phase<pg8::EpiRes<0>, pg8::StaticOrder, true, true>(F.lds, g, S, E); }
        xcd_barrier(bar);
    }
#endif
    if (IN(3)) REP(3) {
        pg8::Gemm g{HB, (const bf16*)(ws + WS_WIN), MP, NIN, D}; pg8::MainSideOrder S; int ir, nidle; S.init(NPROMPT, NIN, F.G, vx, SEAMW3, ir, nidle);
        pg8::EpiWin E{ss2, args.in[12], args.in[13], ws, args.out};
        pg8::gemm_phase<pg8::EpiWin, pg8::MainSideOrder, MULTI_ALIGN, MULTI_SP2>(F.lds, g, S, E);
#ifndef NO_IDLE_ITEMS
        if (ir >= 15) p0_items(F, args, P0_C0, P0_C0 + P0_C_P3, ir - 15, nidle - 15);
#endif
        SEAM(3);
    }
#ifdef PROBE_P3
    if (IN(3)) {
        pg8::Gemm g{HB, (const bf16*)(ws + WS_WIN), MP, NIN, D}; pg8::StaticOrder S; S.init(MP, NIN, F.G, bx);
        pg8::EpiWin E{ss2, args.in[12], args.in[13], ws, args.out};
        pg8::gemm_phase<pg8::EpiWin, pg8::StaticOrder, true, true>(F.lds, g, S, E);
        if (PROBE_P3 == 2) { const int nu = NTM * 15, rem = nu % F.G; if (bx >= rem) p0_items(F, args, P0_C0, P0_C0 + P0_C_P3, bx - rem, F.G - rem); }
        xcd_barrier(bar);
    }
#endif
    if (IN(4)) REP(4) { p4_mixers(F, args, (xloc && SEAM4_LOCAL) ? vx : -1); VM_WAIT(); __syncthreads(); if (xloc && SEAM4_LOCAL) xcd_barrier_local(bar, 4); else SEAM(4); }
#ifdef PROBE_P4
    if (IN(4)) { p4_mixers(F, args); VM_WAIT(); __syncthreads(); xcd_barrier(bar); }
#endif
    if (IN(5)) REP(5) {
#ifdef PROBE_ICACHE
        { int x_ = F.tid; asm volatile(".rept " MK_STR(PROBE_ICACHE) "\n\tv_mov_b32_e64 %0, %0\n\t.endr" : "+v"(x_)); if (x_ == 0x7fffffff) F.MISC[12] = 1u; }
#endif
        pg8::Gemm g{R1, (const bf16*)(ws + WS_WMIX), NPROMPT, D, D}; pg8::StaticOrder S; S.init(NPROMPT, D, F.G, vx);
        pg8::EpiMix E{(const bf16*)(ws + WS_GA), (const bf16*)(ws + WS_GC), (bf16*)(ws + WS_MIXB)};
        struct Post5 { Frame& F; const Args& a; const XcdBarrier& bar; bool w; __device__ __forceinline__ void operator()() const { if (w) xcd_seam_wait(bar, 4); side_p5(F, a); } } post{F, args, bar, xloc && SEAM4_LOCAL};
        pg8::gemm_phase<pg8::EpiMix, pg8::StaticOrder, true, true, Post5>(F.lds, g, S, E, post);
        if (xloc) xcd_barrier_local(bar, 5); else SEAM(5);
    }
#ifdef PROBE_P5
    if (IN(5)) {
        if (PROBE_P5 == 1) side_p5(F, args);
#ifdef PROBE_DELAY
        if ((bx & 7) < 4) { const unsigned long long t0_ = __builtin_amdgcn_s_memrealtime(); while (__builtin_amdgcn_s_memrealtime() - t0_ < PROBE_DELAY) __builtin_amdgcn_s_sleep(8); }
#endif
        pg8::Gemm g{R1, (const bf16*)(ws + WS_WMIX), NPROMPT, D, D}; pg8::StaticOrder S; S.init(NPROMPT, D, F.G, bx);
        if (PROBE_P5 == 9 || PROBE_P5 == 10) { pg8::EpiMixT<0, PROBE_P5> E{(const bf16*)(ws + WS_GA), (const bf16*)(ws + WS_GC), (bf16*)(ws + WS_MIX)}; pg8::gemm_phase<pg8::EpiMixT<0, PROBE_P5>, pg8::StaticOrder, true, true>(F.lds, g, S, E); }
        else if (PROBE_P5 == 8) { pg8::EpiMixT<0, 8> E{(const bf16*)(ws + WS_GA), (const bf16*)(ws + WS_GC), (bf16*)(ws + WS_MIX)}; pg8::gemm_phase<pg8::EpiMixT<0, 8>, pg8::StaticOrder, true, true>(F.lds, g, S, E); }
        else if (PROBE_P5 >= 15 && PROBE_P5 <= 17) { pg8::EpiMixT<0, PROBE_P5 - 10> E{(const bf16*)(ws + WS_GA), (const bf16*)(ws + WS_GC), (bf16*)(ws + WS_MIX)}; pg8::gemm_phase<pg8::EpiMixT<0, PROBE_P5 - 10>, pg8::StaticOrder, true, true>(F.lds, g, S, E); }
        else if (PROBE_P5 == 6) { pg8::EpiMixT<0, 3> E{(const bf16*)(ws + WS_GA), (const bf16*)(ws + WS_GC), (bf16*)(ws + WS_MIX)}; pg8::gemm_phase<pg8::EpiMixT<0, 3>, pg8::StaticOrder, true, true>(F.lds, g, S, E); }
        else if (PROBE_P5 == 7) { pg8::EpiMixT<0, 4> E{(const bf16*)(ws + WS_GA), (const bf16*)(ws + WS_GC), (bf16*)(ws + WS_MIX)}; pg8::gemm_phase<pg8::EpiMixT<0, 4>, pg8::StaticOrder, true, true>(F.lds, g, S, E); }
        else if (PROBE_P5 == 4) { pg8::EpiMixT<0, 1> E{(const bf16*)(ws + WS_GA), (const bf16*)(ws + WS_GC), (bf16*)(ws + WS_MIX)}; pg8::gemm_phase<pg8::EpiMixT<0, 1>, pg8::StaticOrder, true, true>(F.lds, g, S, E); }
        else if (PROBE_P5 == 5) { pg8::EpiMixT<0, 2> E{(const bf16*)(ws + WS_GA), (const bf16*)(ws + WS_GC), (bf16*)(ws + WS_MIX)}; pg8::gemm_phase<pg8::EpiMixT<0, 2>, pg8::StaticOrder, true, true>(F.lds, g, S, E); }
        else if (PROBE_P5 == 3) { pg8::EpiMixT<0> E{(const bf16*)(ws + WS_GA), (const bf16*)(ws + WS_GC), (bf16*)(ws + WS_MIX)}; pg8::gemm_phase<pg8::EpiMixT<0>, pg8::StaticOrder, true, true>(F.lds, g, S, E); }
        else { pg8::EpiMix E{(const bf16*)(ws + WS_GA), (const bf16*)(ws + WS_GC), (bf16*)(ws + WS_MIXB)}; pg8::gemm_phase<pg8::EpiMix, pg8::StaticOrder, true, true>(F.lds, g, S, E); }
        SEAM(5);
    }
#endif
    if (IN(6)) REP(6) {
#ifdef P6_TEST
        pg8::Gemm g{(const bf16*)(ws + P6_TEST), (const bf16*)(ws + WS_WOUT), MP, D, D}; pg8::StaticOrder S; S.init(MP, D, F.G, bx);
        pg8::EpiRes<1> E{nullptr, HB, nullptr, (bf16*)(ws + WS_MIX), ss3};
#else
        pg8::Gemm g{(const bf16*)(ws + WS_MIXB), (const bf16*)(ws + WS_WOUT), NPROMPT, D, D}; pg8::StaticOrder S; S.init(NPROMPT, D, F.G, vx);
        pg8::EpiRes<1> E{nullptr, HB, nullptr, R1, ss3};
#endif
        struct Post6 { Frame& F; const Args& a; float* ss; const XcdBarrier& bar; bool xloc; __device__ __forceinline__ void operator()() const {
#ifndef P6_TEST
            if (xloc) xcd_seam_wait(bar, 5);
            side_p6(F, a, ss);
#endif
        } } post{F, args, ss3, bar, xloc};
        pg8::gemm_phase<pg8::EpiRes<1>, pg8::StaticOrder, true, true, Post6>(F.lds, g, S, E, post);
        if (xloc) xcd_barrier_local(bar, 6); else SEAM(6);
    }
#ifdef PROBE_P56
    if (IN(6)) { float* const ssd = (float*)(F.ctl + CW_SS3 + MP);
        xcd_barrier(bar);
        { side_p5(F, args);
          pg8::Gemm g{R1  , (const bf16*)(ws + WS_WMIX), NPROMPT, D, D}; pg8::StaticOrder S; S.init(NPROMPT, D, F.G, bx);
          pg8::EpiMix E{(const bf16*)(ws + WS_GA), (const bf16*)(ws + WS_GC), (bf16*)(ws + WS_MIX)};
          pg8::gemm_phase<pg8::EpiMix, pg8::StaticOrder, true, true>(F.lds, g, S, E); }
        xcd_barrier(bar);
        { pg8::Gemm g{(const bf16*)(ws + WS_MIX), (const bf16*)(ws + WS_WOUT), NPROMPT, D, D}; pg8::StaticOrder S; S.init(NPROMPT, D, F.G, bx);
          pg8::EpiRes<1> E{nullptr, HB, nullptr, (bf16*)(ws + WS_MIXB), ssd};
          pg8::gemm_phase<pg8::EpiRes<1>, pg8::StaticOrder, true, true>(F.lds, g, S, E); }
    }
#endif
    if (IN(7)) REP(7) {
        pg8::Gemm g{R1, (const bf16*)(ws + WS_W13B), MP, 2 * DFF, D}; pg8::MainSideOrder S; int ir, nidle; S.init(NPROMPT, 2 * DFF, F.G, vx, SEAMW7, ir, nidle);
        pg8::EpiUp E{HID, DFF, ss3};
        pg8::gemm_phase<pg8::EpiUp, pg8::MainSideOrder, MULTI_ALIGN, MULTI_SP2>(F.lds, g, S, E);
        if (FLUSH7 && xloc && SEAM7_LOCAL && ir >= 0 && ir < 22) flush_block_wt(F, args, WS_R2 + ((size_t)R_META * DFF + ir * 128) * 2, R_END - R_META, 256, DFF * 2);
#ifndef COPIES_IN_P0
        if (ir >= 22) p0_copies(F, args, ir - 22, nidle - 22);
#endif
        if (xloc && SEAM7_LOCAL) xcd_barrier_local(bar, 7); else SEAM(7);
    }
    if (IN(8)) REP(8) {
        pg8::Gemm g{HID, (const bf16*)(ws + WS_W2B), NPROMPT, D, DFF}; pg8::StaticOrder S; S.init(NPROMPT, D, F.G, vx);
        pg8::EpiRes<2> E{nullptr, R1, outy, nullptr, nullptr};
        struct Post8 { Frame& F; const Args& a; const XcdBarrier bar; bool w; __device__ __forceinline__ void operator()() const { if (w) xcd_seam_wait(bar, 7); side_p8(F, a); } } post{F, args, bar, xloc && SEAM7_LOCAL};
        pg8::gemm_phase<pg8::EpiRes<2>, pg8::StaticOrder, true, true, Post8, AUXA_DOWN>(F.lds, g, S, E, post);
    }
#ifdef PROBE_P8
    if (IN(8)) {
        xcd_barrier(bar);
        side_p8(F, args);
        pg8::Gemm g{HID, (const bf16*)(ws + WS_W2B), NPROMPT, D, DFF}; pg8::StaticOrder S; S.init(NPROMPT, D, F.G, bx);
        pg8::EpiRes<2> E{nullptr, R1, outy, nullptr, nullptr};
        pg8::gemm_phase<pg8::EpiRes<2>, pg8::StaticOrder, true, true>(F.lds, g, S, E);
    }
#endif
#ifdef PROBE_P0_END
    if (IN(8)) { xcd_barrier(bar); p0_prologue(F, args); }
#endif
#ifdef PROBE_TWICE
    }
#endif
#undef IN
#undef SEAM
}

extern "C" void kernel_launch(void* const* d_in, const int* in_sizes, int n_in, void* d_out, int out_size, void* d_ws, size_t ws_size, hipStream_t stream) {
    static int grid = 0;
    if (grid == 0) {
        if (n_in != 27 || ws_size < WS_END) { fprintf(stderr, "kernel_launch: unexpected n_in %d / ws %zu\n", n_in, ws_size); grid = -1; return; }
        int dev = 0, cus = 0, per_cu = 0;
        if (hipGetDevice(&dev) != hipSuccess || hipDeviceGetAttribute(&cus, hipDeviceAttributeMultiprocessorCount, dev) != hipSuccess) { grid = -1; return; }
        if (hipFuncSetAttribute((const void*)mk_fwd, hipFuncAttributeMaxDynamicSharedMemorySize, LDS_BYTES) != hipSuccess) { fprintf(stderr, "kernel_launch: hipFuncSetAttribute failed\n"); grid = -1; return; }
        if (hipOccupancyMaxActiveBlocksPerMultiprocessor(&per_cu, (const void*)mk_fwd, NWAVES * 64, LDS_BYTES) != hipSuccess || per_cu < 1) { fprintf(stderr, "kernel_launch: occupancy query failed (%d)\n", per_cu); (void)hipGetLastError(); per_cu = 1; }
        grid = cus * 1;
        fprintf(stderr, "kernel_launch: cus %d per_cu %d grid %d\n", cus, per_cu, grid);
    }
    if (grid < 0) return;
    (void)hipMemsetAsync((char*)d_ws + WS_CTL, 0, CTL_ZERO_BYTES, stream);
    Args a{};
    for (int i = 0; i < 27; ++i) a.in[i] = (const float*)d_in[i];
    a.out = (float*)d_out; a.ws = (unsigned char*)d_ws;
#if MK_SPLIT
    for (int p = 0; p < N_PHASES; ++p) { a.ph_lo = p; a.ph_hi = p + 1; hipLaunchKernelGGL(mk_fwd, dim3(grid), dim3(NWAVES * 64), LDS_BYTES, stream, a); }
#else
    a.ph_lo = 0; a.ph_hi = N_PHASES;
    void* kargs[] = {&a};
#ifdef PROBE_PLAIN_LAUNCH
    hipLaunchKernelGGL(mk_fwd, dim3(grid), dim3(NWAVES * 64), LDS_BYTES, stream, a); hipError_t e = hipSuccess; (void)kargs;
#else
    hipError_t e = hipLaunchCooperativeKernel((const void*)mk_fwd, dim3(grid), dim3(NWAVES * 64), kargs, LDS_BYTES, stream);
#endif
    if (e != hipSuccess) fprintf(stderr, "kernel_launch: cooperative launch failed: %s (grid %d)\n", hipGetErrorString(e), grid);
#ifdef PROBE_EMPTY_LAUNCH
    { Args a2 = a; a2.ph_lo = 0; a2.ph_hi = 0; void* kargs2[] = {&a2};
      (void)hipLaunchCooperativeKernel((const void*)mk_fwd, dim3(grid), dim3(NWAVES * 64), kargs2, LDS_BYTES, stream); }
#endif
#ifdef PROBE_2LAUNCH
    (void)hipMemsetAsync((char*)d_ws + WS_CTL, 0, CTL_ZERO_BYTES, stream);
    (void)hipLaunchCooperativeKernel((const void*)mk_fwd, dim3(grid), dim3(NWAVES * 64), kargs, LDS_BYTES, stream);
#endif
#endif
}
```

```cpp
#define MK_SPLIT 0
#include <hip/hip_runtime.h>
#include <cstdio>
#include <cstdint>

constexpr int NWAVES = 8;
#ifndef MK_SPLIT
#define MK_SPLIT 0
#endif
constexpr int N_PHASES = 9;

constexpr int D = 1024, DFF = 2816, SEQ = 8192, NPROMPT = 16384, R_META = 16384, R_SAMPLE = 16400, R_END = 16528, MP = 16640, NTM = 65;
constexpr int NIN = 3840;
constexpr float EPS = 1e-6f;
constexpr size_t O_Y = 0, O_YS = 16777216, O_NKP = 16908288, O_NVP = 16941056, O_NCP = 16973824, O_NKS = 17004544, O_NVS = 19101696, O_NCS = 21198848;

constexpr size_t MiB = 1u << 20;
constexpr size_t WS_CTL = 0, CTL_ZERO_BYTES = 1 * MiB;
constexpr size_t WS_HSIDE = 1 * MiB;
constexpr size_t WS_W13A = 2 * MiB, WS_W2A = 13 * MiB, WS_WIN = 19 * MiB, WS_WMIX = 27 * MiB, WS_WOUT = 29 * MiB, WS_W13B = 31 * MiB, WS_W2B = 42 * MiB;
constexpr size_t WS_R1 = 48 * MiB;
constexpr size_t WS_R2 = 81 * MiB;
constexpr size_t WS_R3 = 171 * MiB;
constexpr size_t SZ_ROWS1K = (size_t)MP * 1024 * 2;
constexpr size_t WS_GA = WS_R2, WS_GC = WS_R2 + SZ_ROWS1K;
constexpr size_t WS_QB = WS_R3, WS_KB = WS_QB + (size_t)MP * 512 * 2, WS_VB = WS_KB + (size_t)MP * 128 * 2, WS_GLU = WS_VB + (size_t)MP * 128 * 2;
constexpr size_t WS_MIXB = WS_R3, WS_MIX = WS_R3 + 41 * MiB;
constexpr size_t WS_END = 256 * MiB;
static_assert(WS_W2B + (size_t)1024 * 2816 * 2 <= WS_R1 && WS_R1 + SZ_ROWS1K <= WS_R2 && WS_R2 + (size_t)MP * 2816 * 2 <= WS_R3 && WS_GC + SZ_ROWS1K <= WS_R3, "ws map 1");
static_assert(WS_GLU + (size_t)MP * 512 * 2 <= WS_MIX && WS_MIXB + SZ_ROWS1K <= WS_MIX && WS_MIX + SZ_ROWS1K <= WS_END, "ws map 2");
constexpr int CW_TMO = 0;
constexpr int CW_BAR = 4096;
constexpr int CW_SS1 = 32768, CW_SS2 = CW_SS1 + MP, CW_SS3 = CW_SS2 + MP;
static_assert((CW_SS3 + MP) * 4 <= (int)CTL_ZERO_BYTES, "ctl");

constexpr int RING_BYTES = 131072, LDSCTL_OFF = 159744, MISC_OFF = LDSCTL_OFF + 320, LDS_BYTES = 163840;

#define GAS __attribute__((address_space(1)))
#define LAS __attribute__((address_space(3)))
typedef unsigned short bf16;
typedef unsigned v4u __attribute__((ext_vector_type(4)));
typedef unsigned v2u __attribute__((ext_vector_type(2)));
typedef float f32x4 __attribute__((ext_vector_type(4)));
typedef float f32x16 __attribute__((ext_vector_type(16)));
typedef short bf16x8 __attribute__((ext_vector_type(8)));
typedef GAS unsigned gu32;
#define RLX_AGENT __ATOMIC_RELAXED, __HIP_MEMORY_SCOPE_AGENT
#define LDS_WAIT() asm volatile("s_waitcnt lgkmcnt(0)" ::: "memory")
#define VM_WAIT() asm volatile("s_waitcnt vmcnt(0)" ::: "memory")
__device__ __forceinline__ unsigned f2bf(float f) { unsigned u = __builtin_bit_cast(unsigned, f); return (u + 0x7fffu + ((u >> 16) & 1u)) >> 16; }
__device__ __forceinline__ unsigned pk2(float lo, float hi) { return f2bf(lo) | (f2bf(hi) << 16); }
__device__ __forceinline__ float bf2f(unsigned short h) { return __uint_as_float((unsigned)h << 16); }
#ifndef PG8_WGM
#define PG8_WGM 8
#endif
namespace pg8 {
#define PG8_LAS __attribute__((address_space(3)))
typedef unsigned short bf16_t;
typedef short bf16x8 __attribute__((ext_vector_type(8)));
typedef float f32x4 __attribute__((ext_vector_type(4)));
typedef unsigned u32x4 __attribute__((ext_vector_type(4)));
constexpr int BM = 256, BK = 64, HALF = 128, HTB = HALF * BK * 2  , STAGE_BYTES = 8 * HTB, NXCD = 8, WGM = PG8_WGM;

__host__ __device__ __forceinline__ int lds_byte(int r, int c) { const int st = (r >> 4) * 2 + (c >> 5), rr = r & 15, cc = c & 31, ob = rr * 64 + cc * 2; return st * 1024 + (ob ^ (((ob >> 9) & 1) << 5)); }
__host__ __device__ __forceinline__ void stage_rc(int b, int& R, int& C) { const int st = b / 1024, sb = b % 1024, swz = sb ^ (((sb >> 9) & 1) << 5); R = (st >> 1) * 16 + swz / 64; C = (st & 1) * 32 + (swz % 64) / 2; }
__host__ __device__ __forceinline__ int perm32(int rho) { const int n = rho >> 4, i = rho & 15; return 8 * (i >> 2) + 4 * n + (i & 3); }

struct Unit { int pm, pn; };
struct Gemm { const bf16_t* A; const bf16_t* Bt; int M, N, K; };

struct StaticOrder {
    int nM, nN, nwg, G, c;
    __host__ __device__ void init(int M, int N, int G_, int c_) { nM = M / BM; nN = N / BM; nwg = nM * nN; G = G_; c = c_; }
    __host__ __device__ bool next(int i, Unit& u) const {
        const long L = (long)i * G + c; if (L >= nwg) return false;
        int wgid = (int)L; { const int q = nwg / NXCD, r = nwg % NXCD, xcd = wgid % NXCD, off = wgid / NXCD; wgid = (xcd < r ? xcd * (q + 1) : r * (q + 1) + (xcd - r) * q) + off; }
        const int nig = WGM * nN, gid = wgid / nig, fm = gid * WGM, gsz = (nM - fm) < WGM ? (nM - fm) : WGM;
        u.pm = fm + ((wgid % nig) % gsz); u.pn = (wgid % nig) / gsz; return true;
    }
    __device__ __forceinline__ void a_ready(const Unit&) const {}
    __device__ __forceinline__ void done(const Unit&) const {}
};

struct MainSideOrder {
    static constexpr int PMS = 64;
    StaticOrder m; int nmain, sidepn; unsigned* seamw;
    __device__ void init(int Mmain, int N, int G, int c, unsigned* seamw_, int& ir, int& nidle) {
        m.init(Mmain, N, G, c); seamw = seamw_;
        nmain = c < m.nwg ? (m.nwg - 1 - c) / G + 1 : 0;
        const int rem = m.nwg % G; nidle = rem == 0 ? G : G - rem; ir = rem == 0 ? c : c - rem;
        sidepn = (ir >= 0 && ir < m.nN) ? ir : -1;
    }
    __device__ bool next(int i, Unit& u) const {
        if (i < nmain) return m.next(i, u);
        if (i > nmain || sidepn < 0) return false;
        u.pm = PMS; u.pn = sidepn; return true;
    }
    __device__ __forceinline__ void a_ready(const Unit& u) const {
        if (seamw && u.pm == PMS) {
            unsigned sp = 0;
            while (__hip_atomic_load(seamw, __ATOMIC_RELAXED, __HIP_MEMORY_SCOPE_AGENT) < 8u) { __builtin_amdgcn_s_sleep(1); if (++sp > (1u << 22)) break; }
            __builtin_amdgcn_fence(__ATOMIC_ACQUIRE, "agent");
            asm volatile("s_waitcnt vmcnt(0)" ::: "memory");
        }
    }
    __device__ __forceinline__ void done(const Unit&) const {}
};
typedef float f32x2 __attribute__((ext_vector_type(2)));
typedef __bf16 bf16x2_t __attribute__((ext_vector_type(2)));
__device__ __forceinline__ unsigned cvt_pk_bf16(float lo, float hi) { const f32x2 v = {lo, hi}; const bf16x2_t b = __builtin_convertvector(v, bf16x2_t); return __builtin_bit_cast(unsigned, b); }

constexpr int ROWS_PROMPT = 16384, ROW_META = 16384, ROW_SAMPLE = 16400, ROW_END = 16528, MPAD = 16640, DM = 1024;
constexpr float LOG2E = 1.4426950408889634f;
__device__ __forceinline__ float fast_sigmoid(float x) { return __builtin_amdgcn_rcpf(1.0f + __builtin_amdgcn_exp2f(-x * LOG2E)); }
__device__ __forceinline__ u32x4 pack8(const f32x4& a, const f32x4& b) { u32x4 w; w.x = cvt_pk_bf16(a[0], a[1]); w.y = cvt_pk_bf16(a[2], a[3]); w.z = cvt_pk_bf16(b[0], b[1]); w.w = cvt_pk_bf16(b[2], b[3]); return w; }
#ifndef MID_BATCH_MASK
#define MID_BATCH_MASK 1
#endif
#ifndef RES_WT
#define RES_WT 0
#endif
#ifndef MIX_WT
#define MIX_WT 0
#endif
#ifndef WIDE_ST
#define WIDE_ST 1
#endif
#ifndef Y_FULL_LINES
#define Y_FULL_LINES 1
#endif
#ifndef MIX_PRELOAD16
#define MIX_PRELOAD16 0
#endif
#ifndef PF_RES
#define PF_RES 0
#endif
#ifndef PF_MIX
#define PF_MIX 0
#endif
#ifndef NT_RES
#define NT_RES 0
#endif
#ifndef NT_Y
#define NT_Y 1
#endif
#if NT_RES
#define RES_LOAD(p) __builtin_nontemporal_load(p)
#else
#define RES_LOAD(p) (*(p))
#endif
#if NT_Y >= 2
#if NT_Y == 2
#define Y_FLAVOUR "sc1 nt"
#elif NT_Y == 3
#define Y_FLAVOUR "sc0 sc1 nt"
#elif NT_Y == 4
#define Y_FLAVOUR "sc0 sc1"
#else
#define Y_FLAVOUR "sc0 nt"
#endif
__device__ __forceinline__ void y_store_asm(const f32x4& v, f32x4* p) { asm volatile("global_store_dwordx4 %0, %1, off " Y_FLAVOUR "\n\ts_nop 1" :: "v"(p), "v"(v) : "memory"); }
#define Y_STORE(v, p) y_store_asm((v), (p))
#elif NT_Y
#define Y_STORE(v, p) __builtin_nontemporal_store((v), (p))
#else
#define Y_STORE(v, p) (*(p) = (v))
#endif
#ifndef MK_WT
#define MK_WT 16
#endif
__device__ __forceinline__ __amdgpu_buffer_rsrc_t mkrsrc(const void* p) { return __builtin_amdgcn_make_buffer_rsrc((void*)p, 0, 0x10000000, 0x00020000); }
#define ST16(rsrc, byteoff, v) __builtin_amdgcn_raw_buffer_store_b128((v), (rsrc), (unsigned)(byteoff), 0, MK_WT)
#ifndef MK_WT_MULTI
#define MK_WT_MULTI 0
#endif
#define ST16M(rsrc, byteoff, v) __builtin_amdgcn_raw_buffer_store_b128((v), (rsrc), (unsigned)(byteoff), 0, MK_WT_MULTI)
template <int AUX = MK_WT> __device__ __forceinline__ void st_wide(const __amdgpu_buffer_rsrc_t rs, size_t off_grp, int fr, const u32x4& p0, const u32x4& p1) {
    const bool lo8 = fr < 8;
    u32x4 dA, dB;
#pragma unroll
    for (int j = 0; j < 4; ++j) { const unsigned send = lo8 ? p1[j] : p0[j]; const unsigned got = (unsigned)__builtin_amdgcn_mov_dpp((int)send, 0x128, 0xf, 0xf, true);
        dA[j] = lo8 ? p0[j] : got; dB[j] = lo8 ? got : p1[j]; }
    const size_t o = off_grp + (size_t)(fr & 7) * DM + 8 * (fr >> 3);
    __builtin_amdgcn_raw_buffer_store_b128(dA, rs, (unsigned)(o * 2), 0, AUX); __builtin_amdgcn_raw_buffer_store_b128(dB, rs, (unsigned)((o + 8 * DM) * 2), 0, AUX);
}
__device__ __forceinline__ float sum4(const f32x4& a) { return (a[0] + a[1]) + (a[2] + a[3]); }
__device__ __forceinline__ float sumsq4(const f32x4& a) { return (a[0] * a[0] + a[1] * a[1]) + (a[2] * a[2] + a[3] * a[3]); }

struct EpiUp {
    static constexpr bool PERM = true, AFTER_DRAIN = false, WIDE = false; static constexpr int MID_T = 0, PF_T = 0;
    bf16_t* O; int ldc; const float* ss;
    __device__ __forceinline__ void operator()(const f32x4 (&acc)[2][2][4][2], const Unit& u, int wr, int wc, int fr, int fq) const {
        const int row0 = u.pm * BM + wr * 64 + fr, col0 = u.pn * 128 + wc * 32 + 8 * fq;
        const __amdgpu_buffer_rsrc_t rs = mkrsrc(O);
        float sv[2][4];
#pragma unroll
        for (int ai = 0; ai < 2; ++ai)
#pragma unroll
            for (int m = 0; m < 4; ++m) sv[ai][m] = ss[row0 + ai * HALF + m * 16];
#pragma unroll
        for (int ai = 0; ai < 2; ++ai)
#pragma unroll
            for (int m = 0; m < 4; ++m) {
                const int row = row0 + ai * HALF + m * 16;
                const float s = __builtin_amdgcn_rsqf(sv[ai][m] * (1.0f / 1024.0f) + 1e-6f);
                const float c = -s * LOG2E, s2 = s * s;
                f32x4 o[2];
#pragma unroll
                for (int n = 0; n < 2; ++n)
#pragma unroll
                    for (int j = 0; j < 4; j += 2) {
                        const f32x2 g = {acc[ai][0][m][n][j], acc[ai][0][m][n][j + 1]}, up = {acc[ai][1][m][n][j], acc[ai][1][m][n][j + 1]};
                        const f32x2 t = g * c; f32x2 e; e.x = __builtin_amdgcn_exp2f(t.x); e.y = __builtin_amdgcn_exp2f(t.y);
                        const f32x2 d = e + 1.0f; f32x2 r; r.x = __builtin_amdgcn_rcpf(d.x); r.y = __builtin_amdgcn_rcpf(d.y);
                        const f32x2 v = (g * up) * (r * s2);
                        o[n][j] = v.x; o[n][j + 1] = v.y;
                    }
                ST16M(rs, ((size_t)row * ldc + col0) * 2, pack8(o[0], o[1]));
            }
    }
};

template <int MODE> struct EpiRes {
    static constexpr bool PERM = true, AFTER_DRAIN = false, WIDE = (WIDE_ST != 0) && MODE != 2; static constexpr int MID_T = 0, PF_T = PF_RES;
    const float* xf; const bf16_t* xb; float* outy; bf16_t* ob; float* ss;
    __device__ __forceinline__ void prefetch(const Unit& u, int wid, int lane, PG8_LAS unsigned char* dummy) const {
        int tid = wid * 64 + lane; asm volatile("" : "+v"(tid));
#pragma unroll
        for (int i = 0; i < 2; ++i) { const int L = tid + 512 * i;
            __builtin_amdgcn_global_load_lds((const unsigned*)(xb + (size_t)(u.pm * BM + (L >> 2)) * DM + u.pn * BM + (L & 3) * 64), (PG8_LAS unsigned*)(dummy + wid * 256), 4, 0, 0); }
    }
    __device__ __forceinline__ void operator()(const f32x4 (&acc)[2][2][4][2], const Unit& u, int wr, int wc, int fr, int fq) const {
        const int row0 = u.pm * BM + wr * 64 + fr, col0 = u.pn * BM + (WIDE ? wc * 64 + 16 * fq : wc * 32 + 8 * fq);
        constexpr int BJS = WIDE ? 8 : HALF;
        const float alpha = (MODE == 1) ? 1.0f : 0.5f;
        const __amdgpu_buffer_rsrc_t rs = mkrsrc(ob);
#pragma unroll
        for (int ai = 0; ai < 2; ++ai) {
            u32x4 rw[4][2];
#pragma unroll
            for (int m = 0; m < 4; ++m)
#pragma unroll
                for (int bj = 0; bj < 2; ++bj) rw[m][bj] = RES_LOAD((const u32x4*)(xb + (size_t)(row0 + ai * HALF + m * 16) * DM + col0 + bj * BJS));
            float parts[4];
#pragma unroll
            for (int m = 0; m < 4; ++m) {
                const size_t off = (size_t)(row0 + ai * HALF + m * 16) * DM + col0;
                float part = 0.f; u32x4 pw[2];
#pragma unroll
                for (int bj = 0; bj < 2; ++bj) {
                    const u32x4 w = rw[m][bj];
                    const f32x4 r0 = (f32x4){__uint_as_float(w.x << 16), __uint_as_float(w.x & 0xffff0000u), __uint_as_float(w.y << 16), __uint_as_float(w.y & 0xffff0000u)};
                    const f32x4 r1 = (f32x4){__uint_as_float(w.z << 16), __uint_as_float(w.z & 0xffff0000u), __uint_as_float(w.w << 16), __uint_as_float(w.w & 0xffff0000u)};
                    const f32x4 o0 = r0 + acc[ai][bj][m][0] * alpha, o1 = r1 + acc[ai][bj][m][1] * alpha;
                    if (MODE == 2) {
#if Y_FULL_LINES
                        const bool lo8 = fr < 8;
                        f32x4 keep, got;
#pragma unroll
                        for (int j = 0; j < 4; ++j) { keep[j] = lo8 ? o0[j] : o1[j]; const float send = lo8 ? o1[j] : o0[j];
                            got[j] = __int_as_float(__builtin_amdgcn_mov_dpp(__float_as_int(send), 0x128, 0xf, 0xf, true)); }
                        float* pA = outy + off - (size_t)(fr >> 3) * (8 * DM) + bj * HALF + (fr >> 3) * 4;
                        f32x4 dA, dB;
#pragma unroll
                        for (int j = 0; j < 4; ++j) { dA[j] = lo8 ? keep[j] : got[j]; dB[j] = lo8 ? got[j] : keep[j]; }
                        Y_STORE(dA, (f32x4*)pA); Y_STORE(dB, (f32x4*)(pA + 8 * DM));
#else
                        Y_STORE(o0, (f32x4*)(outy + off + bj * HALF)); Y_STORE(o1, (f32x4*)(outy + off + bj * HALF + 4));
#endif
                    }
                    else { if (WIDE) pw[bj] = pack8(o0, o1); else ST16(rs, (off + bj * HALF) * 2, pack8(o0, o1)); part += sumsq4(o0) + sumsq4(o1); }
                }
                if (MODE != 2 && WIDE) st_wide<RES_WT>(rs, off - (size_t)fr * DM, fr, pw[0], pw[1]);
                if (MODE != 2) { part += __shfl_xor(part, 16); part += __shfl_xor(part, 32); }
                parts[m] = part;
            }
            if (MODE != 2 && ss) { const float mine = fq == 0 ? parts[0] : fq == 1 ? parts[1] : fq == 2 ? parts[2] : parts[3];
                atomicAdd(ss + (u.pm * BM + ai * HALF + wr * 64 + 16 * fq + fr), mine); }
        }
    }
};

struct EpiWin {
    static constexpr bool PERM = true, AFTER_DRAIN = false, WIDE = false; static constexpr int MID_T = 0, PF_T = 0;
    const float* ss; const float *qn, *kn; unsigned char* ws; float* out;
    static constexpr size_t O_NKP = 16908288, O_NVP = 16941056, O_NCP = 16973824, O_NKS = 17004544, O_NVS = 19101696, O_NCS = 21198848;
    __device__ __forceinline__ void operator()(const f32x4 (&acc)[2][2][4][2], const Unit& u, int wr, int wc, int fr, int fq) const {
        const int row0 = u.pm * BM + wr * 64 + fr; const int pn = u.pn;
        const __amdgpu_buffer_rsrc_t rs = mkrsrc(ws);
        const bool side_rows = (u.pm == 31 || u.pm == 63 || u.pm == 64);
        float sv[2][4];
#pragma unroll
        for (int ai = 0; ai < 2; ++ai)
#pragma unroll
            for (int m = 0; m < 4; ++m) sv[ai][m] = ss[row0 + ai * HALF + m * 16];
#pragma unroll
        for (int ai = 0; ai < 2; ++ai)
#pragma unroll
            for (int m = 0; m < 4; ++m) {
                const int row = row0 + ai * HALF + m * 16;
                const float s = __builtin_amdgcn_rsqf(sv[ai][m] * (1.0f / 1024.0f) + 1e-6f);
                const float cexp = -s * LOG2E;
                f32x4 v[2][2];
                if (pn < 7) {
#pragma unroll
                    for (int bj = 0; bj < 2; ++bj)
#pragma unroll
                        for (int n = 0; n < 2; ++n) v[bj][n] = acc[ai][bj][m][n] * ((pn >= 3 && bj == 1) ? cexp : s);
                }
                if (pn < 3) {
                    const bool isv = (pn == 2 && wc >= 2), isq = (pn < 2);
                    if (!isv) {
                        float q = (sumsq4(v[0][0]) + sumsq4(v[0][1])) + (sumsq4(v[1][0]) + sumsq4(v[1][1]));
                        q += __shfl_xor(q, 16); q += __shfl_xor(q, 32);
                        const float r = __builtin_amdgcn_rsqf(q * (1.0f / 64.0f) + 1e-6f) * (isq ? 0.125f : 1.0f);
                        const float* gn = isq ? qn : kn;
#pragma unroll
                        for (int bj = 0; bj < 2; ++bj)
#pragma unroll
                            for (int n = 0; n < 2; ++n) { const f32x4 gv = *(const f32x4*)(gn + 32 * bj + 8 * fq + 4 * n); v[bj][n] = v[bj][n] * r * gv; }
                    }
                    size_t obase; int ocol; int ld;
                    if (isq) { obase = WS_QB; ld = 512; ocol = (4 * pn + wc) * 64; } else if (!isv) { obase = WS_KB; ld = 128; ocol = wc * 64; } else { obase = WS_VB; ld = 128; ocol = (wc - 2) * 64; }
#pragma unroll
                    for (int bj = 0; bj < 2; ++bj) ST16M(rs, obase + ((size_t)row * ld + ocol + 32 * bj + 8 * fq) * 2, pack8(v[bj][0], v[bj][1]));
                    if (!isq && side_rows) {
                        float* o = nullptr; const int kvh = isv ? wc - 2 : wc;
                        if (row < ROWS_PROMPT) { const int b = row >> 13, t = row & 8191; if (t >= 8064) o = out + (isv ? O_NVP : O_NKP) + (size_t)((b * 128 + (t - 8064)) * 2 + kvh) * 64; }
                        else if (row >= ROW_SAMPLE && row < ROW_END) o = out + (isv ? O_NVS : O_NKS) + (size_t)(((row - ROW_SAMPLE) * 128 + 127) * 2 + kvh) * 64;
                        if (o) {
#pragma unroll
                            for (int bj = 0; bj < 2; ++bj)
#pragma unroll
                                for (int n = 0; n < 2; ++n) *(f32x4*)(o + 32 * bj + 8 * fq + 4 * n) = v[bj][n];
                        }
                    }
                } else if (pn < 7) {
                    const int ch = 128 * (pn - 3) + 32 * wc + 8 * fq;
                    f32x4 g[2];
#pragma unroll
                    for (int n = 0; n < 2; ++n)
#pragma unroll
                        for (int j = 0; j < 4; ++j) g[n][j] = v[0][n][j] * __builtin_amdgcn_rcpf(1.0f + __builtin_amdgcn_exp2f(v[1][n][j]));
                    ST16M(rs, WS_GLU + ((size_t)row * 512 + ch) * 2, pack8(g[0], g[1]));
                    if (side_rows) {
                        float* o = nullptr;
                        if (row < ROWS_PROMPT) { const int b = row >> 13, t = row & 8191; if (t >= 8162) o = out + O_NCP + (size_t)(b * 30 + (t - 8162)) * 512; }
                        else if (row >= ROW_SAMPLE && row < ROW_END) o = out + O_NCS + (size_t)((row - ROW_SAMPLE) * 30 + 29) * 512;
                        if (o) { *(f32x4*)(o + ch) = g[0]; *(f32x4*)(o + ch + 4) = g[1]; }
                    }
                } else {
                    const size_t obase = pn < 11 ? WS_GA : WS_GC; const int col = 256 * (pn < 11 ? pn - 7 : pn - 11) + 32 * wc + 8 * fq;
#pragma unroll
                    for (int bj = 0; bj < 2; ++bj) {
                        f32x4 g[2];
#pragma unroll
                        for (int n = 0; n < 2; ++n)
#pragma unroll
                            for (int j = 0; j < 4; ++j) g[n][j] = __builtin_amdgcn_rcpf(1.0f + __builtin_amdgcn_exp2f(acc[ai][bj][m][n][j] * cexp));
                        ST16M(rs, obase + ((size_t)row * DM + col + bj * HALF) * 2, pack8(g[0], g[1]));
                    }
                }
            }
    }
};

template <int MIDT, int VAR = 0> struct EpiMixT {
    static constexpr bool PERM = true, AFTER_DRAIN = false, WIDE = (WIDE_ST != 0); static constexpr int MID_T = MIDT, PF_T = PF_MIX;
    const bf16_t *GA, *GC; bf16_t* MIXB;
    __device__ __forceinline__ void prefetch(const Unit& u, int wid, int lane, PG8_LAS unsigned char* dummy) const {
        int tid = wid * 64 + lane; asm volatile("" : "+v"(tid));
#pragma unroll
        for (int i = 0; i < 2; ++i) { const int L = tid + 512 * i; const size_t o = (size_t)(u.pm * BM + (L >> 2)) * DM + u.pn * BM + (L & 3) * 64;
            __builtin_amdgcn_global_load_lds((const unsigned*)(GA + o), (PG8_LAS unsigned*)(dummy + wid * 256), 4, 0, 0);
            __builtin_amdgcn_global_load_lds((const unsigned*)(GC + o), (PG8_LAS unsigned*)(dummy + wid * 256), 4, 0, 0); }
    }
    static __device__ __forceinline__ void unpack8(const u32x4& w, f32x4& a, f32x4& b) {
        a = (f32x4){__uint_as_float(w.x << 16), __uint_as_float(w.x & 0xffff0000u), __uint_as_float(w.y << 16), __uint_as_float(w.y & 0xffff0000u)};
        b = (f32x4){__uint_as_float(w.z << 16), __uint_as_float(w.z & 0xffff0000u), __uint_as_float(w.w << 16), __uint_as_float(w.w & 0xffff0000u)}; }
    __device__ __forceinline__ void mid(f32x4 (&acc)[2][2][4][2], const Unit& u, int wr, int wc, int fr, int fq) const {
        int lo = (u.pm * BM + wr * 64 + fr) * DM + u.pn * BM + (WIDE ? wc * 64 + 16 * fq : wc * 32 + 8 * fq);
        constexpr int BJS = WIDE ? 8 : HALF;
        asm volatile("" : "+v"(lo));
#pragma unroll
        for (int ai = 0; ai < 2; ++ai)
#pragma unroll
            for (int m = 0; m < 4; ++m) {
                const size_t off = (size_t)(unsigned)(lo + (ai * HALF + m * 16) * DM);
#pragma unroll
                for (int bj = 0; bj < 2; ++bj) {
                    const u32x4 gaw = *(const u32x4*)(GA + off + bj * BJS), gcw = *(const u32x4*)(GC + off + bj * BJS);
                    f32x4 a0, a1, c0, c1; unpack8(gaw, a0, a1); unpack8(gcw, c0, c1);
#pragma unroll
                    for (int j = 0; j < 4; ++j) { acc[ai][bj][m][0][j] *= a0[j] * __builtin_amdgcn_rcpf(c0[j]); acc[ai][bj][m][1][j] *= a1[j] * __builtin_amdgcn_rcpf(c1[j]); }
                }
                if ((m & MID_BATCH_MASK) == MID_BATCH_MASK) { asm volatile("" ::: "memory"); __builtin_amdgcn_sched_barrier(0); }
            }
    }
    __device__ __forceinline__ void operator()(const f32x4 (&acc)[2][2][4][2], const Unit& u, int wr, int wc, int fr, int fq) const {
        int lo = (u.pm * BM + wr * 64 + fr) * DM + u.pn * BM + (WIDE ? wc * 64 + 16 * fq : wc * 32 + 8 * fq);
        constexpr int BJS = WIDE ? 8 : HALF;
        asm volatile("" : "+v"(lo));
        const __amdgpu_buffer_rsrc_t rs = mkrsrc(MIXB);
#if MIX_PRELOAD16 == 2
#pragma unroll
        for (int ai = 0; ai < 2; ++ai)
#pragma unroll
            for (int mp = 0; mp < 2; ++mp) {
                u32x4 gw[2][2];
#pragma unroll
                for (int mm = 0; mm < 2; ++mm)
#pragma unroll
                    for (int bj = 0; bj < 2; ++bj) gw[mm][bj] = *(const u32x4*)(GC + (size_t)(unsigned)(lo + (ai * HALF + (2 * mp + mm) * 16) * DM) + bj * HALF);
#pragma unroll
                for (int mm = 0; mm < 2; ++mm) {
                    const int m = 2 * mp + mm;
                    const size_t off = (size_t)(unsigned)(lo + (ai * HALF + m * 16) * DM);
#pragma unroll
                    for (int bj = 0; bj < 2; ++bj) {
                        f32x4 c0, c1; unpack8(gw[mm][bj], c0, c1);
                        ST16(rs, (off + bj * HALF) * 2, pack8(acc[ai][bj][m][0] * c0, acc[ai][bj][m][1] * c1));
                    }
                }
            }
#elif MIX_PRELOAD16
        u32x4 gw[2][4][2];
#pragma unroll
        for (int ai = 0; ai < 2; ++ai)
#pragma unroll
            for (int m = 0; m < 4; ++m)
#pragma unroll
                for (int bj = 0; bj < 2; ++bj) gw[ai][m][bj] = *(const u32x4*)(GC + (size_t)(unsigned)(lo + (ai * HALF + m * 16) * DM) + bj * HALF);
#pragma unroll
        for (int ai = 0; ai < 2; ++ai)
#pragma unroll
            for (int m = 0; m < 4; ++m) {
                const size_t off = (size_t)(unsigned)(lo + (ai * HALF + m * 16) * DM);
#pragma unroll
                for (int bj = 0; bj < 2; ++bj) {
                    f32x4 c0, c1; unpack8(gw[ai][m][bj], c0, c1);
                    ST16(rs, (off + bj * HALF) * 2, pack8(acc[ai][bj][m][0] * c0, acc[ai][bj][m][1] * c1));
                }
            }
#else
#pragma unroll
        for (int ai = 0; ai < 2; ++ai) {
            u32x4 gw[4][2];
#pragma unroll
            for (int m = 0; m < 4; ++m)
#pragma unroll
                for (int bj = 0; bj < 2; ++bj) { if (VAR == 1 || VAR >= 3) gw[m][bj] = (u32x4){0x3f003f00u, 0x3f003f00u, 0x3f003f00u, 0x3f003f00u}; else gw[m][bj] = *(const u32x4*)(GC + (size_t)(unsigned)(lo + (ai * HALF + m * 16) * DM) + bj * BJS); }
            float sink_ = 0.f;
#pragma unroll
            for (int m = 0; m < 4; ++m) {
                const size_t off = (size_t)(unsigned)(lo + (ai * HALF + m * 16) * DM); u32x4 pw[2];
#pragma unroll
                for (int bj = 0; bj < 2; ++bj) {
                    f32x4 c0, c1; unpack8(gw[m][bj], c0, c1);
                    if (VAR == 2) sink_ += sum4(acc[ai][bj][m][0] * c0) + sum4(acc[ai][bj][m][1] * c1);
                    else if (VAR == 5) __builtin_amdgcn_raw_buffer_store_b128(pack8(acc[ai][bj][m][0] * c0, acc[ai][bj][m][1] * c1), rs, (unsigned)((off + bj * HALF) * 2), 0, 2);
                    else if (VAR == 6) __builtin_amdgcn_raw_buffer_store_b128(pack8(acc[ai][bj][m][0] * c0, acc[ai][bj][m][1] * c1), rs, (unsigned)((off + bj * HALF) * 2), 0, 0);
                    else if (VAR == 7) __builtin_amdgcn_raw_buffer_store_b128(pack8(acc[ai][bj][m][0] * c0, acc[ai][bj][m][1] * c1), rs, (unsigned)((off + bj * HALF) * 2), 0, 17);
                    else if (VAR == 9) { if (ai == 0) { const size_t rowb = (size_t)(u.pm * BM + wr * 64 + m * 16 + (fr & 7) + 8 * bj) * (DM * 2) + u.pn * 512;
                        ST16(rs, rowb + wc * 128 + fq * 32 + (fr >> 3) * 16, pack8(acc[ai][bj][m][0] * c0, acc[ai][bj][m][1] * c1)); } else sink_ += sum4(acc[ai][bj][m][0] * c0) + sum4(acc[ai][bj][m][1] * c1); }
                    else if (VAR == 10) { const size_t rowb = (size_t)((u.pm & 1) * BM + ai * HALF + wr * 64 + m * 16 + (fr & 7) + 8 * bj) * (DM * 2) + u.pn * 512;
                        ST16(rs, rowb + wc * 128 + fq * 32 + (fr >> 3) * 16, pack8(acc[ai][bj][m][0] * c0, acc[ai][bj][m][1] * c1)); }
                    else if (VAR == 8) { const size_t rowb = (size_t)(u.pm * BM + ai * HALF + wr * 64 + m * 16 + (fr & 7) + 8 * bj) * (DM * 2 + 128) + u.pn * 512;
                        ST16(rs, rowb + wc * 128 + fq * 32 + (fr >> 3) * 16, pack8(acc[ai][bj][m][0] * c0, acc[ai][bj][m][1] * c1)); }
                    else if (VAR == 3) { const size_t rowb = (size_t)(u.pm * BM + ai * HALF + wr * 64 + m * 16 + fr) * (DM * 2) + u.pn * 512;
                        ST16(rs, rowb + wc * 128 + fq * 32 + bj * 16, pack8(acc[ai][bj][m][0] * c0, acc[ai][bj][m][1] * c1)); }
                    else if (VAR == 4) { const size_t rowb = (size_t)(u.pm * BM + ai * HALF + wr * 64 + m * 16 + (fr & 7) + 8 * bj) * (DM * 2) + u.pn * 512;
                        ST16(rs, rowb + wc * 128 + fq * 32 + (fr >> 3) * 16, pack8(acc[ai][bj][m][0] * c0, acc[ai][bj][m][1] * c1)); }
                    else if (WIDE) pw[bj] = pack8(acc[ai][bj][m][0] * c0, acc[ai][bj][m][1] * c1);
                    else ST16(rs, (off + bj * HALF) * 2, pack8(acc[ai][bj][m][0] * c0, acc[ai][bj][m][1] * c1));
                }
                if (WIDE && VAR == 0) st_wide<MIX_WT>(rs, off - (size_t)fr * DM, fr, pw[0], pw[1]);
            }
            if ((VAR == 2 || VAR == 9) && sink_ == 1.2345e38f) ST16(rs, 0, gw[0][0]);
        }
#endif
    }
};
using EpiMix = EpiMixT<8>;
struct EpiNull {
    static constexpr bool PERM = true, AFTER_DRAIN = false, WIDE = false; static constexpr int MID_T = 0, PF_T = 0;
    float* sink;
    __device__ __forceinline__ void operator()(const f32x4 (&acc)[2][2][4][2], const Unit& u, int wr, int wc, int fr, int fq) const {
        float s = 0.f;
#pragma unroll
        for (int ai = 0; ai < 2; ++ai)
#pragma unroll
            for (int bj = 0; bj < 2; ++bj)
#pragma unroll
                for (int m = 0; m < 4; ++m)
#pragma unroll
                    for (int n = 0; n < 2; ++n) s += sum4(acc[ai][bj][m][n]);
        if (s == 1.2345e38f) sink[0] = s;
    }
};
constexpr int PF_DUMMY_OFF = 155648;
struct NoPost { __device__ __forceinline__ void operator()() const {} };
template <class Epi, class Sched, bool ALIGN_EPI = false, bool SP2 = false, class Post = NoPost, int AUX_A = 0>
__device__ __forceinline__ void gemm_phase(PG8_LAS unsigned char* lds, const Gemm g, const Sched& S, const Epi& E, const Post& post = Post()) {
    const int tid = threadIdx.x, wid = __builtin_amdgcn_readfirstlane(tid >> 6), lane = tid & 63, wr = wid >> 2, wc = wid & 3, fr = lane & 15, fq = lane >> 4;
    const int K = g.K, nt = K / BK;
    unsigned voffA[2], voffB[2];
#pragma unroll
    for (int i = 0; i < 2; ++i) { int R, C; stage_rc(tid * 16 + i * 8192, R, C); const int x32 = perm32(R & 31); const int Rb = Epi::PERM ? (Epi::WIDE ? (64 * (R >> 5) + 16 * (x32 >> 3) + (x32 & 7)) : ((R & ~31) + x32)) : R;
        voffA[i] = (unsigned)(R * K + C) * 2u; voffB[i] = (unsigned)(Rb * K + C) * 2u; }
    const size_t kstep = (size_t)(BK * 2);
    const size_t hstep = (size_t)HALF * K * 2;
    const size_t hstepB = Epi::WIDE ? (size_t)8 * K * 2 : hstep;
    const size_t tstep = 2 * hstep;
    const unsigned ldsw = (unsigned)wid * 1024u;
    const int aoff = lds_byte(wr * 64 + fr, fq * 8), boff = lds_byte(wc * 32 + fr, fq * 8);
#define PG8_SA(b, h) (((b) * 2 + (h)) * HTB)
#define PG8_SB(b, h) ((4 + (b) * 2 + (h)) * HTB)
#define PG8_STAGE(bufoff, gbase, voff) do { _Pragma("unroll") for (int _i = 0; _i < 2; ++_i) { \
        if (AUX_A == 2 && (const void*)(voff) == (const void*)voffA) __builtin_amdgcn_global_load_lds((const unsigned*)((const char*)(gbase) + (voff)[_i]), (PG8_LAS unsigned*)(lds + (bufoff) + ldsw + _i * 8192), 16, 0, 2); \
        else __builtin_amdgcn_global_load_lds((const unsigned*)((const char*)(gbase) + (voff)[_i]), (PG8_LAS unsigned*)(lds + (bufoff) + ldsw + _i * 8192), 16, 0, 0); } } while (0)
#define PG8_LDA(dst, b, h) do { _Pragma("unroll") for (int m = 0; m < 4; ++m) _Pragma("unroll") for (int k = 0; k < 2; ++k) dst[m][k] = *(const PG8_LAS bf16x8*)(lds + PG8_SA(b, h) + aoff + m * 2048 + k * 1024); } while (0)
#define PG8_LDB(dst, b, h) do { _Pragma("unroll") for (int n = 0; n < 2; ++n) _Pragma("unroll") for (int k = 0; k < 2; ++k) dst[n][k] = *(const PG8_LAS bf16x8*)(lds + PG8_SB(b, h) + boff + n * 2048 + k * 1024); } while (0)
#define PG8_MMA(ai, bj, At, Bt) do { __builtin_amdgcn_s_setprio(1); _Pragma("unroll") for (int m = 0; m < 4; ++m) _Pragma("unroll") for (int n = 0; n < 2; ++n) _Pragma("unroll") for (int k = 0; k < 2; ++k) \
        acc[ai][bj][m][n] = __builtin_amdgcn_mfma_f32_16x16x32_bf16(Bt[n][k], At[m][k], acc[ai][bj][m][n], 0, 0, 0); __builtin_amdgcn_s_setprio(0); } while (0)
#define PG8_WAIT_V(n) asm volatile("s_waitcnt vmcnt(" #n ")" ::: "memory")
#define PG8_WAIT_L(n) asm volatile("s_waitcnt lgkmcnt(" #n ")" ::: "memory")
#define PG8_BAR __builtin_amdgcn_s_barrier()
#define PG8_SCHED __builtin_amdgcn_sched_barrier(0)
    Unit cur, nxt; int ui = 0;
    if (!S.next(0, cur)) return;
    f32x4 acc[2][2][4][2];
#pragma unroll
    for (int a = 0; a < 2; ++a)
#pragma unroll
        for (int b = 0; b < 2; ++b)
#pragma unroll
            for (int m = 0; m < 4; ++m)
#pragma unroll
                for (int n = 0; n < 2; ++n) acc[a][b][m][n] = (f32x4){0.f, 0.f, 0.f, 0.f};
    bf16x8 At[4][2], B0[2][2], B1[2][2];
    const char* cA = (const char*)g.A + (size_t)cur.pm * tstep; const char* cB = (const char*)g.Bt + (size_t)cur.pn * tstep;
    S.a_ready(cur);
    if constexpr (SP2) {
        PG8_STAGE(PG8_SB(0, 0), cB, voffB); PG8_STAGE(PG8_SB(0, 1), cB + hstepB, voffB); PG8_STAGE(PG8_SA(0, 0), cA, voffA); PG8_STAGE(PG8_SA(0, 1), cA + hstep, voffA);
        if (wr == 1) PG8_BAR;
        PG8_WAIT_V(2); PG8_BAR;
        PG8_STAGE(PG8_SB(1, 0), cB + kstep, voffB); PG8_STAGE(PG8_SA(1, 0), cA + kstep, voffA); PG8_STAGE(PG8_SB(1, 1), cB + hstepB + kstep, voffB);
        PG8_WAIT_V(6); PG8_BAR;
    } else {
        PG8_STAGE(PG8_SB(0, 0), cB, voffB); PG8_STAGE(PG8_SA(0, 0), cA, voffA); PG8_STAGE(PG8_SB(0, 1), cB + hstepB, voffB); PG8_STAGE(PG8_SA(0, 1), cA + hstep, voffA);
        if (wr == 1) PG8_BAR;
        PG8_WAIT_V(4); PG8_BAR;
        PG8_STAGE(PG8_SB(1, 0), cB + kstep, voffB); PG8_STAGE(PG8_SA(1, 0), cA + kstep, voffA); PG8_STAGE(PG8_SB(1, 1), cB + hstepB + kstep, voffB);
        PG8_WAIT_V(6); PG8_BAR;
    }
    for (;;) {
        const bool has_next = S.next(ui + 1, nxt);
        const char* nA = has_next ? (const char*)g.A + (size_t)nxt.pm * tstep : cA; const char* nB = has_next ? (const char*)g.Bt + (size_t)nxt.pn * tstep : cB;
        for (int t = 0; t < nt; t += 2) {
            if constexpr (Epi::PF_T > 0) { if (t == (nt > Epi::PF_T ? nt - Epi::PF_T : 0)) E.prefetch(cur, wid, lane, lds + PF_DUMMY_OFF); }
            if constexpr (Epi::MID_T > 0) { if (t == Epi::MID_T) E.mid(acc, cur, wr, wc, fr, fq); }
            const bool last = (t == nt - 2);
            const char* a1 = cA + (size_t)(t + 1) * kstep;
            const char* a2 = last ? nA : cA + (size_t)(t + 2) * kstep; const char* b2 = last ? nB : cB + (size_t)(t + 2) * kstep;
            const char* a3 = a2 + kstep; const char* b3 = b2 + kstep;
            if (last && has_next) S.a_ready(nxt);
            if constexpr (SP2) {
            PG8_LDB(B0, 0, 0); PG8_LDB(B1, 0, 1); PG8_SCHED; PG8_LDA(At, 0, 0); PG8_STAGE(PG8_SA(1, 1), a1 + hstep, voffA);
            PG8_WAIT_V(8); PG8_WAIT_L(0); PG8_BAR; PG8_MMA(0, 0, At, B0); PG8_MMA(0, 1, At, B1); PG8_BAR; PG8_SCHED;
            PG8_LDA(At, 0, 1); PG8_STAGE(PG8_SB(0, 0), b2, voffB); PG8_STAGE(PG8_SB(0, 1), b2 + hstepB, voffB); PG8_STAGE(PG8_SA(0, 0), a2, voffA);
            PG8_WAIT_V(8); PG8_WAIT_L(0); PG8_BAR; PG8_MMA(1, 0, At, B0); PG8_MMA(1, 1, At, B1); PG8_BAR; PG8_SCHED;
            PG8_LDB(B0, 1, 0); PG8_LDB(B1, 1, 1); PG8_SCHED; PG8_LDA(At, 1, 0); PG8_STAGE(PG8_SA(0, 1), a2 + hstep, voffA);
            PG8_WAIT_V(8); PG8_WAIT_L(0); PG8_BAR; PG8_MMA(0, 0, At, B0); PG8_MMA(0, 1, At, B1); PG8_BAR; PG8_SCHED;
            PG8_LDA(At, 1, 1); PG8_STAGE(PG8_SB(1, 0), b3, voffB); PG8_STAGE(PG8_SB(1, 1), b3 + hstepB, voffB); PG8_STAGE(PG8_SA(1, 0), a3, voffA);
            PG8_WAIT_V(8); PG8_WAIT_L(0); PG8_BAR; PG8_MMA(1, 0, At, B0); PG8_MMA(1, 1, At, B1); PG8_BAR; PG8_SCHED;
            } else {
            PG8_LDB(B0, 0, 0); PG8_SCHED; PG8_LDA(At, 0, 0); PG8_STAGE(PG8_SA(1, 1), a1 + hstep, voffA);
            PG8_WAIT_L(8); PG8_BAR; PG8_WAIT_L(0); PG8_MMA(0, 0, At, B0); PG8_BAR; PG8_SCHED;
            PG8_LDB(B1, 0, 1); PG8_STAGE(PG8_SB(0, 0), b2, voffB);
            PG8_BAR; PG8_WAIT_L(0); PG8_MMA(0, 1, At, B1); PG8_BAR;
            PG8_LDA(At, 0, 1); PG8_STAGE(PG8_SA(0, 0), a2, voffA);
            PG8_BAR; PG8_WAIT_L(0); PG8_MMA(1, 0, At, B0); PG8_BAR; PG8_SCHED;
            PG8_STAGE(PG8_SB(0, 1), b2 + hstepB, voffB);
            PG8_WAIT_V(6); PG8_BAR; PG8_MMA(1, 1, At, B1); PG8_BAR;
            PG8_LDB(B0, 1, 0); PG8_SCHED; PG8_LDA(At, 1, 0); PG8_STAGE(PG8_SA(0, 1), a2 + hstep, voffA);
            PG8_WAIT_L(8); PG8_BAR; PG8_WAIT_L(0); PG8_MMA(0, 0, At, B0); PG8_BAR; PG8_SCHED;
            PG8_LDB(B1, 1, 1); PG8_STAGE(PG8_SB(1, 0), b3, voffB);
            PG8_BAR; PG8_WAIT_L(0); PG8_MMA(0, 1, At, B1); PG8_BAR;
            PG8_LDA(At, 1, 1); PG8_STAGE(PG8_SA(1, 0), a3, voffA);
            PG8_BAR; PG8_WAIT_L(0); PG8_MMA(1, 0, At, B0); PG8_BAR; PG8_SCHED;
            PG8_STAGE(PG8_SB(1, 1), b3 + hstepB, voffB);
            PG8_WAIT_V(6); PG8_BAR; PG8_MMA(1, 1, At, B1); PG8_BAR;
            }
        }
        if constexpr (ALIGN_EPI) { if (wr == 0) PG8_BAR; }
        if constexpr (!Epi::AFTER_DRAIN) { E(acc, cur, wr, wc, fr, fq); S.done(cur); }
        if (!has_next) break;
#pragma unroll
        for (int a = 0; a < 2; ++a)
#pragma unroll
            for (int b = 0; b < 2; ++b)
#pragma unroll
                for (int m = 0; m < 4; ++m)
#pragma unroll
                    for (int n = 0; n < 2; ++n) acc[a][b][m][n] = (f32x4){0.f, 0.f, 0.f, 0.f};
        cur = nxt; cA = nA; cB = nB; ++ui;
        if constexpr (ALIGN_EPI) { if (wr == 1) PG8_BAR; }
    }
    if constexpr (ALIGN_EPI) post();
    PG8_WAIT_V(0);
    if constexpr (!ALIGN_EPI) { if (wr == 0) PG8_BAR; }
    PG8_BAR;
    if constexpr (Epi::AFTER_DRAIN) { E.fused(acc, cur, wr, wc, fr, fq, lds, wid, lane); S.done(cur); }
#undef PG8_SA
#undef PG8_SB
#undef PG8_STAGE
#undef PG8_LDA
#undef PG8_LDB
#undef PG8_MMA
#undef PG8_WAIT_V
#undef PG8_WAIT_L
#undef PG8_BAR
#undef PG8_SCHED
}
}
#define XB_TMO      128
#define XB_XCNT(j)  (256  + 64 * (j))
#define XB_XSUB(j)  (1280 + 64 * (j))
#define XB_XGEN(j)  (2304 + 64 * (j))
#define XB_TOP      3328
#define XB_TOPGEN   3392
#define XB_SEAM(k)  (3456 + 64 * (k))
#define XCD_BAR_WORDS 3968
#define XB_SPIN_CAP (1u << 18)

__device__ __forceinline__ unsigned xb_ld(unsigned* p)              { return __hip_atomic_load(p, __ATOMIC_RELAXED, __HIP_MEMORY_SCOPE_AGENT); }
__device__ __forceinline__ unsigned xb_add(unsigned* p, unsigned v) { return __hip_atomic_fetch_add(p, v, __ATOMIC_RELAXED, __HIP_MEMORY_SCOPE_AGENT); }
__device__ __forceinline__ unsigned xb_xcc_id() { return (unsigned)__builtin_amdgcn_s_getreg((3 << 11) | 20) & 0xFu; }
#define XB_SPIN(cond, bar) do { unsigned _sp = 0; while (cond) { __builtin_amdgcn_s_sleep(1); \
    if ((++_sp & 255u) == 0u) { if (xb_ld(&(bar)[XB_TMO])) break; if (_sp > XB_SPIN_CAP) { atomicAdd(&(bar)[XB_TMO], 1u); break; } } } } while (0)

struct XcdBarrier {
    unsigned* bar; unsigned x;
    volatile LAS unsigned* st;
};

__device__ __forceinline__ XcdBarrier xcd_barrier_post(unsigned* bar, volatile LAS unsigned* st) {
    XcdBarrier b; b.bar = bar; b.x = xb_xcc_id(); b.st = st;
    if (threadIdx.x == 0) st[2] = xb_add(&bar[XB_XCNT(b.x)], 1u);
    return b;
}
__device__ __forceinline__ void xcd_barrier_complete(unsigned* bar, unsigned x, unsigned& nloc, unsigned& nx) {
    const unsigned G = gridDim.x * gridDim.y * gridDim.z;
    unsigned sum, cnt, mine, sp = 0u;
    for (;;) {
        sum = 0u; cnt = 0u; mine = 0u;
#pragma unroll
        for (unsigned j = 0; j < 16; ++j) { const unsigned c = xb_ld(&bar[XB_XCNT(j)]); sum += c; cnt += (c > 0u) ? 1u : 0u; mine = (j == x) ? c : mine; }
        if (sum == G) break;
        __builtin_amdgcn_s_sleep(1);
        if ((++sp & 255u) == 0u) { if (xb_ld(&bar[XB_TMO])) break; if (sp > XB_SPIN_CAP) { atomicAdd(&bar[XB_TMO], 1u); break; } }
    }
    nloc = mine > 0u ? mine : 1u; nx = cnt > 0u ? cnt : 1u;
}

__device__ __forceinline__ void xcd_barrier(const XcdBarrier& b) {
    asm volatile("s_waitcnt vmcnt(0)" ::: "memory");
    __syncthreads();
    if (threadIdx.x == 0) {
        unsigned* bar = b.bar;
        __builtin_amdgcn_s_waitcnt(0);
        unsigned nloc = b.st[0], nx = b.st[1];
        if (nloc == 0u) { xcd_barrier_complete(bar, b.x, nloc, nx); b.st[0] = nloc; b.st[1] = nx; }
        const unsigned old = xb_add(&bar[XB_XSUB(b.x)], 1u);
        const unsigned gen = old / nloc;
        if (old + 1u == (gen + 1u) * nloc) {
            __builtin_amdgcn_fence(__ATOMIC_RELEASE, "agent");
            asm volatile("s_waitcnt vmcnt(0)" ::: "memory");
            const unsigned og = xb_add(&bar[XB_TOP], 1u);
            const unsigned tg = og / nx;
            if (og + 1u == (tg + 1u) * nx) xb_add(&bar[XB_TOPGEN], 1u);
            else XB_SPIN(xb_ld(&bar[XB_TOPGEN]) == tg, bar);
            __builtin_amdgcn_fence(__ATOMIC_ACQUIRE, "agent");
            xb_add(&bar[XB_XGEN(b.x)], 1u);
            asm volatile("s_waitcnt vmcnt(0)" ::: "memory");
        } else {
            XB_SPIN(xb_ld(&bar[XB_XGEN(b.x)]) == gen, bar);
            __builtin_amdgcn_fence(__ATOMIC_ACQUIRE, "agent");
            asm volatile("s_waitcnt vmcnt(0)" ::: "memory");
        }
    }
    __syncthreads();
}

__device__ __forceinline__ void xcd_barrier_local(const XcdBarrier& b, int seam) {
    asm volatile("s_waitcnt vmcnt(0)" ::: "memory");
    __syncthreads();
    if (threadIdx.x == 0) {
        unsigned* bar = b.bar;
        __builtin_amdgcn_s_waitcnt(0);
        unsigned nloc = b.st[0], nx = b.st[1];
        if (nloc == 0u) { xcd_barrier_complete(bar, b.x, nloc, nx); b.st[0] = nloc; b.st[1] = nx; }
        const unsigned old = xb_add(&bar[XB_XSUB(b.x)], 1u);
        const unsigned gen = old / nloc;
        if (old + 1u == (gen + 1u) * nloc) { xb_add(&bar[XB_SEAM(seam)], 1u); xb_add(&bar[XB_XGEN(b.x)], 1u); }
        else XB_SPIN(xb_ld(&bar[XB_XGEN(b.x)]) == gen, bar);
        __builtin_amdgcn_fence(__ATOMIC_ACQUIRE, "agent");
        asm volatile("s_waitcnt vmcnt(0)" ::: "memory");
    }
    __syncthreads();
}
__device__ __forceinline__ void xcd_seam_wait(const XcdBarrier& b, int seam) {
    if (threadIdx.x == 0) {
        unsigned* bar = b.bar; const unsigned nx = b.st[1];
        XB_SPIN(xb_ld(&bar[XB_SEAM(seam)]) < nx, bar);
        __builtin_amdgcn_fence(__ATOMIC_ACQUIRE, "agent");
        asm volatile("s_waitcnt vmcnt(0)" ::: "memory");
    }
    __syncthreads();
}
__device__ __forceinline__ bool xcd_layout_ok(const XcdBarrier& b, unsigned G) {
    bool ok = (G % 8u) == 0u;
#pragma unroll
    for (unsigned j = 0; j < 16; ++j) { const unsigned c = xb_ld(&b.bar[XB_XCNT(j)]); ok = ok && (c == (j < 8u ? G / 8u : 0u)); }
    return ok;
}

struct Args {
    const float* in[27]; float* out; unsigned char* ws; int ph_lo, ph_hi;
};
struct Frame {
    LAS unsigned char* lds; volatile LAS unsigned* MISC; gu32* ctl;
    int tid, lane, wave, G;
};
__device__ __forceinline__ float wave_sum(float v) {
#pragma unroll
    for (int o = 1; o < 64; o <<= 1) v += __shfl_xor(v, o);
    return v;
}
__device__ __forceinline__ float wave_max(float v) {
#pragma unroll
    for (int o = 1; o < 64; o <<= 1) v = fmaxf(v, __shfl_xor(v, o));
    return v;
}

#ifndef MK_NT
#define MK_NT 1
#endif
#ifndef LOCAL_SEAMS
#define LOCAL_SEAMS 1
#endif
#ifndef AO_LINES
#define AO_LINES 1
#endif
#ifndef SMP_KB
#define SMP_KB 1
#endif
#ifndef SMP_NT
#define SMP_NT 0
#endif
#if SMP_NT
#define SMP_LOAD(p) NT_LOAD(p)
#else
#define SMP_LOAD(p) (*(p))
#endif
#ifndef SK_LINES
#define SK_LINES 1
#endif
#ifndef SIDE_BATCH
#define SIDE_BATCH 2
#endif
#ifndef P0_WT
#define P0_WT 1
#endif
#ifndef P4_WT
#define P4_WT 1
#endif
#ifndef XROWS
#define XROWS 2
#endif
#ifndef NT_ITEMS
#define NT_ITEMS 2
#endif
#if NT_ITEMS == 2
__device__ __forceinline__ void item_store_sc1(v4u v, GAS v4u* p) { asm volatile("global_store_dwordx4 %0, %1, off sc1\n\ts_nop 1" :: "v"(p), "v"(v) : "memory"); }
#define ITEM_STORE(v, p) item_store_sc1((v), (p))
#elif NT_ITEMS
#define ITEM_STORE(v, p) __builtin_nontemporal_store((v), (p))
#else
#define ITEM_STORE(v, p) (*(p) = (v))
#endif
#if MK_NT
#define NT_LOAD(p) __builtin_nontemporal_load(p)
#define NT_STORE(v, p) __builtin_nontemporal_store((v), (p))
#else
#define NT_LOAD(p) (*(p))
#define NT_STORE(v, p) (*(p) = (v))
#endif
__device__ __forceinline__ void p0_transpose_item(const float* W, int K, int N, const float* gain, bf16* WT, int k0, int n0, int dr, LAS float* scr, int lane) {
    const int lr = lane >> 3, lc = 4 * (lane & 7);
    f32x4 w[8];
#pragma unroll
    for (int i = 0; i < 8; ++i) w[i] = NT_LOAD((const GAS f32x4*)(W + (size_t)(k0 + 8 * i + lr) * N + n0 + lc));
    if (gain) {
#pragma unroll
        for (int i = 0; i < 8; ++i) w[i] = w[i] * gain[k0 + 8 * i + lr];
    }
#pragma unroll
    for (int i = 0; i < 8; ++i) { LAS float* d = scr + (8 * i + lr) * 33 + lc; d[0] = w[i].x; d[1] = w[i].y; d[2] = w[i].z; d[3] = w[i].w; }
    LDS_WAIT(); asm volatile("" ::: "memory");
    const int c = lane & 7;
#pragma unroll
    for (int j = 0; j < 4; ++j) { const int n = (lane >> 3) + 8 * j; const LAS float* s = scr + (8 * c) * 33 + n;
        v4u o; o.x = pk2(s[0 * 33], s[1 * 33]); o.y = pk2(s[2 * 33], s[3 * 33]); o.z = pk2(s[4 * 33], s[5 * 33]); o.w = pk2(s[6 * 33], s[7 * 33]);
        ITEM_STORE(o, (GAS v4u*)(WT + (size_t)(dr + n) * K + k0 + 8 * c)); }
    LDS_WAIT(); asm volatile("" ::: "memory");
}
__device__ __forceinline__ int win_dest_row(int n0) {
    if (n0 < 512) { const int head = n0 >> 6, d = n0 & 63; return 256 * (head >> 2) + 128 * (d >> 5) + 32 * (head & 3); }
    if (n0 < 640) { const int kvh = (n0 - 512) >> 6, d = n0 & 63; return 512 + 128 * (d >> 5) + 32 * kvh; }
    if (n0 < 768) { const int vh = (n0 - 640) >> 6, d = n0 & 63; return 512 + 128 * (d >> 5) + 32 * (2 + vh); }
    if (n0 < 1792) { const int which = (n0 - 768) >> 9, ch = (n0 - 768) & 511; return 256 * (3 + (ch >> 7)) + 128 * which + (ch & 127); }
    return n0;
}
__device__ __forceinline__ int ffn_dest_row(int j0, int which) { return 256 * (j0 >> 7) + 128 * which + (j0 & 127); }

constexpr int I_W1 = 32 * 44, I_W2 = 88 * 16, I_WIN = 32 * 60, I_AO = 16 * 16, I_WO = 32 * 16;
constexpr int P0_A0 = 0, P0_B0 = 2 * I_W1, P0_C0 = P0_B0 + I_W2 + I_WIN + 2 * I_AO + I_WO, P0_NITEMS = P0_C0 + 2 * I_W1 + I_W2;
#ifndef W2B_IN_P7
#define W2B_IN_P7 0
#endif
constexpr int P0_C_P7 = W2B_IN_P7 ? P0_C0 + 2 * I_W1 : P0_NITEMS;
#ifndef C_P3
#define C_P3 4224
#endif
constexpr int P0_C_P3 = C_P3;
__device__ __forceinline__ void p0_items(Frame& F, const Args& a, int lo, int hi, int rank, int nworkers) {
    unsigned char* ws = a.ws;
    LAS float* scr = (LAS float*)(F.lds + F.wave * 16384);
    for (int it = lo + rank * NWAVES + F.wave; it < hi; it += nworkers * NWAVES) {
        int r = it;
        if (r < P0_B0 || r >= P0_C0) {
            const bool f = r >= P0_C0; if (f) r -= P0_C0;
            const float* gain = a.in[f ? 23 : 6]; bf16* W13 = (bf16*)(ws + (f ? WS_W13B : WS_W13A)); bf16* W2 = (bf16*)(ws + (f ? WS_W2B : WS_W2A));
            if (r < I_W1) { const int kb = r / 88, nb = r % 88; p0_transpose_item(a.in[f ? 24 : 7], D, DFF, gain, W13, 64 * kb, 32 * nb, ffn_dest_row(32 * nb, 0), scr, F.lane); continue; } r -= I_W1;
            if (r < I_W1) { const int kb = r / 88, nb = r % 88; p0_transpose_item(a.in[f ? 25 : 8], D, DFF, gain, W13, 64 * kb, 32 * nb, ffn_dest_row(32 * nb, 1), scr, F.lane); continue; } r -= I_W1;
            { const int kb = r / 32, nb = r % 32; p0_transpose_item(a.in[26], DFF, D, nullptr, W2, 64 * kb, 32 * nb, 32 * nb, scr, F.lane); continue; }
        }
        r -= P0_B0;
        if (r < I_W2) { const int kb = r / 32, nb = r % 32; p0_transpose_item(a.in[9], DFF, D, nullptr, (bf16*)(ws + WS_W2A), 64 * kb, 32 * nb, 32 * nb, scr, F.lane); continue; } r -= I_W2;
        if (r < I_WIN) { const int kb = r / 120, nb = r % 120; p0_transpose_item(a.in[11], D, NIN, a.in[10], (bf16*)(ws + WS_WIN), 64 * kb, 32 * nb, win_dest_row(32 * nb), scr, F.lane); continue; } r -= I_WIN;
        if (r < I_AO) { const int kb = r / 32, nb = r % 32; p0_transpose_item(a.in[16], 1024, D, nullptr, (bf16*)(ws + WS_WMIX), 64 * kb, 32 * nb, 32 * nb, scr, F.lane); continue; } r -= I_AO;
        if (r < I_AO) { const int kb = r / 32, nb = r % 32; p0_transpose_item(a.in[21], 1024, D, nullptr, (bf16*)(ws + WS_WMIX) + 512, 64 * kb, 32 * nb, 32 * nb, scr, F.lane); continue; } r -= I_AO;
        { const int kb = r / 32, nb = r % 32; p0_transpose_item(a.in[22], D, D, nullptr, (bf16*)(ws + WS_WOUT), 64 * kb, 32 * nb, 32 * nb, scr, F.lane); }
    }
}
__device__ __forceinline__ void p0_copies(Frame& F, const Args& a, int rank, int nworkers) {
    const int gt = rank * (NWAVES * 64) + F.tid, NGT = nworkers * NWAVES * 64;
    for (int i = gt; i < 128 * 4064; i += NGT) { const int s = i / 4064, e = i % 4064;
        NT_STORE(NT_LOAD(((const GAS f32x4*)(a.in[2] + (size_t)s * 16384 + 128)) + e), ((GAS f32x4*)(a.out + O_NKS + (size_t)s * 16384)) + e);
        NT_STORE(NT_LOAD(((const GAS f32x4*)(a.in[3] + (size_t)s * 16384 + 128)) + e), ((GAS f32x4*)(a.out + O_NVS + (size_t)s * 16384)) + e); }
    for (int i = gt; i < 128 * 3712; i += NGT) { const int s = i / 3712, e = i % 3712;
        NT_STORE(NT_LOAD(((const GAS f32x4*)(a.in[4] + (size_t)s * 15360 + 512)) + e), ((GAS f32x4*)(a.out + O_NCS + (size_t)s * 15360)) + e); }
}
__device__ __forceinline__ void p0_prologue(Frame& F, const Args& a) {
    unsigned char* ws = a.ws;
#ifdef P0_ZERO_OUT
    { GAS f32x4* o = (GAS f32x4*)a.out; for (size_t i = (size_t)blockIdx.x * 512 + F.tid; i < (size_t)23164928 / 4; i += (size_t)F.G * 512) o[i] = (f32x4){0.f, 0.f, 0.f, 0.f}; }
#endif
    LAS float* scr = (LAS float*)(F.lds + F.wave * 16384);
    const int gw = blockIdx.x * NWAVES + F.wave, NGW = F.G * NWAVES;
    p0_items(F, a, P0_A0, P0_B0, blockIdx.x, F.G);
    p0_items(F, a, P0_C0 + P0_C_P3, P0_C_P7, blockIdx.x, F.G);
    bf16* XB = (bf16*)(ws + WS_R1); float* ss1 = (float*)(F.ctl + CW_SS1);
    for (int row0 = gw; row0 < MP; row0 += XROWS * NGW) {
        f32x4 v[XROWS][4];
#pragma unroll
        for (int q = 0; q < XROWS; ++q) { const int row = row0 + q * NGW; const int rr = row < R_END ? row : 0;
            const float* src = rr < NPROMPT ? a.in[0] + (size_t)rr * D : rr < R_SAMPLE ? a.in[5] + (size_t)(rr - R_META) * D : a.in[1] + (size_t)(rr - R_SAMPLE) * D;
#pragma unroll
            for (int j = 0; j < 4; ++j) v[q][j] = NT_LOAD(((const GAS f32x4*)src) + F.lane + 64 * j); }
#pragma unroll
        for (int q = 0; q < XROWS; ++q) { const int row = row0 + q * NGW;
            if (row < MP) {
                float s = 0.f;
#pragma unroll
                for (int j = 0; j < 4; ++j) { if (row >= R_END) v[q][j] = (f32x4){0.f, 0.f, 0.f, 0.f}; s += (v[q][j].x * v[q][j].x + v[q][j].y * v[q][j].y) + (v[q][j].z * v[q][j].z + v[q][j].w * v[q][j].w); }
                s = wave_sum(s);
                GAS unsigned long long* o8 = (GAS unsigned long long*)(XB + (size_t)row * D) + F.lane;
#pragma unroll
                for (int j = 0; j < 4; ++j) {
#if P0_WT
                    v2u w2; w2.x = pk2(v[q][j].x, v[q][j].y); w2.y = pk2(v[q][j].z, v[q][j].w);
                    __builtin_amdgcn_raw_buffer_store_b64(w2, pg8::mkrsrc(ws), (unsigned)(WS_R1 + (size_t)row * (D * 2) + F.lane * 8 + 512 * j), 0, 16);
#else
                    o8[64 * j] = (unsigned long long)pk2(v[q][j].x, v[q][j].y) | ((unsigned long long)pk2(v[q][j].z, v[q][j].w) << 32);
#endif
                }
                if (F.lane == 0) ss1[row] = s;
            } }
    }
}

constexpr int VT_STRIDE = 260;
constexpr int KS_STRIDE = 72;
constexpr int L4_OT = 73728;
constexpr int L4_VT = 0, L4_KS = 33792, L4_TAB = 131072, L4_Y = 0, L4_SMP = 137216, L4_WIN = 65536;
__device__ __forceinline__ int crow(int r, int hi) { return (r & 3) + 8 * (r >> 2) + 4 * hi; }
__device__ __forceinline__ int t5_bucket(int d) {
    if (d < 16) return d;
    int b = 16;
    b += (d >= 19); b += (d >= 21); b += (d >= 24); b += (d >= 27); b += (d >= 31); b += (d >= 35); b += (d >= 40); b += (d >= 46);
    b += (d >= 52); b += (d >= 59); b += (d >= 67); b += (d >= 77); b += (d >= 87); b += (d >= 99); b += (d >= 113);
    return b;
}
__device__ __forceinline__ int tok_row(int b, int t) { return t >= 0 ? b * SEQ + t : (t >= -16 ? R_META + 16 + t : -1); }

__device__ __forceinline__ void attn_unit(Frame& F, const Args& a, int b, int kvh, int jb) {
    const bf16* Qb = (const bf16*)(a.ws + WS_QB); const bf16* Kb = (const bf16*)(a.ws + WS_KB); const bf16* Vb = (const bf16*)(a.ws + WS_VB);
    bf16* AO = (bf16*)(a.ws + WS_R1);
    LAS bf16* Vt = (LAS bf16*)(F.lds + L4_VT); LAS bf16* Ks = (LAS bf16*)(F.lds + L4_KS); const LAS float* tab = (const LAS float*)(F.lds + L4_TAB);
    const int tid = F.tid, lane = F.lane, wid = F.wave, ql = lane & 31, hi = lane >> 5;
    const int tk0 = 128 * jb - 128;
    bf16x8 qfa[2][4];
    { const int hq_ = wid & 3, qh_ = wid >> 2;
#pragma unroll
      for (int qs = 0; qs < 2; ++qs)
#pragma unroll
        for (int s = 0; s < 4; ++s) qfa[qs][s] = *(const GAS bf16x8*)(Qb + ((size_t)b * SEQ + 128 * jb + 64 * qh_ + 32 * qs + ql) * 512 + (kvh * 4 + hq_) * 64 + 16 * s + 8 * hi); }
    for (int c = tid; c < 2048; c += NWAVES * 64) {
        const int kk = c >> 3, ch = c & 7; const int row = tok_row(b, tk0 + kk);
        const int rr = row >= 0 ? row : 0;
        v4u w = *(const GAS v4u*)(Vb + (size_t)rr * 128 + kvh * 64 + ch * 8), kw = *(const GAS v4u*)(Kb + (size_t)rr * 128 + kvh * 64 + ch * 8);
        if (row < 0) { w = (v4u){0u, 0u, 0u, 0u}; kw = w; }
        *(LAS v4u*)(Ks + kk * KS_STRIDE + ch * 8) = kw;
#pragma unroll
        for (int i = 0; i < 8; ++i) { const unsigned dw = w[i >> 1]; Vt[(ch * 8 + i) * VT_STRIDE + kk] = (bf16)((i & 1) ? (dw >> 16) : (dw & 0xffffu)); }
    }
    __syncthreads();
    const int hq = wid & 3, qh = wid >> 2, head = kvh * 4 + hq;
    const float sink = a.in[15][head];
#pragma unroll
    for (int qs = 0; qs < 2; ++qs) {
        const int tq = 128 * jb + 64 * qh + 32 * qs;
        const size_t rowq = (size_t)b * SEQ + tq + ql;
        bf16x8 qf[4];
#pragma unroll
        for (int s = 0; s < 4; ++s) qf[s] = qfa[qs][s];
        f32x16 S[5];
        float mx = -1e30f;
        const LAS float* tabq = tab + head * 192 + 1 + ql - 4 * hi;
#pragma unroll
        for (int kt = 0; kt < 5; ++kt) {
            const LAS bf16* kp = Ks + ((tq - 128 + 32 * kt) - tk0 + ql) * KS_STRIDE + 8 * hi;
            f32x16 acc = (f32x16){0.f, 0.f, 0.f, 0.f, 0.f, 0.f, 0.f, 0.f, 0.f, 0.f, 0.f, 0.f, 0.f, 0.f, 0.f, 0.f};
#pragma unroll
            for (int s = 0; s < 4; ++s) {
                const bf16x8 kf = *(const LAS bf16x8*)(kp + 16 * s);
                acc = __builtin_amdgcn_mfma_f32_32x32x16_bf16(kf, qf[s], acc, 0, 0, 0);
            }
            const int kb0 = tq - 128 + 32 * kt; const float pen_lo = kb0 >= -16 ? 0.f : -1e30f, pen_hi = kb0 + 16 >= -16 ? 0.f : -1e30f;
#pragma unroll
            for (int r = 0; r < 16; ++r) {
                const float x = acc[r] + tabq[159 - (32 * kt + (r & 3) + 8 * (r >> 2))] + (r < 8 ? pen_lo : pen_hi);
                acc[r] = x; mx = fmaxf(mx, x);
            }
            S[kt] = acc;
            asm volatile("" ::: "memory"); __builtin_amdgcn_sched_barrier(0);
        }
        mx = fmaxf(mx, __shfl_xor(mx, 32)); mx = fmaxf(mx, sink);
        float sum = 0.f;
#pragma unroll
        for (int kt = 0; kt < 5; ++kt)
#pragma unroll
            for (int r = 0; r < 16; ++r) { const float p = __builtin_amdgcn_exp2f((S[kt][r] - mx) * pg8::LOG2E); S[kt][r] = p; sum += p; }
        sum += __shfl_xor(sum, 32); sum += __builtin_amdgcn_exp2f((sink - mx) * pg8::LOG2E);
        const float inv = 1.0f / sum;
        f32x16 OT[2];
        OT[0] = (f32x16){0.f, 0.f, 0.f, 0.f, 0.f, 0.f, 0.f, 0.f, 0.f, 0.f, 0.f, 0.f, 0.f, 0.f, 0.f, 0.f}; OT[1] = OT[0];
#pragma unroll
        for (int kt = 0; kt < 5; ++kt)
#pragma unroll
            for (int s = 0; s < 2; ++s) {
                v4u pw; pw.x = pg8::cvt_pk_bf16(S[kt][8 * s + 0], S[kt][8 * s + 1]); pw.y = pg8::cvt_pk_bf16(S[kt][8 * s + 2], S[kt][8 * s + 3]);
                pw.z = pg8::cvt_pk_bf16(S[kt][8 * s + 4], S[kt][8 * s + 5]); pw.w = pg8::cvt_pk_bf16(S[kt][8 * s + 6], S[kt][8 * s + 7]);
                const bf16x8 pf = __builtin_bit_cast(bf16x8, pw);
                const int kk0 = (tq - 128 + 32 * kt) - tk0 + 16 * s + 4 * hi;
#pragma unroll
                for (int dt = 0; dt < 2; ++dt) {
                    const LAS bf16* vp = Vt + (32 * dt + ql) * VT_STRIDE + kk0;
                    const v2u lo = *(const LAS v2u*)vp, hh = *(const LAS v2u*)(vp + 8);
                    const v4u vw = (v4u){lo.x, lo.y, hh.x, hh.y};
                    OT[dt] = __builtin_amdgcn_mfma_f32_32x32x16_bf16(__builtin_bit_cast(bf16x8, vw), pf, OT[dt], 0, 0, 0);
                }
                asm volatile("" ::: "memory"); __builtin_amdgcn_sched_barrier(0);
            }
#if AO_LINES
        { LAS bf16* ot = (LAS bf16*)(F.lds + L4_OT + wid * 4608);
#pragma unroll
          for (int dt = 0; dt < 2; ++dt)
#pragma unroll
            for (int g = 0; g < 4; ++g) { v2u w; w.x = pk2(OT[dt][4 * g] * inv, OT[dt][4 * g + 1] * inv); w.y = pk2(OT[dt][4 * g + 2] * inv, OT[dt][4 * g + 3] * inv);
                *(LAS v2u*)(ot + ql * 72 + 32 * dt + 8 * g + 4 * hi) = w; }
          LDS_WAIT();
#pragma unroll
          for (int i = 0; i < 4; ++i) { const int r = (lane >> 3) + 8 * i, c8 = lane & 7;
              const v4u v = *(const LAS v4u*)(ot + r * 72 + 8 * c8);
              __builtin_amdgcn_raw_buffer_store_b128(v, pg8::mkrsrc(a.ws), (unsigned)(WS_R1 + (((size_t)b * SEQ + tq + r) * 1024 + head * 64 + 8 * c8) * 2), 0, 16); }
          LDS_WAIT(); }
#else
        bf16* orow = AO + rowq * 1024 + head * 64;
#pragma unroll
        for (int dt = 0; dt < 2; ++dt)
#pragma unroll
            for (int g = 0; g < 4; ++g) { v2u w; w.x = pk2(OT[dt][4 * g] * inv, OT[dt][4 * g + 1] * inv); w.y = pk2(OT[dt][4 * g + 2] * inv, OT[dt][4 * g + 3] * inv);
                *(GAS v2u*)(orow + 32 * dt + 8 * g + 4 * hi) = w; }
#endif
    }
    __syncthreads();
}

__device__ __forceinline__ void sample_attn_wave(Frame& F, const Args& a, int s, int head, int wslot) {
    const bf16* Qb = (const bf16*)(a.ws + WS_QB); const bf16* Kb = (const bf16*)(a.ws + WS_KB); const bf16* Vb = (const bf16*)(a.ws + WS_VB);
    bf16* AO = (bf16*)(a.ws + WS_R1);
    const LAS float* tab = (const LAS float*)(F.lds + L4_TAB);
    LAS float* qs = (LAS float*)(F.lds + L4_SMP + wslot * 768); LAS float* ps = qs + 64;
    const int lane = F.lane, kvh = head >> 2; const int row = R_SAMPLE + s;
    qs[lane] = bf2f(Qb[(size_t)row * 512 + head * 64 + lane]);
    LDS_WAIT();
    const float* ck = a.in[2] + (size_t)s * 16384 + kvh * 64; const float* cv = a.in[3] + (size_t)s * 16384 + kvh * 64;
    float sc[2];
#pragma unroll
    for (int h = 0; h < 2; ++h) {
        const int i = lane + 64 * h; float acc = 0.f;
        const GAS f32x4* kp = (const GAS f32x4*)(ck + (size_t)(i < 127 ? i + 1 : 127) * 128);
#pragma unroll
        for (int d4 = 0; d4 < 16; ++d4) { const f32x4 kv = SMP_LOAD(kp + d4); const f32x4 qv = *(const LAS f32x4*)(qs + 4 * d4); acc += (kv.x * qv.x + kv.y * qv.y) + (kv.z * qv.z + kv.w * qv.w);
            if (SMP_KB && d4 == 7) { asm volatile("" ::: "memory"); __builtin_amdgcn_sched_barrier(0); } }
        sc[h] = acc;
    }
    { const float accn = wave_sum(bf2f(Kb[(size_t)row * 128 + kvh * 64 + lane]) * qs[lane]);
      if (lane == 63) sc[1] = accn; }
    sc[0] += tab[head * 192 + 32 + (127 - lane)]; sc[1] += tab[head * 192 + 32 + (63 - lane)];
    const float sink = a.in[15][head];
    const float mx = fmaxf(wave_max(fmaxf(sc[0], sc[1])), sink);
    const float p0 = __builtin_amdgcn_exp2f((sc[0] - mx) * pg8::LOG2E), p1 = __builtin_amdgcn_exp2f((sc[1] - mx) * pg8::LOG2E);
    const float den = wave_sum(p0 + p1) + __builtin_amdgcn_exp2f((sink - mx) * pg8::LOG2E);
    ps[lane] = p0; ps[lane + 64] = p1;
    LDS_WAIT();
    const int g = lane >> 4, d4 = lane & 15;
    f32x4 o = (f32x4){0.f, 0.f, 0.f, 0.f};
#pragma unroll
    for (int j = 0; j < 32; ++j) { const int i = 4 * j + g;
        f32x4 v = SMP_LOAD((const GAS f32x4*)(cv + (size_t)(i < 127 ? i + 1 : 127) * 128 + 4 * d4));
        if (j == 31) { const v2u nw = *(const GAS v2u*)(Vb + (size_t)row * 128 + kvh * 64 + 4 * d4);
            const f32x4 nv = (f32x4){__uint_as_float(nw.x << 16), __uint_as_float(nw.x & 0xffff0000u), __uint_as_float(nw.y << 16), __uint_as_float(nw.y & 0xffff0000u)};
            v = (i == 127) ? nv : v; }
        o += v * ps[i]; }
#pragma unroll
    for (int e = 0; e < 4; ++e) { o[e] += __shfl_xor(o[e], 16); o[e] += __shfl_xor(o[e], 32); }
    const float inv = 1.0f / den;
    if (g == 0) { v2u w; w.x = pk2(o[0] * inv, o[1] * inv); w.y = pk2(o[2] * inv, o[3] * inv); *(GAS v2u*)(AO + (size_t)row * 1024 + head * 64 + 4 * d4) = w; }
    LDS_WAIT();
}

__device__ __forceinline__ void conv_ln_store(Frame& F, const Args& a, int row_base) {
    bf16* CA = (bf16*)(a.ws + WS_R1) + 512;
    const LAS float* Y = (const LAS float*)(F.lds + L4_Y);
    const f32x4 g0 = *(const GAS f32x4*)(a.in[19] + 4 * F.lane), g1 = *(const GAS f32x4*)(a.in[19] + 256 + 4 * F.lane);
    const f32x4 b0 = *(const GAS f32x4*)(a.in[20] + 4 * F.lane), b1 = *(const GAS f32x4*)(a.in[20] + 256 + 4 * F.lane);
#pragma unroll
    for (int k = 0; k < 4; ++k) {
        const int i = 4 * F.wave + k; const int row = row_base + i;
        f32x4 x0 = *(const LAS f32x4*)(Y + i * 512 + 4 * F.lane), x1 = *(const LAS f32x4*)(Y + i * 512 + 256 + 4 * F.lane);
        const float mean = wave_sum(pg8::sum4(x0) + pg8::sum4(x1)) * (1.0f / 512.0f);
        x0 = x0 - mean; x1 = x1 - mean;
        const float var = wave_sum(pg8::sumsq4(x0) + pg8::sumsq4(x1)) * (1.0f / 512.0f);
        const float rstd = __builtin_amdgcn_rsqf(var + EPS);
        f32x4 y0 = x0 * rstd * g0 + b0, y1 = x1 * rstd * g1 + b1;
#pragma unroll
        for (int j = 0; j < 4; ++j) { y0[j] = y0[j] * pg8::fast_sigmoid(y0[j]); y1[j] = y1[j] * pg8::fast_sigmoid(y1[j]); }
        if (row >= 0) {
            v2u w0, w1; w0.x = pk2(y0[0], y0[1]); w0.y = pk2(y0[2], y0[3]); w1.x = pk2(y1[0], y1[1]); w1.y = pk2(y1[2], y1[3]);
#if P4_WT
            { const unsigned bo = (unsigned)((const char*)(CA + (size_t)row * 1024 + 4 * F.lane) - (const char*)a.ws);
              __builtin_amdgcn_raw_buffer_store_b64(w0, pg8::mkrsrc(a.ws), bo, 0, 16); __builtin_amdgcn_raw_buffer_store_b64(w1, pg8::mkrsrc(a.ws), bo + 512, 0, 16); }
#else
            *(GAS v2u*)(CA + (size_t)row * 1024 + 4 * F.lane) = w0; *(GAS v2u*)(CA + (size_t)row * 1024 + 256 + 4 * F.lane) = w1;
#endif
        }
    }
}
__device__ __forceinline__ void conv_fma32(const float (&w)[31], const float (&x)[62], float bias, LAS float* Ycol) {
#pragma unroll
    for (int ib = 0; ib < 32; ib += 8) {
        float s0 = bias, s1 = bias, s2 = bias, s3 = bias, s4 = bias, s5 = bias, s6 = bias, s7 = bias;
#pragma unroll
        for (int k = 0; k < 31; ++k) {
            s0 += w[k] * x[ib + 0 + k]; s1 += w[k] * x[ib + 1 + k]; s2 += w[k] * x[ib + 2 + k]; s3 += w[k] * x[ib + 3 + k];
            s4 += w[k] * x[ib + 4 + k]; s5 += w[k] * x[ib + 5 + k]; s6 += w[k] * x[ib + 6 + k]; s7 += w[k] * x[ib + 7 + k];
            asm volatile("" : "+v"(s0), "+v"(s1), "+v"(s2), "+v"(s3), "+v"(s4), "+v"(s5), "+v"(s6), "+v"(s7));
        }
        Ycol[(ib + 0) * 512] = s0; Ycol[(ib + 1) * 512] = s1; Ycol[(ib + 2) * 512] = s2; Ycol[(ib + 3) * 512] = s3;
        Ycol[(ib + 4) * 512] = s4; Ycol[(ib + 5) * 512] = s5; Ycol[(ib + 6) * 512] = s6; Ycol[(ib + 7) * 512] = s7;
    }
}
__device__ __forceinline__ void conv_win_load(const Args& a, int b, int t0, int tid, v4u (&g)[8]) {
    const bf16* GLU = (const bf16*)(a.ws + WS_GLU);
#pragma unroll
    for (int i = 0; i < 8; ++i) { const int ch = tid + 512 * i, r = ch >> 6, cc = ch & 63;
        const int row = tok_row(b, t0 - 30 + (r < 62 ? r : 61)); g[i] = *(const GAS v4u*)(GLU + (size_t)(row >= 0 ? row : 0) * 512 + cc * 8); }
}
__device__ __forceinline__ void conv_win_store(Frame& F, int b, int t0, int tid, const v4u (&g)[8]) {
    LAS bf16* WIN = (LAS bf16*)(F.lds + L4_WIN);
#pragma unroll
    for (int i = 0; i < 8; ++i) { const int ch = tid + 512 * i, r = ch >> 6, cc = ch & 63;
        if (r < 62) { const int row = tok_row(b, t0 - 30 + r); *(LAS v4u*)(WIN + r * 512 + cc * 8) = row >= 0 ? g[i] : (v4u){0u, 0u, 0u, 0u}; } }
}
__device__ __forceinline__ void conv_win_read(Frame& F, int c, float (&x)[62]) {
    const LAS bf16* WIN = (const LAS bf16*)(F.lds + L4_WIN);
#pragma unroll
    for (int r = 0; r < 62; ++r) x[r] = bf2f(WIN[r * 512 + c]);
}
__device__ __forceinline__ void conv_pair(Frame& F, const Args& a, int bA, int tA, int bB, int tB) {
    LAS float* Y = (LAS float*)(F.lds + L4_Y);
    const int c = F.tid;
    float w[31];
#pragma unroll
    for (int k = 0; k < 31; ++k) w[k] = a.in[17][k * 512 + c];
    const float bias = a.in[18][c];
    float x[62];
    { v4u g[8]; conv_win_load(a, bA, tA, F.tid, g); conv_win_store(F, bA, tA, F.tid, g); }
    __syncthreads();
    conv_win_read(F, c, x);
    v4u gB[8]; conv_win_load(a, bB, tB, F.tid, gB);
    conv_fma32(w, x, bias, Y + c);
    __syncthreads();
    conv_win_store(F, bB, tB, F.tid, gB);
    conv_ln_store(F, a, bA * SEQ + tA);
    __syncthreads();
    conv_win_read(F, c, x);
    conv_fma32(w, x, bias, Y + c);
    __syncthreads();
    conv_ln_store(F, a, bB * SEQ + tB);
    __syncthreads();
}
__device__ __forceinline__ void sample_conv_wave(Frame& F, const Args& a, int s) {
    const bf16* GLU = (const bf16*)(a.ws + WS_GLU); bf16* CA = (bf16*)(a.ws + WS_R1) + 512;
    const int c0 = 8 * F.lane;
    f32x4 acc0 = *(const GAS f32x4*)(a.in[18] + c0), acc1 = *(const GAS f32x4*)(a.in[18] + c0 + 4);
    const float* st = a.in[4] + (size_t)s * 15360 + c0; const float* wd = a.in[17] + c0;
#pragma unroll
    for (int k = 0; k < 30; ++k) {
        acc0 += *(const GAS f32x4*)(wd + k * 512) * NT_LOAD((const GAS f32x4*)(st + k * 512));
        acc1 += *(const GAS f32x4*)(wd + k * 512 + 4) * NT_LOAD((const GAS f32x4*)(st + k * 512 + 4));
    }
    { const v4u gw = *(const GAS v4u*)(GLU + (size_t)(R_SAMPLE + s) * 512 + c0);
      const f32x4 g0 = (f32x4){__uint_as_float(gw.x << 16), __uint_as_float(gw.x & 0xffff0000u), __uint_as_float(gw.y << 16), __uint_as_float(gw.y & 0xffff0000u)};
      const f32x4 g1 = (f32x4){__uint_as_float(gw.z << 16), __uint_as_float(gw.z & 0xffff0000u), __uint_as_float(gw.w << 16), __uint_as_float(gw.w & 0xffff0000u)};
      acc0 += *(const GAS f32x4*)(wd + 30 * 512) * g0; acc1 += *(const GAS f32x4*)(wd + 30 * 512 + 4) * g1; }
    const float mean = wave_sum(pg8::sum4(acc0) + pg8::sum4(acc1)) * (1.0f / 512.0f);
    acc0 = acc0 - mean; acc1 = acc1 - mean;
    const float var = wave_sum(pg8::sumsq4(acc0) + pg8::sumsq4(acc1)) * (1.0f / 512.0f);
    const float rstd = __builtin_amdgcn_rsqf(var + EPS);
    f32x4 y0 = acc0 * rstd * *(const GAS f32x4*)(a.in[19] + c0) + *(const GAS f32x4*)(a.in[20] + c0);
    f32x4 y1 = acc1 * rstd * *(const GAS f32x4*)(a.in[19] + c0 + 4) + *(const GAS f32x4*)(a.in[20] + c0 + 4);
#pragma unroll
    for (int j = 0; j < 4; ++j) { y0[j] = y0[j] * pg8::fast_sigmoid(y0[j]); y1[j] = y1[j] * pg8::fast_sigmoid(y1[j]); }
    *(GAS v4u*)(CA + (size_t)(R_SAMPLE + s) * 1024 + c0) = pg8::pack8(y0, y1);
}

constexpr int L_SIDE = 131072;
static_assert(L_SIDE + 3 * 8 * 1024 <= LDSCTL_OFF, "side scratch vs LDS control words");
template <int KS> __device__ __forceinline__ int sk_off(int k0, int fq) {
#if SK_LINES
    constexpr int NP = (KS / 64) * 64;
    return k0 < NP ? (k0 & ~63) + 16 * fq + ((k0 & 32) >> 2) : k0 + 8 * fq;
#else
    return k0 + 8 * fq;
#endif
}
template <int K, int LDA, int LDW> __device__ __forceinline__ f32x4 skinny_slice(const bf16* Arow0, const bf16* Wrow0, int lane, int wave) {
    constexpr int KS = K / 8;
    const int fr = lane & 15, fq = lane >> 4;
    const bf16* ap = Arow0 + (size_t)fr * LDA + wave * KS; const bf16* wp = Wrow0 + (size_t)fr * LDW + wave * KS;
    f32x4 acc0 = (f32x4){0.f, 0.f, 0.f, 0.f}, acc1 = acc0;
#pragma unroll
    for (int k0 = 0; k0 < KS; k0 += 32) {
        const int ko = sk_off<KS>(k0, fq); const bf16x8 av = *(const GAS bf16x8*)(ap + ko), wv = *(const GAS bf16x8*)(wp + ko);
        if ((k0 >> 5) & 1) acc1 = __builtin_amdgcn_mfma_f32_16x16x32_bf16(wv, av, acc1, 0, 0, 0); else acc0 = __builtin_amdgcn_mfma_f32_16x16x32_bf16(wv, av, acc0, 0, 0, 0);
    }
    return acc0 + acc1;
}
template <int K, int LDA, int LDW> __device__ __forceinline__ void skinny_pair(const bf16* A0row0, const bf16* A1row0, const bf16* Wrow0, int lane, int wave, f32x4& c0, f32x4& c1) {
    constexpr int KS = K / 8;
    const int fr = lane & 15, fq = lane >> 4;
    const bf16* ap0 = A0row0 + (size_t)fr * LDA + wave * KS; const bf16* ap1 = A1row0 + (size_t)fr * LDA + wave * KS; const bf16* wp = Wrow0 + (size_t)fr * LDW + wave * KS;
    c0 = (f32x4){0.f, 0.f, 0.f, 0.f}; c1 = c0;
#pragma unroll
    for (int k0 = 0; k0 < KS; k0 += 32) {
        const int ko = sk_off<KS>(k0, fq); const bf16x8 wv = *(const GAS bf16x8*)(wp + ko), a0 = *(const GAS bf16x8*)(ap0 + ko), a1 = *(const GAS bf16x8*)(ap1 + ko);
        c0 = __builtin_amdgcn_mfma_f32_16x16x32_bf16(wv, a0, c0, 0, 0, 0); c1 = __builtin_amdgcn_mfma_f32_16x16x32_bf16(wv, a1, c1, 0, 0, 0);
    }
}
template <int K, int LDA, int LDW> __device__ __forceinline__ void skinny_triple(const bf16* A0row0, const bf16* A1row0, const bf16* A2row0, const bf16* Wrow0, int lane, int wave, f32x4& c0, f32x4& c1, f32x4& c2) {
    constexpr int KS = K / 8;
    const int fr = lane & 15, fq = lane >> 4; const size_t ao = (size_t)fr * LDA + wave * KS;
    const bf16* ap0 = A0row0 + ao; const bf16* ap1 = A1row0 + ao; const bf16* ap2 = A2row0 + ao; const bf16* wp = Wrow0 + (size_t)fr * LDW + wave * KS;
    c0 = (f32x4){0.f, 0.f, 0.f, 0.f}; c1 = c0; c2 = c0;
#pragma unroll
    for (int k0 = 0; k0 < KS; k0 += 32) {
        const int ko = sk_off<KS>(k0, fq); const bf16x8 wv = *(const GAS bf16x8*)(wp + ko), a0 = *(const GAS bf16x8*)(ap0 + ko), a1 = *(const GAS bf16x8*)(ap1 + ko), a2 = *(const GAS bf16x8*)(ap2 + ko);
        c0 = __builtin_amdgcn_mfma_f32_16x16x32_bf16(wv, a0, c0, 0, 0, 0); c1 = __builtin_amdgcn_mfma_f32_16x16x32_bf16(wv, a1, c1, 0, 0, 0); c2 = __builtin_amdgcn_mfma_f32_16x16x32_bf16(wv, a2, c2, 0, 0, 0);
    }
}
template <int K> struct SkFrag { bf16x8 a[K / 8 / 32], w[K / 8 / 32]; };
template <int K, int LDA, int LDW> __device__ __forceinline__ void skinny_load(SkFrag<K>& f, const bf16* Arow0, const bf16* Wrow0, int lane, int wave) {
    constexpr int KS = K / 8;
    const int fr = lane & 15, fq = lane >> 4;
    const bf16* ap = Arow0 + (size_t)fr * LDA + wave * KS; const bf16* wp = Wrow0 + (size_t)fr * LDW + wave * KS;
#pragma unroll
    for (int i = 0; i < KS / 32; ++i) { const int ko = sk_off<KS>(32 * i, fq); f.a[i] = *(const GAS bf16x8*)(ap + ko); f.w[i] = *(const GAS bf16x8*)(wp + ko); }
}
template <int K> __device__ __forceinline__ f32x4 skinny_mma(const SkFrag<K>& f) {
    f32x4 acc0 = (f32x4){0.f, 0.f, 0.f, 0.f}, acc1 = acc0;
#pragma unroll
    for (int i = 0; i < K / 8 / 32; ++i) { if (i & 1) acc1 = __builtin_amdgcn_mfma_f32_16x16x32_bf16(f.w[i], f.a[i], acc1, 0, 0, 0); else acc0 = __builtin_amdgcn_mfma_f32_16x16x32_bf16(f.w[i], f.a[i], acc0, 0, 0, 0); }
    return acc0 + acc1;
}
__device__ __forceinline__ v2u pack4(const f32x4& v) { v2u w; w.x = pg8::cvt_pk_bf16(v[0], v[1]); w.y = pg8::cvt_pk_bf16(v[2], v[3]); return w; }
__device__ __forceinline__ f32x4 unpack4(const v2u& w) { return (f32x4){__uint_as_float(w.x << 16), __uint_as_float(w.x & 0xffff0000u), __uint_as_float(w.y << 16), __uint_as_float(w.y & 0xffff0000u)}; }
__device__ __forceinline__ f32x4 side_reduce(const LAS f32x4* part, int slot, int lane) {
    f32x4 s = part[(slot * 8) * 64 + lane];
#pragma unroll
    for (int w = 1; w < 8; ++w) s += part[(slot * 8 + w) * 64 + lane];
    return s;
}
__device__ __forceinline__ void side_p2(Frame& F, const Args& a, float* ss) {
    const bf16* HID = (const bf16*)(a.ws + WS_R2); const bf16* W2 = (const bf16*)(a.ws + WS_W2A); bf16* HB = (bf16*)a.out;
    float* hside = (float*)(a.ws + WS_HSIDE);
    LAS f32x4* part = (LAS f32x4*)(F.lds + L_SIDE);
    const int fr = F.lane & 15, fq = F.lane >> 4; constexpr int NT = 9 * 64;
    for (int t0 = blockIdx.x; t0 < NT; t0 += 3 * F.G) {
#if SIDE_BATCH == 2
    { const int ta = t0, tb = t0 + F.G, tc = t0 + 2 * F.G;
      if (tc < NT && ((ta ^ tb) & 63) == 0 && ((ta ^ tc) & 63) == 0) { f32x4 c0, c1, c2;
          skinny_triple<DFF, DFF, DFF>(HID + (size_t)(R_META + 16 * (ta >> 6)) * DFF, HID + (size_t)(R_META + 16 * (tb >> 6)) * DFF, HID + (size_t)(R_META + 16 * (tc >> 6)) * DFF, W2 + (size_t)(16 * (ta & 63)) * DFF, F.lane, F.wave, c0, c1, c2);
          part[(0 * 8 + F.wave) * 64 + F.lane] = c0; part[(1 * 8 + F.wave) * 64 + F.lane] = c1; part[(2 * 8 + F.wave) * 64 + F.lane] = c2;
      } else {
      if (tb < NT && ((ta ^ tb) & 63) == 0) { f32x4 c0, c1;
          skinny_pair<DFF, DFF, DFF>(HID + (size_t)(R_META + 16 * (ta >> 6)) * DFF, HID + (size_t)(R_META + 16 * (tb >> 6)) * DFF, W2 + (size_t)(16 * (ta & 63)) * DFF, F.lane, F.wave, c0, c1);
          part[(0 * 8 + F.wave) * 64 + F.lane] = c0; part[(1 * 8 + F.wave) * 64 + F.lane] = c1;
      } else {
          if (ta < NT) part[(0 * 8 + F.wave) * 64 + F.lane] = skinny_slice<DFF, DFF, DFF>(HID + (size_t)(R_META + 16 * (ta >> 6)) * DFF, W2 + (size_t)(16 * (ta & 63)) * DFF, F.lane, F.wave);
          if (tb < NT) part[(1 * 8 + F.wave) * 64 + F.lane] = skinny_slice<DFF, DFF, DFF>(HID + (size_t)(R_META + 16 * (tb >> 6)) * DFF, W2 + (size_t)(16 * (tb & 63)) * DFF, F.lane, F.wave); }
      if (tc < NT) part[(2 * 8 + F.wave) * 64 + F.lane] = skinny_slice<DFF, DFF, DFF>(HID + (size_t)(R_META + 16 * (tc >> 6)) * DFF, W2 + (size_t)(16 * (tc & 63)) * DFF, F.lane, F.wave); } }
#elif SIDE_BATCH
    { SkFrag<DFF> f0, f1; const int ta = t0, tb = t0 + F.G;
      if (ta < NT) skinny_load<DFF, DFF, DFF>(f0, HID + (size_t)(R_META + 16 * (ta >> 6)) * DFF, W2 + (size_t)(16 * (ta & 63)) * DFF, F.lane, F.wave);
      if (tb < NT) skinny_load<DFF, DFF, DFF>(f1, HID + (size_t)(R_META + 16 * (tb >> 6)) * DFF, W2 + (size_t)(16 * (tb & 63)) * DFF, F.lane, F.wave);
      asm volatile("" ::: "memory"); __builtin_amdgcn_sched_barrier(0);
      if (ta < NT) part[(0 * 8 + F.wave) * 64 + F.lane] = skinny_mma<DFF>(f0);
      if (tb < NT) part[(1 * 8 + F.wave) * 64 + F.lane] = skinny_mma<DFF>(f1);
      const int tc = t0 + 2 * F.G;
      if (tc < NT) part[(2 * 8 + F.wave) * 64 + F.lane] = skinny_slice<DFF, DFF, DFF>(HID + (size_t)(R_META + 16 * (tc >> 6)) * DFF, W2 + (size_t)(16 * (tc & 63)) * DFF, F.lane, F.wave); }
#else
#pragma unroll
    for (int j = 0; j < 3; ++j) { const int t = t0 + j * F.G; if (t < NT) { const int rt = t >> 6, cs = t & 63;
        part[(j * 8 + F.wave) * 64 + F.lane] = skinny_slice<DFF, DFF, DFF>(HID + (size_t)(R_META + 16 * rt) * DFF, W2 + (size_t)(16 * cs) * DFF, F.lane, F.wave); } }
#endif
    __syncthreads();
    { const int t = t0 + F.wave * F.G;
      if (F.wave < 3 && t < NT) {
        const int rt = t >> 6, cs = t & 63; const int row0 = R_META + 16 * rt, col = 16 * cs + 4 * fq, row = row0 + fr;
        const f32x4 acc = side_reduce(part, F.wave, F.lane);
        const float* src = rt == 0 ? a.in[5] + (size_t)fr * D : a.in[1] + (size_t)(16 * (rt - 1) + fr) * D;
        const f32x4 h = NT_LOAD((const GAS f32x4*)(src + col)) + acc * 0.5f;
        *(GAS f32x4*)(hside + (size_t)(row - R_META) * D + col) = h;
        __builtin_amdgcn_raw_buffer_store_b64(pack4(h), pg8::mkrsrc(a.out), (unsigned)(((size_t)row * D + col) * 2), 0, 16);
        float p = pg8::sumsq4(h); p += __shfl_xor(p, 16); p += __shfl_xor(p, 32);
        if (fq == 0) atomicAdd(ss + row, p);
      } }
    __syncthreads();
    }
}
__device__ __forceinline__ void side_p5(Frame& F, const Args& a) {
    const bf16* AO = (const bf16*)(a.ws + WS_R1); const bf16* CA = AO + 512; const bf16* Wm = (const bf16*)(a.ws + WS_WMIX);
    const bf16* GA = (const bf16*)(a.ws + WS_GA); const bf16* GC = (const bf16*)(a.ws + WS_GC); bf16* MIXB = (bf16*)(a.ws + WS_MIXB);
    LAS f32x4* part = (LAS f32x4*)(F.lds + L_SIDE);
    const int fr = F.lane & 15, fq = F.lane >> 4; constexpr int NT = 8 * 64;
    for (int t0 = blockIdx.x; t0 < NT; t0 += 2 * F.G) {
#if SIDE_BATCH == 2
    if (t0 + F.G < NT && ((t0 ^ (t0 + F.G)) & 63) == 0) {
        const int cs = t0 & 63, rowa0 = R_SAMPLE + 16 * (t0 >> 6), rowb0 = R_SAMPLE + 16 * ((t0 + F.G) >> 6), col = 16 * cs + 4 * fq;
        f32x4 x0, x1, y0, y1;
        skinny_pair<512, 1024, 1024>(AO + (size_t)rowa0 * 1024, AO + (size_t)rowb0 * 1024, Wm + (size_t)(16 * cs) * 1024, F.lane, F.wave, x0, x1);
        skinny_pair<512, 1024, 1024>(CA + (size_t)rowa0 * 1024, CA + (size_t)rowb0 * 1024, Wm + (size_t)(16 * cs) * 1024 + 512, F.lane, F.wave, y0, y1);
        const v2u gaa = *(const GAS v2u*)(GA + (size_t)(rowa0 + fr) * D + col), gca = *(const GAS v2u*)(GC + (size_t)(rowa0 + fr) * D + col);
        const v2u gab = *(const GAS v2u*)(GA + (size_t)(rowb0 + fr) * D + col), gcb = *(const GAS v2u*)(GC + (size_t)(rowb0 + fr) * D + col);
        part[(0 * 8 + F.wave) * 64 + F.lane] = unpack4(gaa) * x0 + unpack4(gca) * y0;
        part[(1 * 8 + F.wave) * 64 + F.lane] = unpack4(gab) * x1 + unpack4(gcb) * y1;
    } else
#endif
#pragma unroll
    for (int j = 0; j < 2; ++j) { const int t = t0 + j * F.G; if (t < NT) { const int rt = t >> 6, cs = t & 63; const int row0 = R_SAMPLE + 16 * rt, col = 16 * cs + 4 * fq, row = row0 + fr;
        const f32x4 p1 = skinny_slice<512, 1024, 1024>(AO + (size_t)row0 * 1024, Wm + (size_t)(16 * cs) * 1024, F.lane, F.wave);
        const f32x4 p2 = skinny_slice<512, 1024, 1024>(CA + (size_t)row0 * 1024, Wm + (size_t)(16 * cs) * 1024 + 512, F.lane, F.wave);
        const v2u gaw = *(const GAS v2u*)(GA + (size_t)row * D + col), gcw = *(const GAS v2u*)(GC + (size_t)row * D + col);
        part[(j * 8 + F.wave) * 64 + F.lane] = unpack4(gaw) * p1 + unpack4(gcw) * p2; } }
    __syncthreads();
    { const int t = t0 + F.wave * F.G;
      if (F.wave < 2 && t < NT) {
        const int rt = t >> 6, cs = t & 63; const int row0 = R_SAMPLE + 16 * rt, col = 16 * cs + 4 * fq, row = row0 + fr;
        __builtin_amdgcn_raw_buffer_store_b64(pack4(side_reduce(part, F.wave, F.lane)), pg8::mkrsrc(a.ws), (unsigned)(WS_MIXB + ((size_t)row * D + col) * 2), 0, 16);
      } }
    __syncthreads();
    }
}
__device__ __forceinline__ void side_p6(Frame& F, const Args& a, float* ss) {
    const bf16* MIXB = (const bf16*)(a.ws + WS_MIXB); const bf16* Wo = (const bf16*)(a.ws + WS_WOUT); bf16* H2B = (bf16*)(a.ws + WS_R1);
    float* hside = (float*)(a.ws + WS_HSIDE);
    LAS f32x4* part = (LAS f32x4*)(F.lds + L_SIDE);
    const int fr = F.lane & 15, fq = F.lane >> 4; constexpr int NT = 8 * 64;
    for (int t0 = blockIdx.x; t0 < NT; t0 += 2 * F.G) {
#if SIDE_BATCH == 2
    { const int ta = t0, tb = t0 + F.G;
      if (tb < NT && ((ta ^ tb) & 63) == 0) { f32x4 c0, c1;
          skinny_pair<D, D, D>(MIXB + (size_t)(R_SAMPLE + 16 * (ta >> 6)) * D, MIXB + (size_t)(R_SAMPLE + 16 * (tb >> 6)) * D, Wo + (size_t)(16 * (ta & 63)) * D, F.lane, F.wave, c0, c1);
          part[(0 * 8 + F.wave) * 64 + F.lane] = c0; part[(1 * 8 + F.wave) * 64 + F.lane] = c1;
      } else {
          if (ta < NT) part[(0 * 8 + F.wave) * 64 + F.lane] = skinny_slice<D, D, D>(MIXB + (size_t)(R_SAMPLE + 16 * (ta >> 6)) * D, Wo + (size_t)(16 * (ta & 63)) * D, F.lane, F.wave);
          if (tb < NT) part[(1 * 8 + F.wave) * 64 + F.lane] = skinny_slice<D, D, D>(MIXB + (size_t)(R_SAMPLE + 16 * (tb >> 6)) * D, Wo + (size_t)(16 * (tb & 63)) * D, F.lane, F.wave); } }
#elif SIDE_BATCH
    { SkFrag<D> f0, f1; const int ta = t0, tb = t0 + F.G;
      if (ta < NT) skinny_load<D, D, D>(f0, MIXB + (size_t)(R_SAMPLE + 16 * (ta >> 6)) * D, Wo + (size_t)(16 * (ta & 63)) * D, F.lane, F.wave);
      if (tb < NT) skinny_load<D, D, D>(f1, MIXB + (size_t)(R_SAMPLE + 16 * (tb >> 6)) * D, Wo + (size_t)(16 * (tb & 63)) * D, F.lane, F.wave);
      asm volatile("" ::: "memory"); __builtin_amdgcn_sched_barrier(0);
      if (ta < NT) part[(0 * 8 + F.wave) * 64 + F.lane] = skinny_mma<D>(f0);
      if (tb < NT) part[(1 * 8 + F.wave) * 64 + F.lane] = skinny_mma<D>(f1); }
#else
#pragma unroll
    for (int j = 0; j < 2; ++j) { const int t = t0 + j * F.G; if (t < NT) { const int rt = t >> 6, cs = t & 63;
        part[(j * 8 + F.wave) * 64 + F.lane] = skinny_slice<D, D, D>(MIXB + (size_t)(R_SAMPLE + 16 * rt) * D, Wo + (size_t)(16 * cs) * D, F.lane, F.wave); } }
#endif
    __syncthreads();
    { const int t = t0 + F.wave * F.G;
      if (F.wave < 2 && t < NT) {
        const int rt = t >> 6, cs = t & 63; const int row0 = R_SAMPLE + 16 * rt, col = 16 * cs + 4 * fq, row = row0 + fr;
        const f32x4 acc = side_reduce(part, F.wave, F.lane);
        GAS f32x4* hp = (GAS f32x4*)(hside + (size_t)(row - R_META) * D + col);
        const f32x4 h = *hp + acc;
        *hp = h;
        __builtin_amdgcn_raw_buffer_store_b64(pack4(h), pg8::mkrsrc(a.ws), (unsigned)(WS_R1 + ((size_t)row * D + col) * 2), 0, 16);
        float p = pg8::sumsq4(h); p += __shfl_xor(p, 16); p += __shfl_xor(p, 32);
        if (fq == 0) atomicAdd(ss + row, p);
      } }
    __syncthreads();
    }
}
__device__ __forceinline__ void side_p8(Frame& F, const Args& a) {
    const bf16* HID = (const bf16*)(a.ws + WS_R2); const bf16* W2 = (const bf16*)(a.ws + WS_W2B);
    const float* hside = (const float*)(a.ws + WS_HSIDE);
    LAS f32x4* part = (LAS f32x4*)(F.lds + L_SIDE);
    const int fr = F.lane & 15, fq = F.lane >> 4; constexpr int NT = 8 * 64;
    for (int t0 = blockIdx.x; t0 < NT; t0 += 2 * F.G) {
#if SIDE_BATCH == 2
    { const int ta = t0, tb = t0 + F.G;
      if (tb < NT && ((ta ^ tb) & 63) == 0) { f32x4 c0, c1;
          skinny_pair<DFF, DFF, DFF>(HID + (size_t)(R_SAMPLE + 16 * (ta >> 6)) * DFF, HID + (size_t)(R_SAMPLE + 16 * (tb >> 6)) * DFF, W2 + (size_t)(16 * (ta & 63)) * DFF, F.lane, F.wave, c0, c1);
          part[(0 * 8 + F.wave) * 64 + F.lane] = c0; part[(1 * 8 + F.wave) * 64 + F.lane] = c1;
      } else {
          if (ta < NT) part[(0 * 8 + F.wave) * 64 + F.lane] = skinny_slice<DFF, DFF, DFF>(HID + (size_t)(R_SAMPLE + 16 * (ta >> 6)) * DFF, W2 + (size_t)(16 * (ta & 63)) * DFF, F.lane, F.wave);
          if (tb < NT) part[(1 * 8 + F.wave) * 64 + F.lane] = skinny_slice<DFF, DFF, DFF>(HID + (size_t)(R_SAMPLE + 16 * (tb >> 6)) * DFF, W2 + (size_t)(16 * (tb & 63)) * DFF, F.lane, F.wave); } }
#elif SIDE_BATCH
    { SkFrag<DFF> f0, f1; const int ta = t0, tb = t0 + F.G;
      if (ta < NT) skinny_load<DFF, DFF, DFF>(f0, HID + (size_t)(R_SAMPLE + 16 * (ta >> 6)) * DFF, W2 + (size_t)(16 * (ta & 63)) * DFF, F.lane, F.wave);
      if (tb < NT) skinny_load<DFF, DFF, DFF>(f1, HID + (size_t)(R_SAMPLE + 16 * (tb >> 6)) * DFF, W2 + (size_t)(16 * (tb & 63)) * DFF, F.lane, F.wave);
      asm volatile("" ::: "memory"); __builtin_amdgcn_sched_barrier(0);
      if (ta < NT) part[(0 * 8 + F.wave) * 64 + F.lane] = skinny_mma<DFF>(f0);
      if (tb < NT) part[(1 * 8 + F.wave) * 64 + F.lane] = skinny_mma<DFF>(f1); }
#else
#pragma unroll
    for (int j = 0; j < 2; ++j) { const int t = t0 + j * F.G; if (t < NT) { const int rt = t >> 6, cs = t & 63;
        part[(j * 8 + F.wave) * 64 + F.lane] = skinny_slice<DFF, DFF, DFF>(HID + (size_t)(R_SAMPLE + 16 * rt) * DFF, W2 + (size_t)(16 * cs) * DFF, F.lane, F.wave); } }
#endif
    __syncthreads();
    { const int t = t0 + F.wave * F.G;
      if (F.wave < 2 && t < NT) {
        const int rt = t >> 6, cs = t & 63; const int row0 = R_SAMPLE + 16 * rt, col = 16 * cs + 4 * fq, row = row0 + fr;
        const f32x4 acc = side_reduce(part, F.wave, F.lane);
        const f32x4 h = *(const GAS f32x4*)(hside + (size_t)(row - R_META) * D + col);
        *(GAS f32x4*)(a.out + O_YS + (size_t)(row - R_SAMPLE) * D + col) = h + acc * 0.5f;
      } }
    __syncthreads();
    }
}

__device__ __forceinline__ void p4_mixers(Frame& F, const Args& a) {
    { LAS float* tab = (LAS float*)(F.lds + L4_TAB);
      for (int i = F.tid; i < 8 * 192; i += NWAVES * 64) { const int h = i / 192, d = i % 192 - 32; tab[i] = (d >= 0 && d < 128) ? a.in[14][t5_bucket(d) * 8 + h] : -1e30f; }
      __syncthreads(); }
    const int G = F.G, c = blockIdx.x;
#ifdef P4_COPY
    { const v4u* q = (const v4u*)(a.ws + WS_QB); const v4u* g = (const v4u*)(a.ws + WS_GLU); v4u* ao = (v4u*)(a.ws + WS_R1); v4u* ca = ao + (size_t)MP * 64;
      for (size_t i = (size_t)c * 512 + F.tid; i < (size_t)MP * 64; i += (size_t)G * 512) { ao[i] = q[i]; ca[i] = g[i]; } return; }
#endif
#ifndef P4_MASK
#define P4_MASK 15
#endif
#ifndef P4_DUP
#define P4_DUP 0
#endif
    if (P4_MASK & 1) for (int u = c; u < ((P4_DUP & 1) ? 512 : 256); u += G) attn_unit(F, a, (u & 255) >> 7, (u >> 6) & 1, u & 63);
    if (P4_MASK & 2) for (int u = c; u < ((P4_DUP & 2) ? 512 : 256); u += G) { const int uA = 2 * (u & 255), uB = uA + 1; conv_pair(F, a, uA >> 8, 32 * (uA & 255), uB >> 8, 32 * (uB & 255)); }
    if (P4_MASK & 4) for (int t = c * 4 + (F.wave & 3); t < ((P4_DUP & 4) ? 2048 : 1024) && F.wave < 4; t += G * 4) sample_attn_wave(F, a, (t & 1023) >> 3, t & 7, F.wave);
    if (P4_MASK & 8) for (int t = c * 4 + (F.wave & 3); t < ((P4_DUP & 8) ? 1152 : 128) && F.wave >= 4; t += G * 4) sample_conv_wave(F, a, t & 127);
}

__global__ void __launch_bounds__(NWAVES * 64, 2) mk_fwd(Args args) {
    extern __shared__ __attribute__((aligned(16))) unsigned char lds[];
    Frame F;
    F.lds = (LAS unsigned char*)lds;
    F.MISC = (volatile LAS unsigned*)(F.lds + MISC_OFF);
    F.tid = threadIdx.x; F.lane = F.tid & 63; F.wave = __builtin_amdgcn_readfirstlane(F.tid >> 6);
    F.G = gridDim.x;
    unsigned char* ws = args.ws;
    F.ctl = (gu32*)(ws + WS_CTL);
    for (int u = F.tid; u < (LDS_BYTES - LDSCTL_OFF) / 4; u += NWAVES * 64) ((LAS unsigned*)(F.lds + LDSCTL_OFF))[u] = 0u;
    __syncthreads();
    XcdBarrier bar; bar.bar = (unsigned*)(F.ctl + CW_BAR); bar.x = 0; bar.st = nullptr;
    if (!MK_SPLIT) bar = xcd_barrier_post((unsigned*)(F.ctl + CW_BAR), F.MISC + 8);
    const int lo = args.ph_lo, hi = args.ph_hi;
#ifndef PH_MASK
#define PH_MASK 0x1ff
#endif
#define IN(k) (((PH_MASK >> (k)) & 1) && lo <= (k) && (k) < hi)
#define SEAM(k) do { if (IN(k) && IN((k) + 1)) xcd_barrier(bar); } while (0)
#ifndef MULTI_ALIGN
#define MULTI_ALIGN true
#endif
#ifndef MULTI_SP2
#define MULTI_SP2 true
#endif
#ifndef AUXA_DOWN
#define AUXA_DOWN 0
#endif
#ifndef DUP_MASK
#define DUP_MASK 0
#endif
#ifndef EARLY_WB
#define EARLY_WB 0
#endif
#ifndef SEAMW3
#define SEAMW3 (xloc ? bar.bar + XB_SEAM(2) : nullptr)
#endif
#ifndef SEAMW7
#define SEAMW7 (xloc ? bar.bar + XB_SEAM(6) : nullptr)
#endif
#define MK_STR2(x) #x
#define MK_STR(x) MK_STR2(x)
#define REP(k) for (int rep_ = 0; rep_ < (((DUP_MASK >> (k)) & 1) ? 2 : 1); ++rep_)
    const int bx = blockIdx.x;
    float* const ss1 = (float*)(F.ctl + CW_SS1); float* const ss2 = (float*)(F.ctl + CW_SS2); float* const ss3 = (float*)(F.ctl + CW_SS3);
    float* const outy = args.out + O_Y; float* const outys = args.out + O_YS; float* const hside = (float*)(ws + WS_HSIDE);
    bf16* const R1 = (bf16*)(ws + WS_R1); bf16* const HID = (bf16*)(ws + WS_R2); bf16* const HB = (bf16*)args.out;

#ifdef PROBE_TWICE
    for (int whole_ = 0; whole_ < 2; ++whole_) {
    if (whole_ == 1) { xcd_barrier(bar); for (int i = bx * 512 + F.tid; i < 2 * MP; i += F.G * 512) ss2[i] = 0.f; xcd_barrier(bar); }
#endif
    if (IN(0)) REP(0) { p0_prologue(F, args);
#ifdef NO_IDLE_ITEMS
        p0_items(F, args, P0_B0, P0_C0 + P0_C_P3, bx, F.G);
#endif
#ifdef COPIES_IN_P0
        p0_copies(F, args, bx, F.G);
#endif
        SEAM(0); }
    bool xloc = false; int vx = bx;
#if LOCAL_SEAMS
    if (!MK_SPLIT && IN(0) && IN(1)) {
        if (F.tid == 0) F.MISC[11] = xcd_layout_ok(bar, (unsigned)F.G) ? 1u : 0u;
        __syncthreads();
        xloc = F.MISC[11] != 0u;
        if (xloc) vx = (int)bar.x + 8 * (int)F.MISC[10];
#ifdef PROBE_XLOC
        if (xloc) { const unsigned long long t0_ = __builtin_amdgcn_s_memrealtime(); while (__builtin_amdgcn_s_memrealtime() - t0_ < PROBE_XLOC) __builtin_amdgcn_s_sleep(8); }
#endif
    }
#endif
    if (IN(1)) REP(1) {
        pg8::Gemm g{R1, (const bf16*)(ws + WS_W13A), MP, 2 * DFF, D}; pg8::StaticOrder S; S.init(MP, 2 * DFF, F.G, bx);
        pg8::EpiUp E{HID, DFF, ss1};
        pg8::gemm_phase<pg8::EpiUp, pg8::StaticOrder, MULTI_ALIGN, MULTI_SP2>(F.lds, g, S, E);
        { const int nu = NTM * 22, rem = nu % F.G;
#ifndef NO_IDLE_ITEMS
          if (rem == 0) p0_items(F, args, P0_B0, P0_C0, bx, F.G); else if (bx >= rem) p0_items(F, args, P0_B0, P0_C0, bx - rem, F.G - rem);
#endif
        }
        SEAM(1);
    }
#ifdef PROBE_P1
    if (IN(1)) {
        pg8::Gemm g{R1, (const bf16*)(ws + WS_W13A), MP, 2 * DFF, D}; pg8::StaticOrder S; S.init(MP, 2 * DFF, F.G, bx);
        pg8::EpiUp E{HID, DFF, ss1};
        pg8::gemm_phase<pg8::EpiUp, pg8::StaticOrder, true, true>(F.lds, g, S, E);
        if (PROBE_P1 == 2) { const int nu = NTM * 22, rem = nu % F.G; if (bx >= rem) p0_items(F, args, P0_B0, P0_C0, bx - rem, F.G - rem); }
        xcd_barrier(bar);
    }
#endif
#ifdef PROBE_P2
    if (IN(2)) { float* const ssd = (PROBE_P2 >= 3) ? nullptr : (float*)(F.ctl + CW_SS3 + MP);
        if (PROBE_P2 == 1) side_p2(F, args, ssd);
        pg8::Gemm g{HID, (const bf16*)(ws + WS_W2A), NPROMPT, D, DFF}; pg8::StaticOrder S; S.init(NPROMPT, D, F.G, bx);
        pg8::EpiRes<0> E{nullptr, R1, nullptr, HB, ssd};
        pg8::gemm_phase<pg8::EpiRes<0>, pg8::StaticOrder, true, true>(F.lds, g, S, E);
        xcd_barrier(bar); }
#endif
#ifdef PROBE_P6
    if (IN(2)) { float* const ssd = (float*)(F.ctl + CW_SS3 + MP);
        pg8::Gemm g{HID, (const bf16*)(ws + WS_W2A), NPROMPT, D, D}; pg8::StaticOrder S; S.init(NPROMPT, D, F.G, bx);
        pg8::EpiRes<1> E{nullptr, R1, nullptr, (bf16*)(ws + WS_MIX), ssd};
        pg8::gemm_phase<pg8::EpiRes<1>, pg8::StaticOrder, true, true>(F.lds, g, S, E);
        xcd_barrier(bar); }
#endif
    if (IN(2)) REP(2) {
        pg8::Gemm g{HID, (const bf16*)(ws + WS_W2A), NPROMPT, D, DFF}; pg8::StaticOrder S; S.init(NPROMPT, D, F.G, vx);
        pg8::EpiRes<0> E{nullptr, R1, nullptr, HB, ss2};
        struct Post2 { Frame& F; const Args& a; float* ss; __device__ __forceinline__ void operator()() const { side_p2(F, a, ss); } } post{F, args, ss2};
        pg8::gemm_phase<pg8::EpiRes<0>, pg8::StaticOrder, true, true, Post2, AUXA_DOWN>(F.lds, g, S, E, post);
        if (xloc) xcd_barrier_local(bar, 2); else SEAM(2);
    }
#ifdef PROBE_BAR
    if (IN(2)) { for (int i_ = 0; i_ < PROBE_BAR; ++i_) xcd_barrier(bar); }
#endif
#ifdef PROBE_GEMM
    if (IN(2)) {
        if (PROBE_GEMM == 2) { pg8::Gemm g{HID, (const bf16*)(ws + WS_W2A), NPROMPT, D, DFF}; pg8::StaticOrder S; S.init(NPROMPT, D, F.G, bx); pg8::EpiNull E{hside}; pg8::gemm_phase<pg8::EpiNull, pg8::StaticOrder, true, true>(F.lds, g, S, E); }
        if (PROBE_GEMM == 1) { pg8::Gemm g{HID, (const bf16*)(ws + WS_W13A), MP, 2 * DFF, D}; pg8::StaticOrder S; S.init(MP, 2 * DFF, F.G, bx); pg8::EpiNull E{hside}; pg8::gemm_phase<pg8::EpiNull, pg8::StaticOrder, true, true>(F.lds, g, S, E); }
        if (PROBE_GEMM == 6) { pg8::Gemm g{HID, (const bf16*)(ws + WS_WOUT), NPROMPT, D, D}; pg8::StaticOrder S; S.init(NPROMPT, D, F.G, bx); pg8::EpiNull E{hside}; pg8::gemm_phase<pg8::EpiNull, pg8::StaticOrder, true, true>(F.lds, g, S, E); }
        xcd_barrier(bar);
    }
#endif
#ifdef PROBE_P12
    if (IN(2)) { float* const ssd = (float*)(F.ctl + CW_SS3 + MP);
        { pg8::Gemm g{R1, (const bf16*)(ws + WS_W13A), MP, 2 * DFF, D}; pg8::StaticOrder S; S.init(MP, 2 * DFF, F.G, bx);
          pg8::EpiUp E{HID, DFF, ss1};
          pg8::gemm_phase<pg8::EpiUp, pg8::StaticOrder, true, true>(F.lds, g, S, E); }
        xcd_barrier(bar);
        { pg8::Gemm g{HID, (const bf16*)(ws + WS_W2A), NPROMPT, D, DFF}; pg8::StaticOrder S; S.init(NPROMPT, D, F.G, bx);
          pg8::EpiRes<0> E{nullptr, R1, nullptr, HB, ssd};
          pg8::gemm_phase<pg8::EpiRes<0>, pg8::StaticOrder, true, true>(F.lds, g, S, E); }
        xcd_barrier(bar);
    }
#endif
    if (IN(3)) REP(3) {
        pg8::Gemm g{HB, (const bf16*)(ws + WS_WIN), MP, NIN, D}; pg8::MainSideOrder S; int ir, nidle; S.init(NPROMPT, NIN, F.G, vx, SEAMW3, ir, nidle);
        pg8::EpiWin E{ss2, args.in[12], args.in[13], ws, args.out};
        pg8::gemm_phase<pg8::EpiWin, pg8::MainSideOrder, MULTI_ALIGN, MULTI_SP2>(F.lds, g, S, E);
#ifndef NO_IDLE_ITEMS
        if (ir >= 15) p0_items(F, args, P0_C0, P0_C0 + P0_C_P3, ir - 15, nidle - 15);
#endif
        SEAM(3);
    }
#ifdef PROBE_P3
    if (IN(3)) {
        pg8::Gemm g{HB, (const bf16*)(ws + WS_WIN), MP, NIN, D}; pg8::StaticOrder S; S.init(MP, NIN, F.G, bx);
        pg8::EpiWin E{ss2, args.in[12], args.in[13], ws, args.out};
        pg8::gemm_phase<pg8::EpiWin, pg8::StaticOrder, true, true>(F.lds, g, S, E);
        if (PROBE_P3 == 2) { const int nu = NTM * 15, rem = nu % F.G; if (bx >= rem) p0_items(F, args, P0_C0, P0_C0 + P0_C_P3, bx - rem, F.G - rem); }
        xcd_barrier(bar);
    }
#endif
    if (IN(4)) REP(4) { p4_mixers(F, args); VM_WAIT(); __syncthreads(); SEAM(4); }
#ifdef PROBE_P4
    if (IN(4)) { p4_mixers(F, args); VM_WAIT(); __syncthreads(); xcd_barrier(bar); }
#endif
    if (IN(5)) REP(5) {
#ifdef PROBE_ICACHE
        { int x_ = F.tid; asm volatile(".rept " MK_STR(PROBE_ICACHE) "\n\tv_mov_b32_e64 %0, %0\n\t.endr" : "+v"(x_)); if (x_ == 0x7fffffff) F.MISC[12] = 1u; }
#endif
        pg8::Gemm g{R1, (const bf16*)(ws + WS_WMIX), NPROMPT, D, D}; pg8::StaticOrder S; S.init(NPROMPT, D, F.G, vx);
        pg8::EpiMix E{(const bf16*)(ws + WS_GA), (const bf16*)(ws + WS_GC), (bf16*)(ws + WS_MIXB)};
        struct Post5 { Frame& F; const Args& a; __device__ __forceinline__ void operator()() const { side_p5(F, a);
#ifdef PROBE_SIDE2
            side_p5(F, a);
#endif
        } } post{F, args};
        pg8::gemm_phase<pg8::EpiMix, pg8::StaticOrder, true, true, Post5>(F.lds, g, S, E, post);
        if (xloc) xcd_barrier_local(bar, 5); else SEAM(5);
    }
#ifdef PROBE_P5
    if (IN(5)) {
        if (PROBE_P5 == 1) side_p5(F, args);
#ifdef PROBE_DELAY
        if ((bx & 7) < 4) { const unsigned long long t0_ = __builtin_amdgcn_s_memrealtime(); while (__builtin_amdgcn_s_memrealtime() - t0_ < PROBE_DELAY) __builtin_amdgcn_s_sleep(8); }
#endif
        pg8::Gemm g{R1, (const bf16*)(ws + WS_WMIX), NPROMPT, D, D}; pg8::StaticOrder S; S.init(NPROMPT, D, F.G, bx);
        if (PROBE_P5 == 9 || PROBE_P5 == 10) { pg8::EpiMixT<0, PROBE_P5> E{(const bf16*)(ws + WS_GA), (const bf16*)(ws + WS_GC), (bf16*)(ws + WS_MIX)}; pg8::gemm_phase<pg8::EpiMixT<0, PROBE_P5>, pg8::StaticOrder, true, true>(F.lds, g, S, E); }
        else if (PROBE_P5 == 8) { pg8::EpiMixT<0, 8> E{(const bf16*)(ws + WS_GA), (const bf16*)(ws + WS_GC), (bf16*)(ws + WS_MIX)}; pg8::gemm_phase<pg8::EpiMixT<0, 8>, pg8::StaticOrder, true, true>(F.lds, g, S, E); }
        else if (PROBE_P5 >= 15 && PROBE_P5 <= 17) { pg8::EpiMixT<0, PROBE_P5 - 10> E{(const bf16*)(ws + WS_GA), (const bf16*)(ws + WS_GC), (bf16*)(ws + WS_MIX)}; pg8::gemm_phase<pg8::EpiMixT<0, PROBE_P5 - 10>, pg8::StaticOrder, true, true>(F.lds, g, S, E); }
        else if (PROBE_P5 == 6) { pg8::EpiMixT<0, 3> E{(const bf16*)(ws + WS_GA), (const bf16*)(ws + WS_GC), (bf16*)(ws + WS_MIX)}; pg8::gemm_phase<pg8::EpiMixT<0, 3>, pg8::StaticOrder, true, true>(F.lds, g, S, E); }
        else if (PROBE_P5 == 7) { pg8::EpiMixT<0, 4> E{(const bf16*)(ws + WS_GA), (const bf16*)(ws + WS_GC), (bf16*)(ws + WS_MIX)}; pg8::gemm_phase<pg8::EpiMixT<0, 4>, pg8::StaticOrder, true, true>(F.lds, g, S, E); }
        else if (PROBE_P5 == 4) { pg8::EpiMixT<0, 1> E{(const bf16*)(ws + WS_GA), (const bf16*)(ws + WS_GC), (bf16*)(ws + WS_MIX)}; pg8::gemm_phase<pg8::EpiMixT<0, 1>, pg8::StaticOrder, true, true>(F.lds, g, S, E); }
        else if (PROBE_P5 == 5) { pg8::EpiMixT<0, 2> E{(const bf16*)(ws + WS_GA), (const bf16*)(ws + WS_GC), (bf16*)(ws + WS_MIX)}; pg8::gemm_phase<pg8::EpiMixT<0, 2>, pg8::StaticOrder, true, true>(F.lds, g, S, E); }
        else if (PROBE_P5 == 3) { pg8::EpiMixT<0> E{(const bf16*)(ws + WS_GA), (const bf16*)(ws + WS_GC), (bf16*)(ws + WS_MIX)}; pg8::gemm_phase<pg8::EpiMixT<0>, pg8::StaticOrder, true, true>(F.lds, g, S, E); }
        else { pg8::EpiMix E{(const bf16*)(ws + WS_GA), (const bf16*)(ws + WS_GC), (bf16*)(ws + WS_MIXB)}; pg8::gemm_phase<pg8::EpiMix, pg8::StaticOrder, true, true>(F.lds, g, S, E); }
        SEAM(5);
    }
#endif
    if (IN(6)) REP(6) {
#ifdef P6_TEST
        pg8::Gemm g{(const bf16*)(ws + P6_TEST), (const bf16*)(ws + WS_WOUT), MP, D, D}; pg8::StaticOrder S; S.init(MP, D, F.G, bx);
        pg8::EpiRes<1> E{nullptr, HB, nullptr, (bf16*)(ws + WS_MIX), ss3};
#else
        pg8::Gemm g{(const bf16*)(ws + WS_MIXB), (const bf16*)(ws + WS_WOUT), NPROMPT, D, D}; pg8::StaticOrder S; S.init(NPROMPT, D, F.G, vx);
        pg8::EpiRes<1> E{nullptr, HB, nullptr, R1, ss3};
#endif
        struct Post6 { Frame& F; const Args& a; float* ss; const XcdBarrier& bar; bool xloc; __device__ __forceinline__ void operator()() const {
#ifndef P6_TEST
            if (xloc) xcd_seam_wait(bar, 5);
            side_p6(F, a, ss);
#endif
        } } post{F, args, ss3, bar, xloc};
        pg8::gemm_phase<pg8::EpiRes<1>, pg8::StaticOrder, true, true, Post6>(F.lds, g, S, E, post);
        if (xloc) xcd_barrier_local(bar, 6); else SEAM(6);
    }
#ifdef PROBE_P56
    if (IN(6)) { float* const ssd = (float*)(F.ctl + CW_SS3 + MP);
        xcd_barrier(bar);
        { side_p5(F, args);
          pg8::Gemm g{R1  , (const bf16*)(ws + WS_WMIX), NPROMPT, D, D}; pg8::StaticOrder S; S.init(NPROMPT, D, F.G, bx);
          pg8::EpiMix E{(const bf16*)(ws + WS_GA), (const bf16*)(ws + WS_GC), (bf16*)(ws + WS_MIX)};
          pg8::gemm_phase<pg8::EpiMix, pg8::StaticOrder, true, true>(F.lds, g, S, E); }
        xcd_barrier(bar);
        { pg8::Gemm g{(const bf16*)(ws + WS_MIX), (const bf16*)(ws + WS_WOUT), NPROMPT, D, D}; pg8::StaticOrder S; S.init(NPROMPT, D, F.G, bx);
          pg8::EpiRes<1> E{nullptr, HB, nullptr, (bf16*)(ws + WS_MIXB), ssd};
          pg8::gemm_phase<pg8::EpiRes<1>, pg8::StaticOrder, true, true>(F.lds, g, S, E); }
    }
#endif
    if (IN(7)) REP(7) {
        pg8::Gemm g{R1, (const bf16*)(ws + WS_W13B), MP, 2 * DFF, D}; pg8::MainSideOrder S; int ir, nidle; S.init(NPROMPT, 2 * DFF, F.G, vx, SEAMW7, ir, nidle);
        pg8::EpiUp E{HID, DFF, ss3};
        pg8::gemm_phase<pg8::EpiUp, pg8::MainSideOrder, MULTI_ALIGN, MULTI_SP2>(F.lds, g, S, E);
#ifndef COPIES_IN_P0
#if EARLY_WB & 4
        if (ir >= nidle - 8) { if (F.tid == 0) { asm volatile("buffer_wbl2 sc1" ::: "memory"); } }
        else if (ir >= 22) p0_copies(F, args, ir - 22, nidle - 22 - 8);
#else
        if (ir >= 22) p0_copies(F, args, ir - 22, nidle - 22);
#endif
#endif
        SEAM(7);
    }
    if (IN(8)) REP(8) {
        pg8::Gemm g{HID, (const bf16*)(ws + WS_W2B), NPROMPT, D, DFF}; pg8::StaticOrder S; S.init(NPROMPT, D, F.G, bx);
        pg8::EpiRes<2> E{nullptr, R1, outy, nullptr, nullptr};
        struct Post8 { Frame& F; const Args& a; __device__ __forceinline__ void operator()() const { side_p8(F, a);
#ifdef PROBE_SIDE2
            side_p8(F, a);
#endif
        } } post{F, args};
        pg8::gemm_phase<pg8::EpiRes<2>, pg8::StaticOrder, true, true, Post8, AUXA_DOWN>(F.lds, g, S, E, post);
    }
#ifdef PROBE_P8
    if (IN(8)) {
        xcd_barrier(bar);
        side_p8(F, args);
        pg8::Gemm g{HID, (const bf16*)(ws + WS_W2B), NPROMPT, D, DFF}; pg8::StaticOrder S; S.init(NPROMPT, D, F.G, bx);
        pg8::EpiRes<2> E{nullptr, R1, outy, nullptr, nullptr};
        pg8::gemm_phase<pg8::EpiRes<2>, pg8::StaticOrder, true, true>(F.lds, g, S, E);
    }
#endif
#ifdef PROBE_P0_END
    if (IN(8)) { xcd_barrier(bar); p0_prologue(F, args); }
#endif
#ifdef PROBE_TWICE
    }
#endif
#undef IN
#undef SEAM
}

extern "C" void kernel_launch(void* const* d_in, const int* in_sizes, int n_in, void* d_out, int out_size, void* d_ws, size_t ws_size, hipStream_t stream) {
    static int grid = 0;
    if (grid == 0) {
        if (n_in != 27 || ws_size < WS_END) { fprintf(stderr, "kernel_launch: unexpected n_in %d / ws %zu\n", n_in, ws_size); grid = -1; return; }
        int dev = 0, cus = 0, per_cu = 0;
        if (hipGetDevice(&dev) != hipSuccess || hipDeviceGetAttribute(&cus, hipDeviceAttributeMultiprocessorCount, dev) != hipSuccess) { grid = -1; return; }
        if (hipFuncSetAttribute((const void*)mk_fwd, hipFuncAttributeMaxDynamicSharedMemorySize, LDS_BYTES) != hipSuccess) { fprintf(stderr, "kernel_launch: hipFuncSetAttribute failed\n"); grid = -1; return; }
        if (hipOccupancyMaxActiveBlocksPerMultiprocessor(&per_cu, (const void*)mk_fwd, NWAVES * 64, LDS_BYTES) != hipSuccess || per_cu < 1) { fprintf(stderr, "kernel_launch: occupancy query failed (%d)\n", per_cu); (void)hipGetLastError(); per_cu = 1; }
        grid = cus * 1;
        fprintf(stderr, "kernel_launch: cus %d per_cu %d grid %d\n", cus, per_cu, grid);
    }
    if (grid < 0) return;
    (void)hipMemsetAsync((char*)d_ws + WS_CTL, 0, CTL_ZERO_BYTES, stream);
    Args a{};
    for (int i = 0; i < 27; ++i) a.in[i] = (const float*)d_in[i];
    a.out = (float*)d_out; a.ws = (unsigned char*)d_ws;
#if MK_SPLIT
    for (int p = 0; p < N_PHASES; ++p) { a.ph_lo = p; a.ph_hi = p + 1; hipLaunchKernelGGL(mk_fwd, dim3(grid), dim3(NWAVES * 64), LDS_BYTES, stream, a); }
#else
    a.ph_lo = 0; a.ph_hi = N_PHASES;
    void* kargs[] = {&a};
#ifdef PROBE_PLAIN_LAUNCH
    hipLaunchKernelGGL(mk_fwd, dim3(grid), dim3(NWAVES * 64), LDS_BYTES, stream, a); hipError_t e = hipSuccess; (void)kargs;
#else
    hipError_t e = hipLaunchCooperativeKernel((const void*)mk_fwd, dim3(grid), dim3(NWAVES * 64), kargs, LDS_BYTES, stream);
#endif
    if (e != hipSuccess) fprintf(stderr, "kernel_launch: cooperative launch failed: %s (grid %d)\n", hipGetErrorString(e), grid);
#ifdef PROBE_EMPTY_LAUNCH
    { Args a2 = a; a2.ph_lo = 0; a2.ph_hi = 0; void* kargs2[] = {&a2};
      (void)hipLaunchCooperativeKernel((const void*)mk_fwd, dim3(grid), dim3(NWAVES * 64), kargs2, LDS_BYTES, stream); }
#endif
#ifdef PROBE_2LAUNCH
    (void)hipMemsetAsync((char*)d_ws + WS_CTL, 0, CTL_ZERO_BYTES, stream);
    (void)hipLaunchCooperativeKernel((const void*)mk_fwd, dim3(grid), dim3(NWAVES * 64), kargs, LDS_BYTES, stream);
#endif
#endif
}
```
